# Optimizing an MI355X kernel written in HIP

```python
import jax, jax.numpy as jnp
from jax import lax
import numpy as np

D_MODEL = 2048
BATCH = 16
SEQ = 2048
DEPTH = 1
DEC_BATCH = 32
DEC_SEQ = 32
PAST_LEN = 4096

CHUNK = 64
D_MIX = D_MODEL
D_ATTN = D_MIX // 2
D_LRU = D_MIX - D_ATTN
HEAD_DIM = 128
N_HEADS = D_ATTN // HEAD_DIM
N_LRU_BLOCKS = 8
LRU_BLOCK = D_LRU // N_LRU_BLOCKS
CONV_W = 4
LRU_C = 8.0
Q_BLOCK = 128
SPLITS = (D_ATTN, 2 * D_ATTN, 3 * D_ATTN, 3 * D_ATTN + N_HEADS,
          4 * D_ATTN + N_HEADS, 4 * D_ATTN + N_HEADS + D_LRU)
D_IN = 4 * D_ATTN + N_HEADS + 2 * D_LRU
ALPHA = (2.0 * DEPTH) ** 0.25
BETA = (8.0 * DEPTH) ** -0.25
LN_EPS = 1e-5
RMS_EPS = 1e-6

kernel_name = 'hymba_fox_rglru_streaming_step'

F32 = jnp.float32


def project(x, w_in, b_f):
    B, T, _ = x.shape
    z = jnp.einsum('btd,de->bte', x, w_in)
    o = SPLITS
    q = z[..., :o[0]].reshape(B, T, N_HEADS, HEAD_DIM)
    k = z[..., o[0]:o[1]].reshape(B, T, N_HEADS, HEAD_DIM)
    v = z[..., o[1]:o[2]].reshape(B, T, N_HEADS, HEAD_DIM)
    logf = jax.nn.log_sigmoid((z[..., o[2]:o[3]] + b_f).astype(F32))
    g_a = z[..., o[3]:o[4]]
    x_l = z[..., o[4]:o[5]]
    g_l = z[..., o[5]:]
    return q, k, v, logf, g_a, x_l, g_l


def fox_prompt(q, k, v, logf):
    B, S = q.shape[:2]
    scale = HEAD_DIM ** -0.5
    c = jnp.cumsum(logf, axis=1)
    cT = jnp.transpose(c, (0, 2, 1))
    nb = S // Q_BLOCK
    qb = jnp.transpose(q.reshape(B, nb, Q_BLOCK, N_HEADS, HEAD_DIM), (1, 0, 2, 3, 4))
    cb = jnp.transpose(c.reshape(B, nb, Q_BLOCK, N_HEADS), (1, 0, 3, 2))
    kpos = jnp.arange(S)

    def one_block(args):
        i, qi, ci = args
        s = jnp.einsum('bqhd,bkhd->bhqk', qi, k).astype(F32) * scale
        s = s + (ci[..., :, None] - cT[..., None, :])
        qpos = i * Q_BLOCK + jnp.arange(Q_BLOCK)
        mask = kpos[None, :] <= qpos[:, None]
        s = jnp.where(mask, s, -jnp.inf)
        p = jax.nn.softmax(s, axis=-1)
        return jnp.einsum('bhqk,bkhd->bqhd', p.astype(v.dtype), v)

    out = lax.map(one_block, (jnp.arange(nb), qb, cb))
    return jnp.transpose(out, (1, 0, 2, 3, 4)).reshape(B, S, N_HEADS, HEAD_DIM)


def fox_sample(q, k, v, logf, cache_k, cache_v, cache_logf):
    P = cache_k.shape[1]
    T = q.shape[1]
    scale = HEAD_DIM ** -0.5
    c_past = jnp.cumsum(cache_logf.astype(F32), axis=1)
    c_new = c_past[:, -1:, :] + jnp.cumsum(logf, axis=1)
    c_all = jnp.concatenate([c_past, c_new], axis=1)
    k_all = jnp.concatenate([cache_k, k.astype(cache_k.dtype)], axis=1)
    v_all = jnp.concatenate([cache_v, v.astype(cache_v.dtype)], axis=1)
    s = jnp.einsum('bqhd,bkhd->bhqk', q, k_all).astype(F32) * scale
    s = s + (jnp.transpose(c_new, (0, 2, 1))[..., :, None] - jnp.transpose(c_all, (0, 2, 1))[..., None, :])
    kpos = jnp.arange(P + T)
    qpos = P + jnp.arange(T)
    s = jnp.where(kpos[None, :] <= qpos[:, None], s, -jnp.inf)
    p = jax.nn.softmax(s, axis=-1)
    return jnp.einsum('bhqk,bkhd->bqhd', p.astype(v_all.dtype), v_all)


def rglru_branch(x_l, conv_hist, h0, reset_first, conv_w, conv_b, w_r, b_r, w_i, b_i, lru_lambda):
    B, T, _ = x_l.shape
    xpad = jnp.concatenate([conv_hist.astype(x_l.dtype), x_l], axis=1)
    xc = conv_b + xpad[:, 0:T] * conv_w[0]
    for j in range(1, CONV_W):
        xc = xc + xpad[:, j:j + T] * conv_w[j]
    new_hist = xpad[:, T:]
    xb = xc.reshape(B, T, N_LRU_BLOCKS, LRU_BLOCK)
    r = jax.nn.sigmoid((jnp.einsum('btnj,njk->btnk', xb, w_r).reshape(B, T, D_LRU) + b_r).astype(F32))
    i = jax.nn.sigmoid((jnp.einsum('btnj,njk->btnk', xb, w_i).reshape(B, T, D_LRU) + b_i).astype(F32))
    log_a = -LRU_C * r * jax.nn.softplus(-lru_lambda.astype(F32))
    a = jnp.exp(log_a)
    mult = jnp.sqrt(-jnp.expm1(2.0 * log_a))
    if reset_first:
        mult = jnp.where((jnp.arange(T) == 0)[None, :, None], 1.0, mult)
    u = mult * i * xc.astype(F32)

    def step(h, au):
        a_t, u_t = au
        h = a_t * h + u_t
        return h, h

    h_T, hs = lax.scan(step, h0.astype(F32), (jnp.swapaxes(a, 0, 1), jnp.swapaxes(u, 0, 1)))
    return jnp.swapaxes(hs, 0, 1).astype(x_l.dtype), h_T, new_hist


def group_rms(y, g, n_groups):
    B, T, D = y.shape
    yg = y.astype(F32).reshape(B, T, n_groups, D // n_groups)
    yg = yg * lax.rsqrt(jnp.mean(jnp.square(yg), axis=-1, keepdims=True) + RMS_EPS)
    return yg.reshape(B, T, D) * g.astype(F32)


def mix_and_norm(x, attn, lru, g_a, g_l, g_attn, g_lru, w_out, ln_g, ln_b):
    B, T, _ = x.shape
    ya = group_rms(attn.reshape(B, T, D_ATTN), g_attn, N_HEADS) * jax.nn.silu(g_a.astype(F32))
    yl = group_rms(lru, g_lru, N_LRU_BLOCKS) * jax.nn.silu(g_l.astype(F32))
    ycat = jnp.concatenate([ya, yl], axis=-1).astype(x.dtype)
    out = jnp.einsum('bte,ed->btd', ycat, w_out)
    h = ALPHA * x.astype(F32) + out.astype(F32)
    mu = jnp.mean(h, axis=-1, keepdims=True)
    var = jnp.mean(jnp.square(h - mu), axis=-1, keepdims=True)
    return ((h - mu) * lax.rsqrt(var + LN_EPS) * ln_g + ln_b).astype(x.dtype)


def setup_inputs(seed: int = 0) -> dict:
    key = jax.random.key(seed)
    ks = jax.random.split(key, 22)
    nrm = jax.random.normal
    x_prompt = nrm(ks[0], (BATCH, SEQ, D_MODEL), F32)
    x_sample = nrm(ks[1], (DEC_BATCH, DEC_SEQ, D_MODEL), F32)
    cache_k = nrm(ks[2], (DEPTH, DEC_BATCH, PAST_LEN, N_HEADS, HEAD_DIM), F32)
    cache_v = nrm(ks[3], (DEPTH, DEC_BATCH, PAST_LEN, N_HEADS, HEAD_DIM), F32)
    head_bias = jnp.linspace(2.0, 7.0, N_HEADS, dtype=F32)
    cache_logf = jax.nn.log_sigmoid(nrm(ks[4], (DEPTH, DEC_BATCH, PAST_LEN, N_HEADS), F32) + head_bias)
    state_h = 0.5 * nrm(ks[5], (DEPTH, DEC_BATCH, D_LRU), F32)
    state_conv = nrm(ks[6], (DEPTH, DEC_BATCH, CONV_W - 1, D_LRU), F32)
    w_in = nrm(ks[7], (DEPTH, D_MODEL, D_IN), F32) * D_MODEL ** -0.5
    b_f = head_bias + 0.1 * nrm(ks[8], (DEPTH, N_HEADS), F32)
    conv_w = nrm(ks[9], (DEPTH, CONV_W, D_LRU), F32) * CONV_W ** -0.5
    conv_b = 0.01 * nrm(ks[10], (DEPTH, D_LRU), F32)
    w_r = nrm(ks[11], (DEPTH, N_LRU_BLOCKS, LRU_BLOCK, LRU_BLOCK), F32) * LRU_BLOCK ** -0.5
    b_r = 0.01 * nrm(ks[12], (DEPTH, D_LRU), F32)
    w_i = nrm(ks[13], (DEPTH, N_LRU_BLOCKS, LRU_BLOCK, LRU_BLOCK), F32) * LRU_BLOCK ** -0.5
    b_i = 0.01 * nrm(ks[14], (DEPTH, D_LRU), F32)
    a_target = jax.random.uniform(ks[15], (DEPTH, D_LRU), F32, minval=0.9, maxval=0.999)
    p = a_target ** (1.0 / LRU_C)
    lru_lambda = jnp.log(p) - jnp.log1p(-p)
    g_attn = 1.0 + 0.02 * nrm(ks[16], (DEPTH, D_ATTN), F32)
    g_lru = 1.0 + 0.02 * nrm(ks[17], (DEPTH, D_LRU), F32)
    w_out = nrm(ks[18], (DEPTH, D_MIX, D_MODEL), F32) * (D_MIX ** -0.5) * BETA
    ln_g = 1.0 + 0.02 * nrm(ks[19], (DEPTH, D_MODEL), F32)
    ln_b = 0.01 * nrm(ks[20], (DEPTH, D_MODEL), F32)
    return {'x_prompt': x_prompt, 'x_sample': x_sample, 'cache_k': cache_k, 'cache_v': cache_v,
            'cache_logf': cache_logf, 'state_h': state_h, 'state_conv': state_conv,
            'w_in': w_in, 'b_f': b_f, 'conv_w': conv_w, 'conv_b': conv_b, 'w_r': w_r, 'b_r': b_r,
            'w_i': w_i, 'b_i': b_i, 'lru_lambda': lru_lambda, 'g_attn': g_attn, 'g_lru': g_lru,
            'w_out': w_out, 'ln_g': ln_g, 'ln_b': ln_b}


def reference(x_prompt, x_sample, cache_k, cache_v, cache_logf, state_h, state_conv,
              w_in, b_f, conv_w, conv_b, w_r, b_r, w_i, b_i, lru_lambda,
              g_attn, g_lru, w_out, ln_g, ln_b):
    xp, xs = x_prompt, x_sample
    kp_l, vp_l, fp_l, hp_l, cp_l = [], [], [], [], []
    ks_l, vs_l, fs_l, hs_l, cs_l = [], [], [], [], []
    for l in range(DEPTH):
        lru_w = (conv_w[l], conv_b[l], w_r[l], b_r[l], w_i[l], b_i[l], lru_lambda[l])
        q, k, v, logf, g_a, x_l, g_l = project(xp, w_in[l], b_f[l])
        attn = fox_prompt(q, k, v, logf)
        hist0 = jnp.zeros((xp.shape[0], CONV_W - 1, D_LRU), xp.dtype)
        h0 = jnp.zeros((xp.shape[0], D_LRU), F32)
        lru, h_T, hist_T = rglru_branch(x_l, hist0, h0, True, *lru_w)
        kp_l.append(k); vp_l.append(v); fp_l.append(logf); hp_l.append(h_T); cp_l.append(hist_T)
        xp = mix_and_norm(xp, attn, lru, g_a, g_l, g_attn[l], g_lru[l], w_out[l], ln_g[l], ln_b[l])
        q, k, v, logf, g_a, x_l, g_l = project(xs, w_in[l], b_f[l])
        attn = fox_sample(q, k, v, logf, cache_k[l], cache_v[l], cache_logf[l])
        lru, h_T, hist_T = rglru_branch(x_l, state_conv[l], state_h[l], False, *lru_w)
        ks_l.append(k); vs_l.append(v); fs_l.append(logf); hs_l.append(h_T); cs_l.append(hist_T)
        xs = mix_and_norm(xs, attn, lru, g_a, g_l, g_attn[l], g_lru[l], w_out[l], ln_g[l], ln_b[l])
    k_prompt = jnp.stack(kp_l, 0)
    v_prompt = jnp.stack(vp_l, 0)
    logf_prompt = jnp.stack(fp_l, 0)
    h_prompt = jnp.stack(hp_l, 0)
    conv_prompt = jnp.stack(cp_l, 0)
    k_sample = jnp.stack(ks_l, 0)
    v_sample = jnp.stack(vs_l, 0)
    logf_sample = jnp.stack(fs_l, 0)
    h_sample = jnp.stack(hs_l, 0)
    conv_sample = jnp.stack(cs_l, 0)
    return (xp, xs, k_prompt, v_prompt, logf_prompt, h_prompt, conv_prompt,
            k_sample, v_sample, logf_sample, h_sample, conv_sample)
```

```cpp
#include <hip/hip_runtime.h>
#include <hip/hip_bf16.h>
#include <cstdio>
#include <cstdint>

#ifndef MK_N_LAUNCHES
#define MK_N_LAUNCHES 1
#endif

namespace pg8 {
#define PG8_LAS __attribute__((address_space(3)))
typedef unsigned short bf16_t;
typedef short bf16x8 __attribute__((ext_vector_type(8)));
typedef float f32x4 __attribute__((ext_vector_type(4)));
typedef unsigned u32x4 __attribute__((ext_vector_type(4)));
constexpr int BM = 256, BK = 64, HALF = 128, HTB = HALF * BK * 2  , STAGE_BYTES = 8 * HTB, NXCD = 8, WGM = 8;

__host__ __device__ __forceinline__ int lds_byte(int r, int c) { const int st = (r >> 4) * 2 + (c >> 5), rr = r & 15, cc = c & 31, ob = rr * 64 + cc * 2; return st * 1024 + (ob ^ (((ob >> 9) & 1) << 5)); }
__host__ __device__ __forceinline__ void stage_rc(int b, int& R, int& C) { const int st = b / 1024, sb = b % 1024, swz = sb ^ (((sb >> 9) & 1) << 5); R = (st >> 1) * 16 + swz / 64; C = (st & 1) * 32 + (swz % 64) / 2; }
__host__ __device__ __forceinline__ int perm32(int rho) { const int n = rho >> 4, i = rho & 15; return 8 * (i >> 2) + 4 * n + (i & 3); }

struct Unit { int pm, pn; };
struct Gemm { const bf16_t* A; const bf16_t* Bt; int M, N, K; };

struct StaticOrder {
    int nM, nN, nwg, G, c;
    __host__ __device__ void init(int M, int N, int G_, int c_) { nM = M / BM; nN = N / BM; nwg = nM * nN; G = G_; c = c_; }
    __host__ __device__ bool next(int i, Unit& u) const {
        const long L = (long)i * G + c; if (L >= nwg) return false;
        int wgid = (int)L; { const int q = nwg / NXCD, r = nwg % NXCD, xcd = wgid % NXCD, off = wgid / NXCD; wgid = (xcd < r ? xcd * (q + 1) : r * (q + 1) + (xcd - r) * q) + off; }
        const int nig = WGM * nN, gid = wgid / nig, fm = gid * WGM, gsz = (nM - fm) < WGM ? (nM - fm) : WGM;
        u.pm = fm + ((wgid % nig) % gsz); u.pn = (wgid % nig) / gsz; return true;
    }
    __device__ __forceinline__ void a_ready(const Unit&) const {}
    __device__ __forceinline__ void done(const Unit&) const {}
};

__device__ __forceinline__ unsigned cvt_pk_bf16(float lo, float hi) { unsigned r; asm volatile("v_cvt_pk_bf16_f32 %0, %1, %2" : "=v"(r) : "v"(lo), "v"(hi)); return r; }
__device__ __forceinline__ float silu_f(float v) { return v * __builtin_amdgcn_rcpf(1.0f + __builtin_amdgcn_exp2f(-1.4426950408889634f * v)); }

struct EpiIn {
    static constexpr bool PERM = true, AFTER_DRAIN = false;
    bf16_t* act; size_t act_stride;
    float* kout_p; float* vout_p; float* kout_s; float* vout_s; float* conv_p; float* conv_s;
    __device__ __forceinline__ void operator()(const f32x4 (&acc)[2][2][4][2], const Unit& u, int wr, int wc, int fr, int fq) const {
        const int ty = u.pn >> 2, colt = (u.pn & 3) * BM;
        const int row0 = u.pm * BM + wr * 64 + fr, col0 = colt + wc * 32 + 8 * fq;
        const bool samp = u.pm >= 128; const int rofs = samp ? 32768 : 0;
        bf16_t* base = act + (size_t)ty * act_stride;
        float* fo = (ty == 1) ? (samp ? kout_s : kout_p) : ((ty == 2) ? (samp ? vout_s : vout_p) : nullptr);
        const bool do_silu = (ty == 3) || (ty == 5);
#pragma unroll
        for (int ai = 0; ai < 2; ++ai)
#pragma unroll
            for (int m = 0; m < 4; ++m) { const int row = row0 + ai * HALF + m * 16; bf16_t* rowp = base + (size_t)row * 1024 + col0;
#pragma unroll
                for (int bj = 0; bj < 2; ++bj) { f32x4 v0 = acc[ai][bj][m][0], v1 = acc[ai][bj][m][1];
                    if (fo) { float* fp = fo + (size_t)(row - rofs) * 1024 + col0 + bj * HALF; *(f32x4*)fp = v0; *(f32x4*)(fp + 4) = v1; }
                    if (ty == 4) {
                        const int rl = row - rofs; const int t = samp ? (rl & 31) : (rl & 2047); const int tl = samp ? 29 : 2045;
                        if (t >= tl) { float* cp = (samp ? conv_s + (size_t)((rl >> 5) * 3 + (t - tl)) * 1024 : conv_p + (size_t)((rl >> 11) * 3 + (t - tl)) * 1024) + col0 + bj * HALF;
                            *(f32x4*)cp = v0; *(f32x4*)(cp + 4) = v1; }
                    }
                    if (do_silu) { v0[0] = silu_f(v0[0]); v0[1] = silu_f(v0[1]); v0[2] = silu_f(v0[2]); v0[3] = silu_f(v0[3]); v1[0] = silu_f(v1[0]); v1[1] = silu_f(v1[1]); v1[2] = silu_f(v1[2]); v1[3] = silu_f(v1[3]); }
                    u32x4 w; w.x = cvt_pk_bf16(v0[0], v0[1]); w.y = cvt_pk_bf16(v0[2], v0[3]); w.z = cvt_pk_bf16(v1[0], v1[1]); w.w = cvt_pk_bf16(v1[2], v1[3]);
                    *(u32x4*)(rowp + bj * HALF) = w; } }
    }
};
struct EpiRes {
    static constexpr bool PERM = false, AFTER_DRAIN = false;
    const float* xp; const float* xs; float* y; float alpha;
    __device__ __forceinline__ void operator()(const f32x4 (&acc)[2][2][4][2], const Unit& u, int wr, int wc, int fr, int fq) const {
        const int row0 = u.pm * BM + wr * 64 + fr, col0 = u.pn * BM + wc * 32 + 4 * fq;
        const bool samp = u.pm >= 128; const float* xb = samp ? xs - (size_t)0 : xp; const int rofs = samp ? 32768 : 0;
#pragma unroll
        for (int ai = 0; ai < 2; ++ai)
#pragma unroll
            for (int m = 0; m < 4; ++m) { const int row = row0 + ai * HALF + m * 16; const float* xr = xb + (size_t)(row - rofs) * 2048 + col0; float* yr = y + (size_t)row * 2048 + col0;
#pragma unroll
                for (int bj = 0; bj < 2; ++bj)
#pragma unroll
                    for (int n = 0; n < 2; ++n) { const f32x4 xv = *(const f32x4*)(xr + bj * HALF + n * 16); *(f32x4*)(yr + bj * HALF + n * 16) = xv * alpha + acc[ai][bj][m][n]; } }
    }
};
template <class Epi, class Sched, bool ALIGN_EPI = false, bool SP2 = false>
__device__ __forceinline__ void gemm_phase(PG8_LAS unsigned char* lds, const Gemm g, const Sched& S, const Epi& E) {
    const int tid = threadIdx.x, wid = __builtin_amdgcn_readfirstlane(tid >> 6), lane = tid & 63, wr = wid >> 2, wc = wid & 3, fr = lane & 15, fq = lane >> 4;
    const int K = g.K, nt = K / BK;
    unsigned voffA[2], voffB[2];
#pragma unroll
    for (int i = 0; i < 2; ++i) { int R, C; stage_rc(tid * 16 + i * 8192, R, C); const int Rb = Epi::PERM ? ((R & ~31) + perm32(R & 31)) : R;
        voffA[i] = (unsigned)(R * K + C) * 2u; voffB[i] = (unsigned)(Rb * K + C) * 2u; }
    const size_t kstep = (size_t)(BK * 2);
    const size_t hstep = (size_t)HALF * K * 2;
    const size_t tstep = 2 * hstep;
    const unsigned ldsw = (unsigned)wid * 1024u;
    const int aoff = lds_byte(wr * 64 + fr, fq * 8), boff = lds_byte(wc * 32 + fr, fq * 8);
#define PG8_SA(b, h) (((b) * 2 + (h)) * HTB)
#define PG8_SB(b, h) ((4 + (b) * 2 + (h)) * HTB)
#define PG8_STAGE(bufoff, gbase, voff) do { _Pragma("unroll") for (int _i = 0; _i < 2; ++_i) \
        __builtin_amdgcn_global_load_lds((const unsigned*)((const char*)(gbase) + (voff)[_i]), (PG8_LAS unsigned*)(lds + (bufoff) + ldsw + _i * 8192), 16, 0, 0); } while (0)
#define PG8_LDA(dst, b, h) do { _Pragma("unroll") for (int m = 0; m < 4; ++m) _Pragma("unroll") for (int k = 0; k < 2; ++k) dst[m][k] = *(const PG8_LAS bf16x8*)(lds + PG8_SA(b, h) + aoff + m * 2048 + k * 1024); } while (0)
#define PG8_LDB(dst, b, h) do { _Pragma("unroll") for (int n = 0; n < 2; ++n) _Pragma("unroll") for (int k = 0; k < 2; ++k) dst[n][k] = *(const PG8_LAS bf16x8*)(lds + PG8_SB(b, h) + boff + n * 2048 + k * 1024); } while (0)
#define PG8_MMA(ai, bj, At, Bt) do { __builtin_amdgcn_s_setprio(1); _Pragma("unroll") for (int m = 0; m < 4; ++m) _Pragma("unroll") for (int n = 0; n < 2; ++n) _Pragma("unroll") for (int k = 0; k < 2; ++k) \
        acc[ai][bj][m][n] = __builtin_amdgcn_mfma_f32_16x16x32_bf16(Bt[n][k], At[m][k], acc[ai][bj][m][n], 0, 0, 0); __builtin_amdgcn_s_setprio(0); } while (0)
#define PG8_WAIT_V(n) asm volatile("s_waitcnt vmcnt(" #n ")" ::: "memory")
#define PG8_WAIT_L(n) asm volatile("s_waitcnt lgkmcnt(" #n ")" ::: "memory")
#define PG8_BAR __builtin_amdgcn_s_barrier()
#define PG8_SCHED __builtin_amdgcn_sched_barrier(0)
    Unit cur, nxt; int ui = 0;
    if (!S.next(0, cur)) return;
    f32x4 acc[2][2][4][2];
#pragma unroll
    for (int a = 0; a < 2; ++a)
#pragma unroll
        for (int b = 0; b < 2; ++b)
#pragma unroll
            for (int m = 0; m < 4; ++m)
#pragma unroll
                for (int n = 0; n < 2; ++n) acc[a][b][m][n] = (f32x4){0.f, 0.f, 0.f, 0.f};
    bf16x8 At[4][2], B0[2][2], B1[2][2];
    const char* cA = (const char*)g.A + (size_t)cur.pm * tstep; const char* cB = (const char*)g.Bt + (size_t)cur.pn * tstep;
    S.a_ready(cur);
    if constexpr (SP2) {
        PG8_STAGE(PG8_SB(0, 0), cB, voffB); PG8_STAGE(PG8_SB(0, 1), cB + hstep, voffB); PG8_STAGE(PG8_SA(0, 0), cA, voffA); PG8_STAGE(PG8_SA(0, 1), cA + hstep, voffA);
        if (wr == 1) PG8_BAR;
        PG8_WAIT_V(2); PG8_BAR;
        PG8_STAGE(PG8_SB(1, 0), cB + kstep, voffB); PG8_STAGE(PG8_SA(1, 0), cA + kstep, voffA); PG8_STAGE(PG8_SB(1, 1), cB + hstep + kstep, voffB);
        PG8_WAIT_V(6); PG8_BAR;
    } else {
        PG8_STAGE(PG8_SB(0, 0), cB, voffB); PG8_STAGE(PG8_SA(0, 0), cA, voffA); PG8_STAGE(PG8_SB(0, 1), cB + hstep, voffB); PG8_STAGE(PG8_SA(0, 1), cA + hstep, voffA);
        if (wr == 1) PG8_BAR;
        PG8_WAIT_V(4); PG8_BAR;
        PG8_STAGE(PG8_SB(1, 0), cB + kstep, voffB); PG8_STAGE(PG8_SA(1, 0), cA + kstep, voffA); PG8_STAGE(PG8_SB(1, 1), cB + hstep + kstep, voffB);
        PG8_WAIT_V(6); PG8_BAR;
    }
    for (;;) {
        const bool has_next = S.next(ui + 1, nxt);
        const char* nA = has_next ? (const char*)g.A + (size_t)nxt.pm * tstep : cA; const char* nB = has_next ? (const char*)g.Bt + (size_t)nxt.pn * tstep : cB;
        for (int t = 0; t < nt; t += 2) {
            const bool last = (t == nt - 2);
            const char* a1 = cA + (size_t)(t + 1) * kstep;
            const char* a2 = last ? nA : cA + (size_t)(t + 2) * kstep; const char* b2 = last ? nB : cB + (size_t)(t + 2) * kstep;
            const char* a3 = a2 + kstep; const char* b3 = b2 + kstep;
            if (last && has_next) S.a_ready(nxt);
            if constexpr (SP2) {
            PG8_LDB(B0, 0, 0); PG8_LDB(B1, 0, 1); PG8_SCHED; PG8_LDA(At, 0, 0); PG8_STAGE(PG8_SA(1, 1), a1 + hstep, voffA);
            PG8_WAIT_V(8); PG8_WAIT_L(0); PG8_BAR; PG8_MMA(0, 0, At, B0); PG8_MMA(0, 1, At, B1); PG8_BAR; PG8_SCHED;
            PG8_LDA(At, 0, 1); PG8_STAGE(PG8_SB(0, 0), b2, voffB); PG8_STAGE(PG8_SB(0, 1), b2 + hstep, voffB); PG8_STAGE(PG8_SA(0, 0), a2, voffA);
            PG8_WAIT_V(8); PG8_WAIT_L(0); PG8_BAR; PG8_MMA(1, 0, At, B0); PG8_MMA(1, 1, At, B1); PG8_BAR; PG8_SCHED;
            PG8_LDB(B0, 1, 0); PG8_LDB(B1, 1, 1); PG8_SCHED; PG8_LDA(At, 1, 0); PG8_STAGE(PG8_SA(0, 1), a2 + hstep, voffA);
            PG8_WAIT_V(8); PG8_WAIT_L(0); PG8_BAR; PG8_MMA(0, 0, At, B0); PG8_MMA(0, 1, At, B1); PG8_BAR; PG8_SCHED;
            PG8_LDA(At, 1, 1); PG8_STAGE(PG8_SB(1, 0), b3, voffB); PG8_STAGE(PG8_SB(1, 1), b3 + hstep, voffB); PG8_STAGE(PG8_SA(1, 0), a3, voffA);
            PG8_WAIT_V(8); PG8_WAIT_L(0); PG8_BAR; PG8_MMA(1, 0, At, B0); PG8_MMA(1, 1, At, B1); PG8_BAR; PG8_SCHED;
            } else {
            PG8_LDB(B0, 0, 0); PG8_SCHED; PG8_LDA(At, 0, 0); PG8_STAGE(PG8_SA(1, 1), a1 + hstep, voffA);
            PG8_WAIT_L(8); PG8_BAR; PG8_WAIT_L(0); PG8_MMA(0, 0, At, B0); PG8_BAR; PG8_SCHED;
            PG8_LDB(B1, 0, 1); PG8_STAGE(PG8_SB(0, 0), b2, voffB);
            PG8_BAR; PG8_WAIT_L(0); PG8_MMA(0, 1, At, B1); PG8_BAR;
            PG8_LDA(At, 0, 1); PG8_STAGE(PG8_SA(0, 0), a2, voffA);
            PG8_BAR; PG8_WAIT_L(0); PG8_MMA(1, 0, At, B0); PG8_BAR; PG8_SCHED;
            PG8_STAGE(PG8_SB(0, 1), b2 + hstep, voffB);
            PG8_WAIT_V(6); PG8_BAR; PG8_MMA(1, 1, At, B1); PG8_BAR;
            PG8_LDB(B0, 1, 0); PG8_SCHED; PG8_LDA(At, 1, 0); PG8_STAGE(PG8_SA(0, 1), a2 + hstep, voffA);
            PG8_WAIT_L(8); PG8_BAR; PG8_WAIT_L(0); PG8_MMA(0, 0, At, B0); PG8_BAR; PG8_SCHED;
            PG8_LDB(B1, 1, 1); PG8_STAGE(PG8_SB(1, 0), b3, voffB);
            PG8_BAR; PG8_WAIT_L(0); PG8_MMA(0, 1, At, B1); PG8_BAR;
            PG8_LDA(At, 1, 1); PG8_STAGE(PG8_SA(1, 0), a3, voffA);
            PG8_BAR; PG8_WAIT_L(0); PG8_MMA(1, 0, At, B0); PG8_BAR; PG8_SCHED;
            PG8_STAGE(PG8_SB(1, 1), b3 + hstep, voffB);
            PG8_WAIT_V(6); PG8_BAR; PG8_MMA(1, 1, At, B1); PG8_BAR;
            }
        }
        if constexpr (ALIGN_EPI) { if (wr == 0) PG8_BAR; }
        if constexpr (!Epi::AFTER_DRAIN) { E(acc, cur, wr, wc, fr, fq); S.done(cur); }
        if (!has_next) break;
#pragma unroll
        for (int a = 0; a < 2; ++a)
#pragma unroll
            for (int b = 0; b < 2; ++b)
#pragma unroll
                for (int m = 0; m < 4; ++m)
#pragma unroll
                    for (int n = 0; n < 2; ++n) acc[a][b][m][n] = (f32x4){0.f, 0.f, 0.f, 0.f};
        cur = nxt; cA = nA; cB = nB; ++ui;
        if constexpr (ALIGN_EPI) { if (wr == 1) PG8_BAR; }
    }
    PG8_WAIT_V(0);
    if constexpr (!ALIGN_EPI) { if (wr == 0) PG8_BAR; }
    PG8_BAR;
    if constexpr (Epi::AFTER_DRAIN) { E.fused(acc, cur, wr, wc, fr, fq, lds, wid, lane); S.done(cur); }
#undef PG8_SA
#undef PG8_SB
#undef PG8_STAGE
#undef PG8_LDA
#undef PG8_LDB
#undef PG8_MMA
#undef PG8_WAIT_V
#undef PG8_WAIT_L
#undef PG8_BAR
#undef PG8_SCHED
}
}

namespace pa {
using bf16 = __hip_bfloat16;
typedef short bf16x8 __attribute__((ext_vector_type(8)));
typedef short s16x4 __attribute__((ext_vector_type(4)));
typedef float f32x16 __attribute__((ext_vector_type(16)));
typedef float f32x4 __attribute__((ext_vector_type(4)));
typedef unsigned u32x4 __attribute__((ext_vector_type(4)));
template <class A, class Bt> struct same_t { static constexpr bool v = false; };
template <class A> struct same_t<A, A> { static constexpr bool v = true; };
constexpr int D = 128, LDR = 1024, LDY = 2048;
constexpr float SCALE = 0.08838834764831845f;
constexpr float THR = 8.f;
constexpr int NW = 8, QBLK = 32, KVBLK = 64, QB = NW * QBLK;
constexpr int SHM_V = KVBLK * D * 2, SHM_K = KVBLK * D * 2;
constexpr int LDS_WS = 2 * SHM_V + 2 * SHM_K, LDS_BIAS = LDS_WS + NW * 64 * 4, LDS_BYTES = LDS_BIAS + 2 * 2048 * 4;
enum { ORDER_NATURAL = 0, ORDER_REVERSED = 1, ORDER_PAIRED = 2, ORDER_XCD = 4 };
#define KSWZ(row, colB) ((row) * 256 + ((colB) ^ (((row) & 7) << 4)))
#define SBAR() __builtin_amdgcn_sched_barrier(0)
__device__ __forceinline__ int v_st(int k, int c) { const int kk = (k & ~0xC) | ((k & 4) << 1) | ((k & 8) >> 1); return ((kk >> 3) * 4 + (c >> 5)) * 512 + ((kk & 7) * 32 + (c & 31)) * 2; }
__device__ __forceinline__ int v_rd_base(int lane) { return ((lane & 3) << 3) | (((lane >> 2) & 3) << 6) | (((lane >> 4) & 1) << 5) | (((lane >> 5) & 1) << 8); }
constexpr int v_rd_off(int d0, int ks, int half) { return d0 * 512 + ks * 4096 + half * 2048; }
__device__ __forceinline__ int crow(int r, int hi) { return (r & 3) + 8 * (r >> 2) + 4 * hi; }
__device__ __forceinline__ unsigned cvtpk(float lo, float hi) {
    unsigned r; asm volatile("v_cvt_pk_bf16_f32 %0, %1, %2" : "=v"(r) : "v"(lo), "v"(hi)); return r;
}
__device__ __forceinline__ bf16x8 pack8(f32x4 a, f32x4 b) {
    u32x4 w = {cvtpk(a[0], a[1]), cvtpk(a[2], a[3]), cvtpk(b[0], b[1]), cvtpk(b[2], b[3])};
    return *reinterpret_cast<bf16x8*>(&w);
}
template <class T> __device__ __forceinline__ bf16x8 load8(const T* p) {
    if constexpr (same_t<T, float>::v) { return pack8(*(const f32x4*)p, *(const f32x4*)(p + 4)); }
    else { return *reinterpret_cast<const bf16x8*>(p); }
}
__device__ __forceinline__ void mask_tile(f32x16& p0, f32x16& p1, int dq, unsigned W) {
    const float NEG = -__builtin_inff();
#pragma unroll
    for (int r = 0; r < 16; ++r) {
        const int c = (r & 3) + 8 * (r >> 2);
        if ((unsigned)(dq - c) >= W) p0[r] = NEG;
        if ((unsigned)(dq - c - 32) >= W) p1[r] = NEG;
    }
}
__device__ __forceinline__ void partialSM(f32x16& p0, f32x16& p1, float& m_reg, float& mn, float& alpha) {
    float pmax = p0[0]; for (int r = 1; r < 16; ++r) pmax = fmaxf(pmax, p0[r]); for (int r = 0; r < 16; ++r) pmax = fmaxf(pmax, p1[r]);
    { auto rr = __builtin_amdgcn_permlane32_swap(__float_as_uint(pmax), __float_as_uint(pmax), false, false);
      pmax = fmaxf(__uint_as_float(rr[0]), __uint_as_float(rr[1])); }
    constexpr float C2 = 1.4426950408889634f * SCALE;
    if (__builtin_expect(__all((pmax - m_reg) * SCALE <= THR), 1)) { mn = m_reg; alpha = 1.f; }
    else { mn = fmaxf(m_reg, pmax); alpha = __builtin_amdgcn_exp2f((m_reg - mn) * C2); m_reg = mn; }
    const float mnL = -mn * C2;
    for (int r = 0; r < 16; ++r) p0[r] = fmaf(p0[r], C2, mnL); for (int r = 0; r < 16; ++r) p1[r] = fmaf(p1[r], C2, mnL);
    for (int r = 0; r < 16; ++r) p0[r] = __builtin_amdgcn_exp2f(p0[r]);
}
__device__ __forceinline__ void finishSM(f32x16& p0, f32x16& p1, float alpha, float& l_reg, bf16x8& pa0, bf16x8& pa1, bf16x8& pa2, bf16x8& pa3) {
    for (int r = 0; r < 16; ++r) p1[r] = __builtin_amdgcn_exp2f(p1[r]);
    float ps = 0; for (int r = 0; r < 16; ++r) ps += p0[r]; for (int r = 0; r < 16; ++r) ps += p1[r];
    { auto rr = __builtin_amdgcn_permlane32_swap(__float_as_uint(ps), __float_as_uint(ps), false, false);
      ps = __uint_as_float(rr[0]) + __uint_as_float(rr[1]); }
    l_reg = l_reg * alpha + ps;
#define PK4(P, B_, OUT) do { unsigned a0 = cvtpk(P[B_+0], P[B_+1]), a1 = cvtpk(P[B_+2], P[B_+3]);                          \
        unsigned b0 = cvtpk(P[B_+4], P[B_+5]), b1 = cvtpk(P[B_+6], P[B_+7]);                                             \
        auto r0 = __builtin_amdgcn_permlane32_swap(a0, b0, false, false); auto r1 = __builtin_amdgcn_permlane32_swap(a1, b1, false, false); \
        u32x4 w = {r0[0], r1[0], r0[1], r1[1]}; OUT = *reinterpret_cast<bf16x8*>(&w); } while (0)
    PK4(p0, 0, pa0); PK4(p0, 8, pa1); PK4(p1, 0, pa2); PK4(p1, 8, pa3);
#undef PK4
}
template <int KB>
__device__ __forceinline__ void qkt(f32x16& p0, f32x16& p1, const char* K_lds, const char* bias_t, int r32, int hi, const bf16x8* qr) {
    { const f32x4 b0 = *(const f32x4*)(bias_t), b1 = *(const f32x4*)(bias_t + 32), b2 = *(const f32x4*)(bias_t + 64), b3 = *(const f32x4*)(bias_t + 96);
      const f32x4 c0 = *(const f32x4*)(bias_t + 128), c1 = *(const f32x4*)(bias_t + 160), c2 = *(const f32x4*)(bias_t + 192), c3 = *(const f32x4*)(bias_t + 224);
      p0 = (f32x16){b0[0], b0[1], b0[2], b0[3], b1[0], b1[1], b1[2], b1[3], b2[0], b2[1], b2[2], b2[3], b3[0], b3[1], b3[2], b3[3]};
      p1 = (f32x16){c0[0], c0[1], c0[2], c0[3], c1[0], c1[1], c1[2], c1[3], c2[0], c2[1], c2[2], c2[3], c3[0], c3[1], c3[2], c3[3]}; }
    const char* kb[4];
#pragma unroll
    for (int dd = 0; dd < 4; ++dd) kb[dd] = K_lds + KB * SHM_K + KSWZ(r32, (dd * 16 + hi * 8) * 2);
#pragma unroll
    for (int d0 = 0; d0 < 8; ++d0) { const char* a = kb[d0 & 3] + (d0 >> 2) * 128;
        bf16x8 b0 = *reinterpret_cast<const bf16x8*>(a);
        bf16x8 b1 = *reinterpret_cast<const bf16x8*>(a + 32 * 256);
        p0 = __builtin_amdgcn_mfma_f32_32x32x16_bf16(b0, qr[d0], p0, 0, 0, 0);
        p1 = __builtin_amdgcn_mfma_f32_32x32x16_bf16(b1, qr[d0], p1, 0, 0, 0); }
}
template <int VB>
__device__ __forceinline__ void pv_tile(f32x16* o, int vb0, bf16x8 pa0, bf16x8 pa1, bf16x8 pa2, bf16x8 pa3) {
#define TRRD(dst, off) asm volatile("ds_read_b64_tr_b16 %0, %1 offset:%2" : "=&v"(dst) : "v"(vb0), "i"(off) : "memory")
#define PV_D0(d0) do { s16x4 l0, l1, l2, l3, h0, h1, h2, h3; constexpr int b_ = VB * SHM_V + v_rd_off(d0, 0, 0);     \
        TRRD(l0, b_); TRRD(h0, b_ + 2048); TRRD(l1, b_ + 4096); TRRD(h1, b_ + 6144); TRRD(l2, b_ + 8192); TRRD(h2, b_ + 10240); TRRD(l3, b_ + 12288); TRRD(h3, b_ + 14336); \
        asm volatile("s_waitcnt lgkmcnt(0)" ::: "memory"); SBAR();                 \
        o[d0] = __builtin_amdgcn_mfma_f32_32x32x16_bf16(pa0, (bf16x8){l0[0], l0[1], l0[2], l0[3], h0[0], h0[1], h0[2], h0[3]}, o[d0], 0, 0, 0);   \
        o[d0] = __builtin_amdgcn_mfma_f32_32x32x16_bf16(pa1, (bf16x8){l1[0], l1[1], l1[2], l1[3], h1[0], h1[1], h1[2], h1[3]}, o[d0], 0, 0, 0);   \
        o[d0] = __builtin_amdgcn_mfma_f32_32x32x16_bf16(pa2, (bf16x8){l2[0], l2[1], l2[2], l2[3], h2[0], h2[1], h2[2], h2[3]}, o[d0], 0, 0, 0);   \
        o[d0] = __builtin_amdgcn_mfma_f32_32x32x16_bf16(pa3, (bf16x8){l3[0], l3[1], l3[2], l3[3], h3[0], h3[1], h3[2], h3[3]}, o[d0], 0, 0, 0); } while (0)
    PV_D0(0); PV_D0(1); PV_D0(2); PV_D0(3);
#undef PV_D0
#undef TRRD
}

struct BlockRef { const bf16* Q; const bf16* K; const bf16* V; const float* Bias; const bf16* GA; bf16* Y; const float* gattn; int P0; };
struct Seam { bf16x8 qr[8]; bf16x8 st_v0, st_v1, st_k0, st_k1; };
#define ROW(p, k0, rr) ((p) + (size_t)((k0) + (rr)) * LDR + sc)
#define VMW() asm volatile("s_waitcnt vmcnt(0)" ::: "memory")
#define VMWN(n) asm volatile("s_waitcnt vmcnt(%0)" :: "i"(n) : "memory")
#define SLOAD_H(Kp, Vp, k0) do { S.st_v0 = load8<bf16>(ROW(Vp, k0, sr)); S.st_v1 = load8<bf16>(ROW(Vp, k0, 32 + sr));              \
                         S.st_k0 = load8<bf16>(ROW(Kp, k0, sr)); S.st_k1 = load8<bf16>(ROW(Kp, k0, 32 + sr)); } while (0)
#define SWRITE_HK(bf) do { *(bf16x8*)(K_lds + (bf) * SHM_K + kws) = S.st_k0; *(bf16x8*)(K_lds + (bf) * SHM_K + kws + 32 * 256) = S.st_k1; } while (0)
#define SWRITE_HV(bf) do { *(bf16x8*)(V_lds + (bf) * SHM_V + vst0) = S.st_v0; *(bf16x8*)(V_lds + (bf) * SHM_V + vst1) = S.st_v1; } while (0)
#define SWRITE_H(bf) do { SWRITE_HV(bf); SWRITE_HK(bf); } while (0)
__device__ __forceinline__ void causal_prime(const BlockRef& cur, char* lds, Seam& S) {
    const int tid = threadIdx.x, wid = __builtin_amdgcn_readfirstlane(tid >> 6), lane = tid & 63, r32 = lane & 31, hi = lane >> 5;
    const int sr = tid >> 4, sc = (tid & 15) * 8, kws = KSWZ(sr, sc * 2); char* K_lds = lds + 2 * SHM_V;
#pragma unroll
    for (int d0 = 0; d0 < 8; ++d0) S.qr[d0] = load8<bf16>(cur.Q + (size_t)(wid * QBLK + r32) * LDR + d0 * 16 + hi * 8);
    SLOAD_H(cur.K, cur.V, 0);
    if (tid * 4 < cur.P0 + QB) *(f32x4*)(lds + LDS_BIAS + tid * 16) = *(const f32x4*)(cur.Bias + tid * 4);
    VMW(); SWRITE_HK(0);
    __syncthreads();
}
__device__ __forceinline__ void causal_block(const BlockRef& cur, const BlockRef& nxt, char* lds, Seam& S, int par  ) {
    int tid = threadIdx.x; asm volatile("" : "+v"(tid));
    const int wid = __builtin_amdgcn_readfirstlane(tid >> 6), lane = tid & 63, r32 = lane & 31, hi = lane >> 5;
    const int NT = (cur.P0 + QB) / KVBLK;
    const int qlo = cur.P0 + wid * QBLK, qm = qlo + r32 - 4 * hi;
    char* V_lds = lds; char* K_lds = lds + 2 * SHM_V;
    const char* bias_l = lds + LDS_BIAS + par * 8192 + hi * 16;
    float* ws = (float*)(lds + LDS_WS) + wid * 64; float* li_l = ws, * al_l = ws + 32;
    float m_reg = -1e30f, l_reg = 0; f32x16 o[4] = {};
    const int sr = tid >> 4, sc = (tid & 15) * 8, vst0 = v_st(sr, sc), vst1 = v_st(32 + sr, sc), kws = KSWZ(sr, sc * 2);
    const int vb0 = (int)(uintptr_t)V_lds + v_rd_base(lane);
    const bf16* Kh = cur.K; const bf16* Vh = cur.V;
#define RESC(a) do { if (__any((a) < 1.f)) { if (hi == 0) al_l[r32] = (a); asm volatile("s_waitcnt lgkmcnt(0)" ::: "memory");              \
                     for (int d_ = 0; d_ < 4; ++d_) for (int r = 0; r < 16; ++r) o[d_][r] *= al_l[crow(r, hi)]; } } while (0)
#define KBASE(t) ((t) * KVBLK)
#define MASKT(P0_, P1_, t) do { const int kb_ = KBASE(t); if (kb_ + KVBLK - 1 > qlo) mask_tile(P0_, P1_, qm - kb_, 0x40000000u); } while (0)
#define SEAM_K0() do { VMWN(8); SWRITE_HK(0); SBAR(); } while (0)
    f32x16 pA0, pA1, pB0, pB1; float mnA, mnB, alA, alB; bf16x8 pa0, pa1, pa2, pa3;
    SWRITE_HV(0); SBAR();
    if (NT > 1) SLOAD_H(Kh, Vh, KBASE(1));
    SBAR(); qkt<0>(pA0, pA1, K_lds, bias_l + KBASE(0) * 4, r32, hi, S.qr);
    MASKT(pA0, pA1, 0); partialSM(pA0, pA1, m_reg, mnA, alA);
    if (NT > 1) { VMW(); SWRITE_H(1); }
    __syncthreads();
#define HALF_STEP(PX0, PX1, mnX, alX, PY0, PY1, alY, t, KB, VB, SB) do {                                                      \
        SBAR(); qkt<KB>(PX0, PX1, K_lds, bias_l + KBASE(t) * 4, r32, hi, S.qr);                                               \
        finishSM(PY0, PY1, alY, l_reg, pa0, pa1, pa2, pa3); SBAR();                                                           \
        if ((t) + 1 < NT) { SLOAD_H(Kh, Vh, KBASE((t) + 1)); SBAR(); }                                                        \
        pv_tile<VB>(o, vb0, pa0, pa1, pa2, pa3); MASKT(PX0, PX1, (t)); partialSM(PX0, PX1, m_reg, mnX, alX);                  \
        __syncthreads();                                                                                                      \
        if ((t) + 1 < NT) { VMW(); SWRITE_H(SB); }                                                                            \
        RESC(alX); __syncthreads(); } while (0)
    for (int t = 1; t + 1 < NT; t += 2) {
        HALF_STEP(pB0, pB1, mnB, alB, pA0, pA1, alA, t, 1, 0, 0);
        HALF_STEP(pA0, pA1, mnA, alA, pB0, pB1, alB, t + 1, 0, 1, 1);
    }
    const bool even = (NT & 1) == 0;
    if (even) { SBAR(); qkt<1>(pB0, pB1, K_lds, bias_l + KBASE(NT - 1) * 4, r32, hi, S.qr); SBAR(); }
    __builtin_amdgcn_global_load_lds((const __attribute__((address_space(1))) unsigned*)(nxt.Bias + tid * 4), (__attribute__((address_space(3))) unsigned*)(lds + LDS_BIAS + (par ^ 1) * 8192 + wid * 1024), 16, 0, 0);
    SBAR();
    SLOAD_H(nxt.K, nxt.V, 0); SBAR();
#pragma unroll
    for (int d0 = 0; d0 < 8; ++d0) S.qr[d0] = load8<bf16>(nxt.Q + (size_t)(wid * QBLK + r32) * LDR + d0 * 16 + hi * 8);
    SBAR();
    finishSM(pA0, pA1, alA, l_reg, pa0, pa1, pa2, pa3); SBAR();
    pv_tile<0>(o, vb0, pa0, pa1, pa2, pa3);
    if (even) { MASKT(pB0, pB1, NT - 1); partialSM(pB0, pB1, m_reg, mnB, alB); __syncthreads(); RESC(alB);
        finishSM(pB0, pB1, alB, l_reg, pa0, pa1, pa2, pa3); SBAR(); pv_tile<1>(o, vb0, pa0, pa1, pa2, pa3); }
    SBAR(); SEAM_K0();
    if (hi == 0) li_l[r32] = l_reg; asm volatile("s_waitcnt lgkmcnt(0)" ::: "memory");
    float rs[16];
#pragma unroll
    for (int r = 0; r < 16; ++r) { const float rl = __builtin_amdgcn_rcpf(li_l[crow(r, hi)]); float s = 0.f;
#pragma unroll
        for (int d0 = 0; d0 < 4; ++d0) { o[d0][r] *= rl; s = fmaf(o[d0][r], o[d0][r], s); }
        s += __shfl_xor(s, 1); s += __shfl_xor(s, 2); s += __shfl_xor(s, 4); s += __shfl_xor(s, 8); s += __shfl_xor(s, 16);
        rs[r] = __builtin_amdgcn_rsqf(s * (1.0f / 128.0f) + 1e-6f); }
    float gw[4];
#pragma unroll
    for (int d0 = 0; d0 < 4; ++d0) gw[d0] = cur.gattn[d0 * 32 + r32];
#pragma unroll
    for (int r = 0; r < 16; ++r) { const int orow = wid * QBLK + crow(r, hi);
#pragma unroll
        for (int d0 = 0; d0 < 4; ++d0) { const float ga = __uint_as_float((unsigned)(*(const unsigned short*)(cur.GA + (size_t)orow * LDR + d0 * 32 + r32)) << 16);
            const float v = o[d0][r] * rs[r] * gw[d0] * ga; const float vn = __shfl_xor(v, 1);
            if ((r32 & 1) == 0) *(unsigned*)(cur.Y + (size_t)orow * LDY + d0 * 32 + r32) = cvtpk(v, vn); }
        if (r & 1) asm volatile("" ::: "memory"); }
    __syncthreads();
#undef RESC
#undef KBASE
#undef MASKT
#undef SEAM_K0
#undef HALF_STEP
}
#undef ROW
#undef VMW
#undef VMWN
#undef SLOAD_H
#undef SWRITE_HK
#undef SWRITE_HV
#undef SWRITE_H

struct SwaItem { int bh, qb0, qb1; };
__device__ __forceinline__ SwaItem swa_decode(int L, int nbh, int nqb, int nx) {
    SwaItem it; int x;
    { const int xcd = L & 7, k = L >> 3, gi = k / nx, r = k - gi * nx; it.bh = gi * 8 + xcd; x = r; }
    it.qb0 = x; it.qb1 = nqb - 1 - x;
    return it;
}
struct PTensors { const bf16* Q; const bf16* K; const bf16* V; const float* Bias; const bf16* GA; bf16* Y; const float* gattn; };
__device__ __forceinline__ BlockRef swa_ref(const SwaItem& it, int pass, const PTensors& T) {
    const int qb = pass ? it.qb1 : it.qb0, b = it.bh >> 3, h = it.bh & 7; const size_t row0 = (size_t)b * 2048 + (size_t)qb * QB;
    BlockRef r; r.Q = T.Q + row0 * LDR + h * D; r.K = T.K + (size_t)b * 2048 * LDR + h * D; r.V = T.V + (size_t)b * 2048 * LDR + h * D;
    r.Bias = T.Bias + (size_t)it.bh * 2048; r.GA = T.GA + row0 * LDR + h * D; r.Y = T.Y + row0 * LDY + h * D; r.gattn = T.gattn + h * D; r.P0 = qb * QB;
    return r;
}
__device__ __forceinline__ void attn_prompt_phase(char* lds, const PTensors& T, int wg, int nwg) {
    constexpr int nqb = 8, nx = 4, nbh = 128, total = nx * nbh;
    int L = wg; if (L >= total) return;
    SwaItem it = swa_decode(L, nbh, nqb, nx); int pass = 0;
    BlockRef cur = swa_ref(it, 0, T);
    Seam S;
    causal_prime(cur, lds, S);
    int par = 0;
    for (;;) {
        const bool more_pass = pass == 0 && it.qb1 != it.qb0, more_item = L + nwg < total, last = !more_pass && !more_item;
        SwaItem itn = it; int passn = pass + 1, Ln = L;
        if (!more_pass) { passn = 0; Ln = more_item ? L + nwg : L; itn = swa_decode(Ln, nbh, nqb, nx); }
        const BlockRef nxt = last ? cur : swa_ref(itn, passn, T);
        causal_block(cur, nxt, lds, S, par);
        if (last) break;
        cur = nxt; it = itn; pass = passn; L = Ln; par ^= 1;
    }
}
}

namespace sa {
using namespace pa;
constexpr int SA_BIAS = 131072, SA_WS = SA_BIAS + 4160 * 4, SA_M = SA_WS + 2048, SA_L = SA_M + 1024, SA_WT = SA_L + 1024, LDS_BYTES = SA_WT + 64;
constexpr float SQRTD = 11.313708498984761f, C2 = 1.4426950408889634f * SCALE;
struct STensors { const bf16* Q; const bf16* Kn; const bf16* Vn; const float* ck; const float* cv; const float* clogf; const float* logf_s; const bf16* GA; bf16* Y; const float* gattn; };

__device__ __forceinline__ void sm_step(f32x16& p, float& m_reg, float& l_reg, float& alpha, bf16x8& pa0, bf16x8& pa1) {
    float pmax = p[0];
#pragma unroll
    for (int r = 1; r < 16; ++r) pmax = fmaxf(pmax, p[r]);
    { auto rr = __builtin_amdgcn_permlane32_swap(__float_as_uint(pmax), __float_as_uint(pmax), false, false);
      pmax = fmaxf(__uint_as_float(rr[0]), __uint_as_float(rr[1])); }
    float mn;
    if (__builtin_expect(__all((pmax - m_reg) * SCALE <= THR), 1)) { mn = m_reg; alpha = 1.f; }
    else { mn = fmaxf(m_reg, pmax); alpha = __builtin_amdgcn_exp2f((m_reg - mn) * C2); m_reg = mn; }
    const float mnL = -mn * C2;
    float ps = 0.f;
#pragma unroll
    for (int r = 0; r < 16; ++r) { p[r] = __builtin_amdgcn_exp2f(fmaf(p[r], C2, mnL)); ps += p[r]; }
    { auto rr = __builtin_amdgcn_permlane32_swap(__float_as_uint(ps), __float_as_uint(ps), false, false);
      ps = __uint_as_float(rr[0]) + __uint_as_float(rr[1]); }
    l_reg = l_reg * alpha + ps;
#define PK4(P, B_, OUT) do { unsigned a0 = cvtpk(P[B_+0], P[B_+1]), a1 = cvtpk(P[B_+2], P[B_+3]);                          \
        unsigned b0 = cvtpk(P[B_+4], P[B_+5]), b1 = cvtpk(P[B_+6], P[B_+7]);                                             \
        auto r0 = __builtin_amdgcn_permlane32_swap(a0, b0, false, false); auto r1 = __builtin_amdgcn_permlane32_swap(a1, b1, false, false); \
        u32x4 w = {r0[0], r1[0], r0[1], r1[1]}; OUT = *reinterpret_cast<bf16x8*>(&w); } while (0)
    PK4(p, 0, pa0); PK4(p, 8, pa1);
#undef PK4
}

__device__ __forceinline__ void sample_unit(char* lds, int b, int h, const STensors& T) {
    const int tid = threadIdx.x, wid = __builtin_amdgcn_readfirstlane(tid >> 6); int lane = tid & 63; asm volatile("" : "+v"(lane));
    const int r32 = lane & 31, hi = lane >> 5;
    char* Kt = lds + wid * 16384; char* Vt = Kt + 8192;
    float* biasL = (float*)(lds + SA_BIAS);
    float* ws = (float*)(lds + SA_WS) + wid * 64; float* li_l = ws; float* al_l = ws + 32;
    float* Mx = (float*)(lds + SA_M); float* Lx = (float*)(lds + SA_L); float* wt = (float*)(lds + SA_WT);
    {
        const float* lf = T.clogf + ((size_t)b * 4096 + 512 * wid + 8 * lane) * 8 + h;
        float v[8], e[8];
#pragma unroll
        for (int k = 0; k < 8; ++k) v[k] = lf[k * 8];
        float run = 0.f;
#pragma unroll
        for (int k = 7; k >= 0; --k) { e[k] = run; run += v[k]; }
        float incl = run;
#pragma unroll
        for (int off = 1; off < 64; off <<= 1) { const float t = __shfl_down(incl, off); if (lane + off < 64) incl += t; }
        const float excl = incl - run;
        if (lane == 0) wt[wid] = incl;
        float nv = 0.f;
        if (wid == 0) { if (lane < 32) nv = T.logf_s[((size_t)b * 32 + lane) * 8 + h];
#pragma unroll
            for (int off = 1; off < 32; off <<= 1) { const float t = __shfl_up(nv, off); if (lane >= off) nv += t; } }
        __syncthreads();
        float X = 0.f;
        for (int w2 = wid + 1; w2 < 8; ++w2) X += wt[w2];
#pragma unroll
        for (int k = 0; k < 8; ++k) biasL[512 * wid + 8 * lane + k] = (e[k] + excl + X) * SQRTD;
        if (wid == 0 && lane < 32) biasL[4096 + lane] = -nv * SQRTD;
    }
    bf16x8 qr[8];
    { const bf16* qp = T.Q + ((size_t)b * 32 + r32) * 1024 + h * 128 + hi * 8;
#pragma unroll
      for (int d0 = 0; d0 < 8; ++d0) qr[d0] = load8<bf16>(qp + d0 * 16); }
    __syncthreads();
    float m_reg = -1e30f, l_reg = 0.f; f32x16 o[4] = {};
    const int vb0 = (int)(uintptr_t)Vt + v_rd_base(lane);
    const char* ckb = (const char*)(T.ck + (((size_t)b * 4096) * 8 + h) * 128);
    const char* cvb = (const char*)(T.cv + (((size_t)b * 4096) * 8 + h) * 128);
    const unsigned lofs = (unsigned)(hi * 4096 + r32 * 16);
    char* const kwb0 = Kt + KSWZ(0 + hi, r32 * 8); char* const kwb1 = Kt + KSWZ(2 + hi, r32 * 8); char* const kwb2 = Kt + KSWZ(4 + hi, r32 * 8); char* const kwb3 = Kt + KSWZ(6 + hi, r32 * 8);
    char* const vwb = Vt + ((r32 * 4) >> 5) * 512 + hi * 64 + ((r32 * 4) & 31) * 2;
    f32x4 stg[16];
#define SA_ISSUE(src, kb) do { const char* s_ = (src) + (size_t)(kb) * 4096; _Pragma("unroll") for (int i = 0; i < 16; ++i) stg[i] = *(const f32x4*)(s_ + (size_t)i * 8192 + lofs); } while (0)
#define SA_WRITE_K() do { _Pragma("unroll") for (int i = 0; i < 16; ++i) { uint2 w_; w_.x = cvtpk(stg[i][0], stg[i][1]); w_.y = cvtpk(stg[i][2], stg[i][3]); \
        char* kb_ = (i & 3) == 0 ? kwb0 : ((i & 3) == 1 ? kwb1 : ((i & 3) == 2 ? kwb2 : kwb3)); *(uint2*)(kb_ + (i >> 2) * 2048) = w_; } } while (0)
#define SA_WRITE_V() do { _Pragma("unroll") for (int i = 0; i < 16; ++i) { uint2 w_; w_.x = cvtpk(stg[i][0], stg[i][1]); w_.y = cvtpk(stg[i][2], stg[i][3]); \
        *(uint2*)(vwb + (i & 1) * 128 + ((i >> 1) & 1) * 2048 + ((i >> 2) & 1) * 256 + ((i >> 3) & 1) * 4096) = w_; } } while (0)
#define SA_VMW() asm volatile("s_waitcnt vmcnt(0)" ::: "memory")
#define SA_LGW() asm volatile("s_waitcnt lgkmcnt(0)" ::: "memory")
#define SA_QKT(p, kb) do { const char* bt_ = (const char*)(biasL + (kb) + 4 * hi); \
        { const f32x4 b0 = *(const f32x4*)(bt_), b1 = *(const f32x4*)(bt_ + 32), b2 = *(const f32x4*)(bt_ + 64), b3 = *(const f32x4*)(bt_ + 96); \
          p = (f32x16){b0[0], b0[1], b0[2], b0[3], b1[0], b1[1], b1[2], b1[3], b2[0], b2[1], b2[2], b2[3], b3[0], b3[1], b3[2], b3[3]}; } \
        _Pragma("unroll") for (int d0 = 0; d0 < 8; ++d0) { const bf16x8 kf = *(const bf16x8*)(Kt + KSWZ(r32, ((d0 & 3) * 16 + hi * 8) * 2) + (d0 >> 2) * 128); \
            p = __builtin_amdgcn_mfma_f32_32x32x16_bf16(kf, qr[d0], p, 0, 0, 0); } } while (0)
#define SA_RESC(a) do { if (__any((a) < 1.f)) { if (hi == 0) al_l[r32] = (a); SA_LGW();              \
        _Pragma("unroll") for (int d_ = 0; d_ < 4; ++d_) _Pragma("unroll") for (int r = 0; r < 16; ++r) o[d_][r] *= al_l[crow(r, hi)]; } } while (0)
#define SA_TRRD(dst, off) asm volatile("ds_read_b64_tr_b16 %0, %1 offset:%2" : "=&v"(dst) : "v"(vb0), "i"(off) : "memory")
#define SA_PV() do { _Pragma("unroll") for (int d0 = 0; d0 < 4; ++d0) { s16x4 l0, h0, l1, h1; \
        if (d0 == 0) { SA_TRRD(l0, 0); SA_TRRD(h0, 2048); SA_TRRD(l1, 4096); SA_TRRD(h1, 6144); } \
        else if (d0 == 1) { SA_TRRD(l0, 512); SA_TRRD(h0, 2560); SA_TRRD(l1, 4608); SA_TRRD(h1, 6656); } \
        else if (d0 == 2) { SA_TRRD(l0, 1024); SA_TRRD(h0, 3072); SA_TRRD(l1, 5120); SA_TRRD(h1, 7168); } \
        else { SA_TRRD(l0, 1536); SA_TRRD(h0, 3584); SA_TRRD(l1, 5632); SA_TRRD(h1, 7680); } \
        SA_LGW(); SBAR(); \
        o[d0] = __builtin_amdgcn_mfma_f32_32x32x16_bf16(pa0, (bf16x8){l0[0], l0[1], l0[2], l0[3], h0[0], h0[1], h0[2], h0[3]}, o[d0], 0, 0, 0); \
        o[d0] = __builtin_amdgcn_mfma_f32_32x32x16_bf16(pa1, (bf16x8){l1[0], l1[1], l1[2], l1[3], h1[0], h1[1], h1[2], h1[3]}, o[d0], 0, 0, 0); } } while (0)
    const int kw0 = 512 * wid;
    SA_ISSUE(ckb, kw0);
#pragma unroll 1
    for (int i = 0; i < 16; ++i) {
        const int kb = kw0 + 32 * i;
        f32x16 p; float alpha; bf16x8 pa0, pa1;
        SA_VMW(); SA_WRITE_K(); SBAR();
        SA_ISSUE(cvb, kb); SBAR();
        SA_LGW(); SA_QKT(p, kb);
        sm_step(p, m_reg, l_reg, alpha, pa0, pa1);
        SA_VMW(); SA_WRITE_V(); SBAR();
        if (i + 1 < 16) SA_ISSUE(ckb, kb + 32);
        SBAR();
        SA_RESC(alpha);
        SA_LGW(); SA_PV();
    }
    if (wid == 0) {
        const bf16* kn = T.Kn + ((size_t)b * 32 + (lane >> 4)) * 1024 + h * 128 + (lane & 15) * 8;
        const bf16* vn = T.Vn + ((size_t)b * 32 + (lane >> 4)) * 1024 + h * 128 + (lane & 15) * 8;
        bf16x8 kk[8], vv[8];
#pragma unroll
        for (int i = 0; i < 8; ++i) { kk[i] = load8<bf16>(kn + (size_t)i * 4096); vv[i] = load8<bf16>(vn + (size_t)i * 4096); }
#pragma unroll
        for (int i = 0; i < 8; ++i) { const int row = 4 * i + (lane >> 4); *(bf16x8*)(Kt + KSWZ(row, (lane & 15) * 16)) = kk[i]; *(bf16x8*)(Vt + v_st(row, (lane & 15) * 8)) = vv[i]; }
        f32x16 p; float alpha; bf16x8 pa0, pa1;
        SA_LGW(); SA_QKT(p, 4096);
        { const float NEG = -__builtin_inff();
#pragma unroll
          for (int r = 0; r < 16; ++r) if (crow(r, hi) > r32) p[r] = NEG; }
        sm_step(p, m_reg, l_reg, alpha, pa0, pa1);
        SA_RESC(alpha);
        SA_LGW(); SA_PV();
    }
    if (hi == 0) Mx[wid * 32 + r32] = m_reg;
    __syncthreads();
    { float ms = Mx[r32];
#pragma unroll
      for (int w2 = 1; w2 < 8; ++w2) ms = fmaxf(ms, Mx[w2 * 32 + r32]);
      const float f = __builtin_amdgcn_exp2f((m_reg - ms) * C2);
      l_reg *= f;
      if (hi == 0) { al_l[r32] = f; Lx[wid * 32 + r32] = l_reg; }
      SA_LGW();
#pragma unroll
      for (int d_ = 0; d_ < 4; ++d_)
#pragma unroll
          for (int r = 0; r < 16; ++r) o[d_][r] *= al_l[crow(r, hi)]; }
#define SA_OWR(slot) do { char* sp_ = lds + (slot) * 16384 + lane * 16; _Pragma("unroll") for (int d_ = 0; d_ < 4; ++d_) _Pragma("unroll") for (int g = 0; g < 4; ++g) \
        *(f32x4*)(sp_ + (d_ * 4 + g) * 1024) = (f32x4){o[d_][4 * g], o[d_][4 * g + 1], o[d_][4 * g + 2], o[d_][4 * g + 3]}; } while (0)
#define SA_OAD(slot) do { const char* sp_ = lds + (slot) * 16384 + lane * 16; _Pragma("unroll") for (int d_ = 0; d_ < 4; ++d_) _Pragma("unroll") for (int g = 0; g < 4; ++g) { \
        const f32x4 t_ = *(const f32x4*)(sp_ + (d_ * 4 + g) * 1024); o[d_][4 * g] += t_[0]; o[d_][4 * g + 1] += t_[1]; o[d_][4 * g + 2] += t_[2]; o[d_][4 * g + 3] += t_[3]; } } while (0)
    if (wid >= 4) SA_OWR(wid - 4);
    __syncthreads();
    if (wid < 4) SA_OAD(wid);
    __syncthreads();
    if (wid == 2 || wid == 3) SA_OWR(wid - 2);
    __syncthreads();
    if (wid < 2) SA_OAD(wid);
    __syncthreads();
    if (wid == 1) SA_OWR(0);
    __syncthreads();
    if (wid == 0) {
        SA_OAD(0);
        int r32 = lane & 31, hi = lane >> 5; asm volatile("" : "+v"(r32), "+v"(hi));
        float lt = Lx[r32];
#pragma unroll
        for (int w2 = 1; w2 < 8; ++w2) lt += Lx[w2 * 32 + r32];
        if (hi == 0) li_l[r32] = lt;
        SA_LGW();
        float rs[16];
#pragma unroll
        for (int r = 0; r < 16; ++r) { const float rl = __builtin_amdgcn_rcpf(li_l[crow(r, hi)]); float s = 0.f;
#pragma unroll
            for (int d0 = 0; d0 < 4; ++d0) { o[d0][r] *= rl; s = fmaf(o[d0][r], o[d0][r], s); }
            s += __shfl_xor(s, 1); s += __shfl_xor(s, 2); s += __shfl_xor(s, 4); s += __shfl_xor(s, 8); s += __shfl_xor(s, 16);
            rs[r] = __builtin_amdgcn_rsqf(s * (1.0f / 128.0f) + 1e-6f); }
        float gw[4];
#pragma unroll
        for (int d0 = 0; d0 < 4; ++d0) gw[d0] = T.gattn[h * 128 + d0 * 32 + r32];
        const bf16* gap = T.GA + (size_t)b * 32 * 1024 + h * 128; bf16* yp = T.Y + (size_t)b * 32 * 2048 + h * 128;
#pragma unroll
        for (int r = 0; r < 16; ++r) { const int orow = crow(r, hi);
#pragma unroll
            for (int d0 = 0; d0 < 4; ++d0) { const float ga = __uint_as_float((unsigned)(*(const unsigned short*)(gap + (size_t)orow * 1024 + d0 * 32 + r32)) << 16);
                const float v = o[d0][r] * rs[r] * gw[d0] * ga; const float vn = __shfl_xor(v, 1);
                if ((r32 & 1) == 0) *(unsigned*)(yp + (size_t)orow * 2048 + d0 * 32 + r32) = cvtpk(v, vn); } }
    }
    __syncthreads();
#undef SA_ISSUE
#undef SA_WRITE_K
#undef SA_WRITE_V
#undef SA_VMW
#undef SA_LGW
#undef SA_QKT
#undef SA_RESC
#undef SA_TRRD
#undef SA_PV
#undef SA_OWR
#undef SA_OAD
}
}

namespace lru {
using namespace pa;
constexpr int WP = 272;
constexpr int L_WR = 0, L_WI = 128 * WP, L_CW = 2 * 128 * WP, L_CST = L_CW + 5 * 128 * 4, L_XA = L_CST + 4 * 128 * 4, L_XU = L_XA + 2 * 8 * 32 * 4, L_CAR = L_XU + 2 * 8 * 32 * 4, LDS_BYTES = L_CAR + 2 * 128 * 4;
struct LTensors { const bf16* XL; const bf16* GL; bf16* Y; const bf16* WrT; const bf16* WiT; const float* conv_w; const float* conv_b; const float* b_r; const float* b_i; const float* lam; const float* g_lru;
                  const float* state_h; const float* state_conv; float* h_p; float* h_s; };

__device__ __forceinline__ void load_weights(char* lds, const LTensors& T, int n) {
    int tid = threadIdx.x; asm volatile("" : "+v"(tid));
#pragma unroll
    for (int i = 0; i < 4; ++i) { const int ch = tid + 512 * i, row = ch >> 4, c16 = ch & 15;
        *(u32x4*)(lds + L_WR + row * WP + c16 * 16) = *(const u32x4*)((const char*)(T.WrT + (size_t)n * 16384) + row * 256 + c16 * 16);
        *(u32x4*)(lds + L_WI + row * WP + c16 * 16) = *(const u32x4*)((const char*)(T.WiT + (size_t)n * 16384) + row * 256 + c16 * 16); }
    for (int i = tid; i < 5 * 128; i += 512) { const int d = i >> 7, c = i & 127; ((float*)(lds + L_CW))[i] = (d < 4) ? T.conv_w[d * 1024 + n * 128 + c] : T.conv_b[n * 128 + c]; }
    if (tid < 128) { const int c = n * 128 + tid; float* cst = (float*)(lds + L_CST);
        cst[tid] = T.b_r[c]; cst[128 + tid] = T.b_i[c]; const float lam = T.lam[c]; cst[256 + tid] = 8.0f * (fmaxf(-lam, 0.f) + log1pf(expf(-fabsf(lam)))); cst[384 + tid] = T.g_lru[c]; }
    if (tid < 256) ((float*)(lds + L_CAR))[tid] = 0.f;
}
template <bool SAMPLE>
__device__ __forceinline__ void tile_afrags(const char* lds, const bf16* xl, int t0, const float* hist, bf16x8 (&af)[8], int r32, int hi) {
    const float* cw = (const float*)(lds + L_CW);
#pragma unroll
    for (int ks = 0; ks < 8; ++ks) { const int c8 = ks * 16 + hi * 8;
        f32x4 x0 = *(const f32x4*)(cw + 4 * 128 + c8), x1 = *(const f32x4*)(cw + 4 * 128 + c8 + 4);
#pragma unroll
        for (int d = 0; d < 4; ++d) { const int tt = r32 - 3 + d; f32x4 v0 = {0.f, 0.f, 0.f, 0.f}, v1 = {0.f, 0.f, 0.f, 0.f};
            if (t0 + tt >= 0) { const bf16x8 raw = *(const bf16x8*)(xl + (ptrdiff_t)tt * 1024 + c8);
                v0 = (f32x4){__uint_as_float((unsigned)(unsigned short)raw[0] << 16), __uint_as_float((unsigned)(unsigned short)raw[1] << 16), __uint_as_float((unsigned)(unsigned short)raw[2] << 16), __uint_as_float((unsigned)(unsigned short)raw[3] << 16)};
                v1 = (f32x4){__uint_as_float((unsigned)(unsigned short)raw[4] << 16), __uint_as_float((unsigned)(unsigned short)raw[5] << 16), __uint_as_float((unsigned)(unsigned short)raw[6] << 16), __uint_as_float((unsigned)(unsigned short)raw[7] << 16)}; }
            else if (SAMPLE) { const float* hp = hist + (size_t)(tt + 3) * 1024 + c8; v0 = *(const f32x4*)hp; v1 = *(const f32x4*)(hp + 4); }
            const f32x4 w0 = *(const f32x4*)(cw + d * 128 + c8), w1 = *(const f32x4*)(cw + d * 128 + c8 + 4);
            x0 += w0 * v0; x1 += w1 * v1; }
        af[ks] = pack8(x0, x1);
        asm volatile("" ::: "memory"); }
}
__device__ __forceinline__ void cb_maps(const char* lds, const bf16x8 (&af)[8], int cb, bool first0, f32x16& PA, f32x16& PU, float& tA, float& tU, int r32, int hi) {
    f32x16 ar = {}, ai = {}, ax = {};
    const char* wp = lds + (cb * 32 + r32) * WP + hi * 16;
#pragma unroll
    for (int ks = 0; ks < 8; ++ks) {
        const bf16x8 br = *(const bf16x8*)(wp + L_WR + ks * 32), bi = *(const bf16x8*)(wp + L_WI + ks * 32);
        ar = __builtin_amdgcn_mfma_f32_32x32x16_bf16(af[ks], br, ar, 0, 0, 0);
        ai = __builtin_amdgcn_mfma_f32_32x32x16_bf16(af[ks], bi, ai, 0, 0, 0);
        if ((ks & 1) == 1) asm volatile("" ::: "memory"); }
    {
        const int j = r32 & 7; const unsigned one = (j & 1) ? 0x3F800000u : 0x00003F80u; const bool hm = (hi == ((r32 >> 3) & 1));
        const bool c0 = hm && ((r32 >> 4) == 0), c1 = hm && ((r32 >> 4) == 1);
        u32x4 f0, f1;
        f0.x = (c0 && (j >> 1) == 0) ? one : 0u; f0.y = (c0 && (j >> 1) == 1) ? one : 0u; f0.z = (c0 && (j >> 1) == 2) ? one : 0u; f0.w = (c0 && (j >> 1) == 3) ? one : 0u;
        f1.x = (c1 && (j >> 1) == 0) ? one : 0u; f1.y = (c1 && (j >> 1) == 1) ? one : 0u; f1.z = (c1 && (j >> 1) == 2) ? one : 0u; f1.w = (c1 && (j >> 1) == 3) ? one : 0u;
        ax = __builtin_amdgcn_mfma_f32_32x32x16_bf16(af[2 * cb], *reinterpret_cast<bf16x8*>(&f0), ax, 0, 0, 0);
        ax = __builtin_amdgcn_mfma_f32_32x32x16_bf16(af[2 * cb + 1], *reinterpret_cast<bf16x8*>(&f1), ax, 0, 0, 0); }
    const float* cst = (const float*)(lds + L_CST) + cb * 32 + r32;
    const float cbr = cst[0], cbi = cst[128], csp = cst[256];
    const bool first = first0 && (hi == 0);
#pragma unroll
    for (int r = 0; r < 16; ++r) {
        const float rg = __builtin_amdgcn_rcpf(1.0f + __builtin_amdgcn_exp2f(-1.4426950408889634f * (ar[r] + cbr)));
        const float ig = __builtin_amdgcn_rcpf(1.0f + __builtin_amdgcn_exp2f(-1.4426950408889634f * (ai[r] + cbi)));
        const float av = __builtin_amdgcn_exp2f(-1.4426950408889634f * csp * rg);
        float mult = __builtin_amdgcn_sqrtf(fmaxf(fmaf(-av, av, 1.0f), 0.f));
        if (r == 0 && first) mult = 1.0f;
        ar[r] = av; ai[r] = mult * ig * ax[r]; }
    float Ag[4], Ug[4];
#pragma unroll
    for (int gl = 0; gl < 4; ++gl) { const int r0 = 4 * gl;
        float pa = ar[r0], pu = ai[r0];
#pragma unroll
        for (int k = 1; k < 4; ++k) { pu = fmaf(ar[r0 + k], pu, ai[r0 + k]); pa = ar[r0 + k] * pa; ar[r0 + k] = pa; ai[r0 + k] = pu; }
        Ag[gl] = pa; Ug[gl] = pu; }
    float GA = 1.0f, GU = 0.f;
#pragma unroll
    for (int gl = 0; gl < 4; ++gl) { const int r0 = 4 * gl;
        const float oA = __shfl_xor(Ag[gl], 32), oU = __shfl_xor(Ug[gl], 32);
        const float sA0 = hi ? oA : Ag[gl], sU0 = hi ? oU : Ug[gl], sA1 = hi ? Ag[gl] : oA, sU1 = hi ? Ug[gl] : oU;
        const float GA1 = sA0 * GA, GU1 = fmaf(sA0, GU, sU0);
        const float mA = hi ? GA1 : GA, mU = hi ? GU1 : GU;
#pragma unroll
        for (int k = 0; k < 4; ++k) { PU[r0 + k] = fmaf(ar[r0 + k], mU, ai[r0 + k]); PA[r0 + k] = ar[r0 + k] * mA; }
        GA = sA1 * GA1; GU = fmaf(sA1, GU1, sU1); }
    tA = GA; tU = GU;
}
__device__ __forceinline__ void tile_out(const char* lds, f32x16 (&H)[4], const bf16* gl, bf16* y, int r32, int hi) {
    const float* cst = (const float*)(lds + L_CST) + 384 + r32;
    const float cg0 = cst[0], cg1 = cst[32], cg2 = cst[64], cg3 = cst[96];
#pragma unroll
    for (int r = 0; r < 16; ++r) { float s = 0.f;
#pragma unroll
        for (int cb = 0; cb < 4; ++cb) s = fmaf(H[cb][r], H[cb][r], s);
        s += __shfl_xor(s, 1); s += __shfl_xor(s, 2); s += __shfl_xor(s, 4); s += __shfl_xor(s, 8); s += __shfl_xor(s, 16);
        const float rs = __builtin_amdgcn_rsqf(s * (1.0f / 128.0f) + 1e-6f); const int tt = crow(r, hi);
#pragma unroll
        for (int cb = 0; cb < 4; ++cb) { const float g = __uint_as_float((unsigned)(*(const unsigned short*)(gl + (size_t)tt * 1024 + cb * 32 + r32)) << 16);
            const float v = H[cb][r] * rs * (cb == 0 ? cg0 : (cb == 1 ? cg1 : (cb == 2 ? cg2 : cg3))) * g; const float vn = __shfl_xor(v, 1);
            if ((r32 & 1) == 0) *(unsigned*)(y + (size_t)tt * 2048 + cb * 32 + r32) = cvtpk(v, vn); } }
}
__device__ __forceinline__ void prompt_unit(char* lds, const LTensors& T, int b, int n) {
    const int tid = threadIdx.x, wid = __builtin_amdgcn_readfirstlane(tid >> 6); const int lane0 = tid & 63;
    load_weights(lds, T, n);
    __syncthreads();
    float* XA = (float*)(lds + L_XA); float* XU = (float*)(lds + L_XU); float* CAR = (float*)(lds + L_CAR);
#pragma unroll 1
    for (int ch = 0; ch < 8; ++ch) {
        int lane = lane0; asm volatile("" : "+v"(lane)); const int r32 = lane & 31, hi = lane >> 5;
        const int t0 = ch * 256 + wid * 32; const size_t row = (size_t)b * 2048 + t0;
        bf16x8 af[8];
        tile_afrags<false>(lds, T.XL + row * 1024 + n * 128, t0, nullptr, af, r32, hi);
        f32x16 H[4];
#pragma unroll
        for (int cb = 0; cb < 4; ++cb) { const int par = cb & 1, c = cb * 32 + r32;
            f32x16 PA, PU; float tA, tU;
            cb_maps(lds, af, cb, t0 == 0, PA, PU, tA, tU, r32, hi);
            if (hi == 0) { XA[(par * 8 + wid) * 32 + r32] = tA; XU[(par * 8 + wid) * 32 + r32] = tU; }
            __syncthreads();
            float hin = CAR[(ch & 1) * 128 + c];
            for (int w2 = 0; w2 < wid; ++w2) hin = fmaf(XA[(par * 8 + w2) * 32 + r32], hin, XU[(par * 8 + w2) * 32 + r32]);
#pragma unroll
            for (int r = 0; r < 16; ++r) H[cb][r] = fmaf(PA[r], hin, PU[r]);
            if (wid == 7 && hi == 1) { CAR[((ch + 1) & 1) * 128 + c] = H[cb][15]; if (ch == 7) T.h_p[(size_t)b * 1024 + n * 128 + c] = H[cb][15]; } }
        { int r32v = r32, hiv = hi; asm volatile("" : "+v"(r32v), "+v"(hiv)); tile_out(lds, H, T.GL + row * 1024 + n * 128, T.Y + row * 2048 + 1024 + n * 128, r32v, hiv); }
    }
    __syncthreads();
}
__device__ __forceinline__ void sample_unit(char* lds, const LTensors& T, int n) {
    const int tid = threadIdx.x, wid = __builtin_amdgcn_readfirstlane(tid >> 6); const int lane0 = tid & 63;
    load_weights(lds, T, n);
    __syncthreads();
#pragma unroll 1
    for (int bi = 0; bi < 4; ++bi) { const int b = wid + 8 * bi;
        int lane = lane0; asm volatile("" : "+v"(lane)); const int r32 = lane & 31, hi = lane >> 5; const size_t row = 32768 + (size_t)b * 32;
        bf16x8 af[8];
        tile_afrags<true>(lds, T.XL + row * 1024 + n * 128, 0, T.state_conv + (size_t)b * 3 * 1024 + n * 128, af, r32, hi);
        f32x16 H[4];
#pragma unroll
        for (int cb = 0; cb < 4; ++cb) { const int c = n * 128 + cb * 32 + r32;
            f32x16 PA, PU; float tA, tU;
            cb_maps(lds, af, cb, false, PA, PU, tA, tU, r32, hi);
            const float hin = T.state_h[(size_t)b * 1024 + c];
#pragma unroll
            for (int r = 0; r < 16; ++r) H[cb][r] = fmaf(PA[r], hin, PU[r]);
            if (hi == 1) T.h_s[(size_t)b * 1024 + c] = H[cb][15]; }
        { int r32v = r32, hiv = hi; asm volatile("" : "+v"(r32v), "+v"(hiv)); tile_out(lds, H, T.GL + row * 1024 + n * 128, T.Y + row * 2048 + 1024 + n * 128, r32v, hiv); }
    }
    __syncthreads();
}
}

constexpr int NWAVES = 8;
constexpr int N_LAUNCHES = MK_N_LAUNCHES;
constexpr int PER_PHASE = 6;
constexpr int DM = 2048, SEQ = 2048, NB = 16, DB = 32, DS = 32, PAST = 4096, NH = 8, HD = 128, DA = 1024, DL = 1024;
constexpr int MP = NB * SEQ, MS = DB * DS, M = MP + MS;
constexpr int D_IN = 6152, NIN = 6144;
constexpr float LN_EPS = 1e-5f, ALPHA = 1.189207115002721f;
constexpr size_t O_YP = 0, O_YS = O_YP + (size_t)MP * DM, O_KP = O_YS + (size_t)MS * DM, O_VP = O_KP + (size_t)MP * DA, O_FP = O_VP + (size_t)MP * DA,
                 O_HP = O_FP + (size_t)MP * NH, O_CP = O_HP + (size_t)NB * DL, O_KS = O_CP + (size_t)NB * 3 * DL, O_VS = O_KS + (size_t)MS * DA, O_FS = O_VS + (size_t)MS * DA,
                 O_HS = O_FS + (size_t)MS * NH, O_CS = O_HS + (size_t)DB * DL, O_END = O_CS + (size_t)DB * 3 * DL;
static_assert(O_END == 138878976, "d_out size");
constexpr size_t MiB = 1u << 20;
constexpr size_t WS_CTL = 0, CTL_ZERO_BYTES = 1 * MiB;
constexpr size_t WS_WIN = 2 * MiB;
constexpr size_t WS_WOUT = 26 * MiB;
constexpr size_t WS_WR = 34 * MiB, WS_WI = 34 * MiB + 512 * 1024;
constexpr size_t WS_BIAS = 35 * MiB;
constexpr size_t WS_XB = 40 * MiB;
constexpr size_t ACT_BYTES = (size_t)M * 1024 * 2;
constexpr size_t WS_ACT = 172 * MiB;
constexpr size_t WS_YC = WS_ACT + 6 * ACT_BYTES;
constexpr size_t WS_END = WS_YC + (size_t)M * 2048 * 2;
static_assert(ACT_BYTES == 66 * MiB && WS_XB + (size_t)M * 2048 * 2 <= WS_ACT, "ws map");
constexpr int CW_TMO = 0, CW_CODE = 1, CW_BAR = 4096;
constexpr int PH_BYTES = 153600;
constexpr int LDSCTL_OFF = PH_BYTES, MISC_OFF = LDSCTL_OFF + 320, LDS_BYTES = 155648;
static_assert(MISC_OFF + 128 <= LDS_BYTES && sa::LDS_BYTES <= PH_BYTES && lru::LDS_BYTES <= PH_BYTES && pa::LDS_BYTES <= PH_BYTES && pg8::STAGE_BYTES <= PH_BYTES, "LDS map");

#define GAS __attribute__((address_space(1)))
#define LAS __attribute__((address_space(3)))
typedef unsigned short bf16;
typedef unsigned v4u __attribute__((ext_vector_type(4)));
typedef float f32x4 __attribute__((ext_vector_type(4)));
typedef GAS unsigned gu32;
#define RLX_AGENT __ATOMIC_RELAXED, __HIP_MEMORY_SCOPE_AGENT
#define LDS_WAIT() asm volatile("s_waitcnt lgkmcnt(0)" ::: "memory")
#define VM_WAIT() asm volatile("s_waitcnt vmcnt(0)" ::: "memory")
__device__ __forceinline__ unsigned f2bf(float f) { unsigned u = __builtin_bit_cast(unsigned, f); return (u + 0x7fffu + ((u >> 16) & 1u)) >> 16; }
__device__ __forceinline__ unsigned pk2(float lo, float hi) { return f2bf(lo) | (f2bf(hi) << 16); }

#define XB_TMO      128
#define XB_XCNT(j)  (256  + 64 * (j))
#define XB_XSUB(j)  (1280 + 64 * (j))
#define XB_XGEN(j)  (2304 + 64 * (j))
#define XB_TOP      3328
#define XB_TOPGEN   3392
#define XCD_BAR_WORDS 3456
#define XB_SPIN_CAP (1u << 18)

__device__ __forceinline__ unsigned xb_ld(unsigned* p)              { return __hip_atomic_load(p, __ATOMIC_RELAXED, __HIP_MEMORY_SCOPE_AGENT); }
__device__ __forceinline__ unsigned xb_add(unsigned* p, unsigned v) { return __hip_atomic_fetch_add(p, v, __ATOMIC_RELAXED, __HIP_MEMORY_SCOPE_AGENT); }
__device__ __forceinline__ unsigned xb_xcc_id() { return (unsigned)__builtin_amdgcn_s_getreg((3 << 11) | 20) & 0xFu; }
#define XB_SPIN(cond, bar) do { unsigned _sp = 0; while (cond) { __builtin_amdgcn_s_sleep(1); \
    if ((++_sp & 255u) == 0u) { if (xb_ld(&(bar)[XB_TMO])) break; if (_sp > XB_SPIN_CAP) { atomicAdd(&(bar)[XB_TMO], 1u); break; } } } } while (0)

struct XcdBarrier {
    unsigned* bar; unsigned x;
    volatile LAS unsigned* st;
};

__device__ __forceinline__ XcdBarrier xcd_barrier_post(unsigned* bar, volatile LAS unsigned* st) {
    XcdBarrier b; b.bar = bar; b.x = xb_xcc_id(); b.st = st;
    if (threadIdx.x == 0) (void)xb_add(&bar[XB_XCNT(b.x)], 1u);
    return b;
}
__device__ __forceinline__ void xcd_barrier_complete(unsigned* bar, unsigned x, unsigned& nloc, unsigned& nx) {
    const unsigned G = gridDim.x * gridDim.y * gridDim.z;
    unsigned sum, cnt, mine, sp = 0u;
    for (;;) {
        sum = 0u; cnt = 0u; mine = 0u;
#pragma unroll
        for (unsigned j = 0; j < 16; ++j) { const unsigned c = xb_ld(&bar[XB_XCNT(j)]); sum += c; cnt += (c > 0u) ? 1u : 0u; mine = (j == x) ? c : mine; }
        if (sum == G) break;
        __builtin_amdgcn_s_sleep(1);
        if ((++sp & 255u) == 0u) { if (xb_ld(&bar[XB_TMO])) break; if (sp > XB_SPIN_CAP) { atomicAdd(&bar[XB_TMO], 1u); break; } }
    }
    nloc = mine > 0u ? mine : 1u; nx = cnt > 0u ? cnt : 1u;
}

__device__ __forceinline__ void xcd_barrier(const XcdBarrier& b) {
    asm volatile("s_waitcnt vmcnt(0)" ::: "memory");
    __syncthreads();
    if (threadIdx.x == 0) {
        unsigned* bar = b.bar;
        __builtin_amdgcn_s_waitcnt(0);
        unsigned nloc = b.st[0], nx = b.st[1];
        if (nloc == 0u) { xcd_barrier_complete(bar, b.x, nloc, nx); b.st[0] = nloc; b.st[1] = nx; }
        const unsigned old = xb_add(&bar[XB_XSUB(b.x)], 1u);
        const unsigned gen = old / nloc;
        if (old + 1u == (gen + 1u) * nloc) {
            __builtin_amdgcn_fence(__ATOMIC_RELEASE, "agent");
            asm volatile("s_waitcnt vmcnt(0)" ::: "memory");
            const unsigned og = xb_add(&bar[XB_TOP], 1u);
            const unsigned tg = og / nx;
            if (og + 1u == (tg + 1u) * nx) xb_add(&bar[XB_TOPGEN], 1u);
            else XB_SPIN(xb_ld(&bar[XB_TOPGEN]) == tg, bar);
            __builtin_amdgcn_fence(__ATOMIC_ACQUIRE, "agent");
            xb_add(&bar[XB_XGEN(b.x)], 1u);
            asm volatile("s_waitcnt vmcnt(0)" ::: "memory");
        } else {
            XB_SPIN(xb_ld(&bar[XB_XGEN(b.x)]) == gen, bar);
            __builtin_amdgcn_fence(__ATOMIC_ACQUIRE, "agent");
            asm volatile("s_waitcnt vmcnt(0)" ::: "memory");
        }
    }
    __syncthreads();
}

__device__ __forceinline__ float wave_sum(float v) {
#pragma unroll
    for (int o = 1; o < 64; o <<= 1) v += __shfl_xor(v, o);
    return v;
}
__device__ __forceinline__ void p0_transpose_item(const float* W, int ldw, int scol, bf16* WT, int K, int drow, int k0, LAS float* scr, int lane) {
#pragma unroll 8
    for (int i = 0; i < 32; ++i) { const int kk = 2 * i + (lane >> 5); scr[kk * 33 + (lane & 31)] = W[(size_t)(k0 + kk) * ldw + scol + (lane & 31)]; }
    LDS_WAIT(); asm volatile("" ::: "memory");
    const int c = lane & 7;
#pragma unroll
    for (int j = 0; j < 4; ++j) { const int n = (lane >> 3) + 8 * j; const LAS float* s = scr + (8 * c) * 33 + n;
        v4u o; o.x = pk2(s[0 * 33], s[1 * 33]); o.y = pk2(s[2 * 33], s[3 * 33]); o.z = pk2(s[4 * 33], s[5 * 33]); o.w = pk2(s[6 * 33], s[7 * 33]);
        *(GAS v4u*)(WT + (size_t)(drow + n) * K + k0 + 8 * c) = o; }
    LDS_WAIT(); asm volatile("" ::: "memory");
}

struct Args { const float* in[21]; float* out; unsigned char* ws; int ph_lo, ph_hi; };

__global__ void __launch_bounds__(NWAVES * 64, 2) fwd_kernel(Args args) {
    extern __shared__ __attribute__((aligned(16))) unsigned char lds[];
    LAS unsigned char* ldsl = (LAS unsigned char*)lds;
    volatile LAS unsigned* MISC = (volatile LAS unsigned*)(ldsl + MISC_OFF);
    const int tid = threadIdx.x, lane = tid & 63, wave = __builtin_amdgcn_readfirstlane(tid >> 6);
    const int G = gridDim.x, bx = blockIdx.x;
    unsigned char* ws = args.ws;
    gu32* ctl = (gu32*)(ws + WS_CTL);
    float* out = args.out;
    const float* x_p = args.in[0]; const float* x_s = args.in[1];
    bf16* WinT = (bf16*)(ws + WS_WIN); bf16* WoutT = (bf16*)(ws + WS_WOUT); bf16* WrT = (bf16*)(ws + WS_WR); bf16* WiT = (bf16*)(ws + WS_WI);
    float* BIAS = (float*)(ws + WS_BIAS); bf16* XB = (bf16*)(ws + WS_XB); bf16* ACT = (bf16*)(ws + WS_ACT); bf16* YC = (bf16*)(ws + WS_YC);
    constexpr size_t ACT_EL = ACT_BYTES / 2;
    bf16* QB = ACT; bf16* KBf = ACT + ACT_EL; bf16* VBf = ACT + 2 * ACT_EL; bf16* GA = ACT + 3 * ACT_EL; bf16* XL = ACT + 4 * ACT_EL; bf16* GL = ACT + 5 * ACT_EL;

    for (int u = tid; u < (LDS_BYTES - LDSCTL_OFF) / 4; u += NWAVES * 64) ((LAS unsigned*)(ldsl + LDSCTL_OFF))[u] = 0u;
    __syncthreads();
    XcdBarrier bar; bar.bar = (unsigned*)(ctl + CW_BAR); bar.x = 0; bar.st = nullptr;
    if (N_LAUNCHES != PER_PHASE) bar = xcd_barrier_post((unsigned*)(ctl + CW_BAR), MISC + 8);
#define GRID_BAR(seam) do { if (N_LAUNCHES == PER_PHASE) { if (tid == 0) __hip_atomic_store(ctl + CW_TMO, 0xBADBA0u | (unsigned)(seam), RLX_AGENT); } else { xcd_barrier(bar); } } while (0)
    const int lo = args.ph_lo, hi_ph = args.ph_hi;
#ifndef ONLY_PHASE
#define ONLY_PHASE -1
#endif
#define IN(k) (lo <= (k) && (k) < hi_ph && (ONLY_PHASE < 0 || ONLY_PHASE == (k)))
#define BOTH(k) (IN(k) && IN((k) + 1))

    if (IN(0)) {
        const int gw = bx * NWAVES + wave, NGW = G * NWAVES;
        const float* w_in = args.in[7]; const float* w_out = args.in[18]; const float* w_r = args.in[11]; const float* w_i = args.in[13]; const float* b_f = args.in[8];
        LAS float* scr = (LAS float*)(ldsl + wave * 16384);
        constexpr int I_IN = 32 * 192, I_OUT = 32 * 64, I_R = 64, NITEMS = I_IN + I_OUT + 2 * I_R;
        for (int it = gw; it < NITEMS; it += NGW) {
            int r = it;
            if (r < I_IN) { const int kb = r / 192, nb = r % 192; p0_transpose_item(w_in, D_IN, 32 * nb + (nb >= 96 ? 8 : 0), WinT, 2048, 32 * nb, 64 * kb, scr, lane); continue; } r -= I_IN;
            if (r < I_OUT) { const int kb = r / 64, nb = r % 64; p0_transpose_item(w_out, 2048, 32 * nb, WoutT, 2048, 32 * nb, 64 * kb, scr, lane); continue; } r -= I_OUT;
            if (r < I_R) { const int n = r >> 3, kb = (r >> 2) & 1, nb = r & 3; p0_transpose_item(w_r + (size_t)n * 16384, 128, 32 * nb, WrT + (size_t)n * 16384, 128, 32 * nb, 64 * kb, scr, lane); continue; } r -= I_R;
            { const int n = r >> 3, kb = (r >> 2) & 1, nb = r & 3; p0_transpose_item(w_i + (size_t)n * 16384, 128, 32 * nb, WiT + (size_t)n * 16384, 128, 32 * nb, 64 * kb, scr, lane); }
        }
        __syncthreads();
        LAS float* wf = (LAS float*)ldsl;
#pragma unroll
        for (int i = 0; i < 4; ++i) { const int k = tid + 512 * i; const f32x4 a = *(const f32x4*)(w_in + (size_t)k * D_IN + 3072), b = *(const f32x4*)(w_in + (size_t)k * D_IN + 3076);
            wf[0 * 2048 + k] = a[0]; wf[1 * 2048 + k] = a[1]; wf[2 * 2048 + k] = a[2]; wf[3 * 2048 + k] = a[3]; wf[4 * 2048 + k] = b[0]; wf[5 * 2048 + k] = b[1]; wf[6 * 2048 + k] = b[2]; wf[7 * 2048 + k] = b[3]; }
        __syncthreads();
        const float bfl = (lane < 8) ? b_f[lane] : 0.f;
        for (int m = gw; m < M; m += NGW) {
            const float* xr = (m < MP) ? x_p + (size_t)m * DM : x_s + (size_t)(m - MP) * DM;
            f32x4 v[8];
#pragma unroll
            for (int j = 0; j < 8; ++j) v[j] = *(const f32x4*)(xr + 4 * lane + 256 * j);
            GAS unsigned long long* o8 = (GAS unsigned long long*)(XB + (size_t)m * DM) + lane;
#pragma unroll
            for (int j = 0; j < 8; ++j) o8[64 * j] = (unsigned long long)pk2(v[j][0], v[j][1]) | ((unsigned long long)pk2(v[j][2], v[j][3]) << 32);
            float acc[8];
#pragma unroll
            for (int h = 0; h < 8; ++h) { float a = 0.f;
#pragma unroll
                for (int j = 0; j < 8; ++j) { const f32x4 w = *(const LAS f32x4*)(wf + h * 2048 + 256 * j + 4 * lane); a = fmaf(v[j][0], w[0], a); a = fmaf(v[j][1], w[1], a); a = fmaf(v[j][2], w[2], a); a = fmaf(v[j][3], w[3], a); }
                acc[h] = wave_sum(a); asm volatile("" ::: "memory"); }
            float z = acc[0];
#pragma unroll
            for (int h = 1; h < 8; ++h) z = (lane == h) ? acc[h] : z;
            if (lane < 8) { z += bfl; const float lf = fminf(z, 0.f) - log1pf(expf(-fabsf(z)));
                float* fo = (m < MP) ? out + O_FP + (size_t)m * NH : out + O_FS + (size_t)(m - MP) * NH; fo[lane] = lf; }
        }
        if (BOTH(0)) GRID_BAR(0);
    }

    if (IN(1)) {
        pg8::Gemm g{XB, WinT, M, NIN, DM}; pg8::StaticOrder S; S.init(M, NIN, G, bx);
        pg8::EpiIn E{ACT, ACT_EL, out + O_KP, out + O_VP, out + O_KS, out + O_VS, out + O_CP, out + O_CS};
        pg8::gemm_phase<pg8::EpiIn, pg8::StaticOrder, true, true>(ldsl, g, S, E);
        if (BOTH(1)) GRID_BAR(1);
    }

    if (IN(2)) {
        {
            const int gwr = (G - 1 - bx) * NWAVES + wave;
            for (int bh = gwr; bh < NB * NH; bh += G * NWAVES) { const int b = bh >> 3, h = bh & 7;
                const float* lf = out + O_FP + ((size_t)b * SEQ + 32 * lane) * NH + h;
                float v[32];
#pragma unroll
                for (int k = 0; k < 32; ++k) v[k] = lf[k * NH];
#pragma unroll
                for (int k = 1; k < 32; ++k) v[k] += v[k - 1];
                float incl = v[31];
#pragma unroll
                for (int off = 1; off < 64; off <<= 1) { const float t = __shfl_up(incl, off); if (lane >= off) incl += t; }
                const float excl = incl - v[31];
                float* bo = BIAS + (size_t)bh * SEQ + 32 * lane;
#pragma unroll
                for (int k = 0; k < 32; k += 4) *(f32x4*)(bo + k) = (f32x4){-(v[k] + excl) * sa::SQRTD, -(v[k + 1] + excl) * sa::SQRTD, -(v[k + 2] + excl) * sa::SQRTD, -(v[k + 3] + excl) * sa::SQRTD};
            }
        }
        lru::LTensors LT{(const pa::bf16*)XL, (const pa::bf16*)GL, (pa::bf16*)YC, (const pa::bf16*)WrT, (const pa::bf16*)WiT, args.in[9], args.in[10], args.in[12], args.in[14], args.in[15], args.in[17],
                         args.in[5], args.in[6], out + O_HP, out + O_HS};
#if defined(NO_LS)
        for (int u = bx; u < 128; u += G) lru::prompt_unit((char*)lds, LT, u >> 3, u & 7);
#elif defined(NO_LP)
        for (int u = bx; u < 8; u += G) lru::sample_unit((char*)lds, LT, u);
#else
        for (int u = bx; u < 136; u += G) { if (u < 128) lru::prompt_unit((char*)lds, LT, u >> 3, u & 7); else lru::sample_unit((char*)lds, LT, u - 128); }
#endif
        if (BOTH(2)) GRID_BAR(2);
    }

    if (IN(3)) {
        const pa::PTensors PT{(const pa::bf16*)QB, (const pa::bf16*)KBf, (const pa::bf16*)VBf, BIAS, (const pa::bf16*)GA, (pa::bf16*)YC, args.in[16]};
#ifndef NO_PA
        pa::attn_prompt_phase((char*)lds, PT, bx, G);
#endif
        const sa::STensors ST{(const pa::bf16*)(QB + (size_t)MP * 1024), (const pa::bf16*)(KBf + (size_t)MP * 1024), (const pa::bf16*)(VBf + (size_t)MP * 1024), args.in[2], args.in[3], args.in[4],
                              out + O_FS, (const pa::bf16*)(GA + (size_t)MP * 1024), (pa::bf16*)(YC + (size_t)MP * 2048), args.in[16]};
#ifndef NO_SA
        for (int u = bx; u < DB * NH; u += G) sa::sample_unit((char*)lds, u >> 3, u & 7, ST);
#endif
        if (BOTH(3)) GRID_BAR(3);
    }

    if (IN(4)) {
        pg8::Gemm g{YC, WoutT, M, DM, DM}; pg8::StaticOrder S; S.init(M, DM, G, bx);
        pg8::EpiRes E{x_p, x_s, out + O_YP, ALPHA};
        pg8::gemm_phase<pg8::EpiRes, pg8::StaticOrder, true, true>(ldsl, g, S, E);
        if (BOTH(4)) GRID_BAR(4);
    }

    if (IN(5)) {
        const int gw = bx * NWAVES + wave, NGW = G * NWAVES;
        const float* ln_g = args.in[19]; const float* ln_b = args.in[20];
        f32x4 gv[8], bv[8];
#pragma unroll
        for (int j = 0; j < 8; ++j) { gv[j] = *(const f32x4*)(ln_g + 4 * lane + 256 * j); bv[j] = *(const f32x4*)(ln_b + 4 * lane + 256 * j); }
        for (int m = gw; m < M; m += NGW) {
            float* yr = out + O_YP + (size_t)m * DM + 4 * lane;
            f32x4 v[8]; float s = 0.f;
#pragma unroll
            for (int j = 0; j < 8; ++j) { v[j] = *(const f32x4*)(yr + 256 * j); s += (v[j][0] + v[j][1]) + (v[j][2] + v[j][3]); }
            const float mean = wave_sum(s) * (1.f / DM); float s2 = 0.f;
#pragma unroll
            for (int j = 0; j < 8; ++j) { v[j] = v[j] - mean; s2 += (v[j][0] * v[j][0] + v[j][1] * v[j][1]) + (v[j][2] * v[j][2] + v[j][3] * v[j][3]); }
            const float rstd = 1.f / sqrtf(wave_sum(s2) * (1.f / DM) + LN_EPS);
#pragma unroll
            for (int j = 0; j < 8; ++j) *(f32x4*)(yr + 256 * j) = v[j] * rstd * gv[j] + bv[j];
        }
    }
#undef IN
#undef BOTH
#undef GRID_BAR
}

extern "C" void kernel_launch(void* const* d_in, const int* in_sizes, int n_in, void* d_out, int out_size, void* d_ws, size_t ws_size, hipStream_t stream) {
    static int grid = 0;
    if (grid == 0) {
        if (n_in != 21 || (size_t)out_size != O_END || ws_size < WS_END) { fprintf(stderr, "kernel_launch: unexpected shapes: n_in %d out %d ws %zu (need >= %zu); nothing launched\n", n_in, out_size, ws_size, (size_t)WS_END); grid = -1; return; }
        int dev = 0, cus = 0, per_cu = 0;
        if (hipGetDevice(&dev) != hipSuccess || hipDeviceGetAttribute(&cus, hipDeviceAttributeMultiprocessorCount, dev) != hipSuccess) { fprintf(stderr, "kernel_launch: device query failed\n"); grid = -1; return; }
        if (hipFuncSetAttribute((const void*)fwd_kernel, hipFuncAttributeMaxDynamicSharedMemorySize, LDS_BYTES) != hipSuccess) { fprintf(stderr, "kernel_launch: hipFuncSetAttribute failed\n"); grid = -1; return; }
        if (hipOccupancyMaxActiveBlocksPerMultiprocessor(&per_cu, (const void*)fwd_kernel, NWAVES * 64, LDS_BYTES) != hipSuccess || per_cu < 1)
            fprintf(stderr, "kernel_launch: note: occupancy query reports %d workgroups per CU\n", per_cu);
        (void)hipGetLastError();
        grid = cus;
    }
    if (grid < 0) return;
    if (hipMemsetAsync((char*)d_ws + WS_CTL, 0, CTL_ZERO_BYTES, stream) != hipSuccess) { fprintf(stderr, "kernel_launch: memset failed\n"); return; }
    Args a{};
    for (int i = 0; i < 21; ++i) a.in[i] = (const float*)d_in[i];
    a.out = (float*)d_out; a.ws = (unsigned char*)d_ws;
    if (N_LAUNCHES == 1) { a.ph_lo = 0; a.ph_hi = PER_PHASE; hipLaunchKernelGGL(fwd_kernel, dim3(grid), dim3(NWAVES * 64), LDS_BYTES, stream, a); }
    else { for (int li = 0; li < PER_PHASE; ++li) { a.ph_lo = li; a.ph_hi = li + 1; hipLaunchKernelGGL(fwd_kernel, dim3(grid), dim3(NWAVES * 64), LDS_BYTES, stream, a); } }
    const hipError_t le = hipPeekAtLastError();
    if (le != hipSuccess) fprintf(stderr, "kernel_launch: launch failed: %s\n", hipGetErrorName(le));
}
```

```cpp
#include <hip/hip_runtime.h>
#include <hip/hip_bf16.h>
#include <cstdio>
#include <cstdint>

#ifndef MK_N_LAUNCHES
#define MK_N_LAUNCHES 1
#endif

namespace pg8 {
#define PG8_LAS __attribute__((address_space(3)))
typedef unsigned short bf16_t;
typedef short bf16x8 __attribute__((ext_vector_type(8)));
typedef float f32x4 __attribute__((ext_vector_type(4)));
typedef unsigned u32x4 __attribute__((ext_vector_type(4)));
constexpr int BM = 256, BK = 64, HALF = 128, HTB = HALF * BK * 2  , STAGE_BYTES = 8 * HTB, NXCD = 8, WGM = 8;

__host__ __device__ __forceinline__ int lds_byte(int r, int c) { const int st = (r >> 4) * 2 + (c >> 5), rr = r & 15, cc = c & 31, ob = rr * 64 + cc * 2; return st * 1024 + (ob ^ (((ob >> 9) & 1) << 5)); }
__host__ __device__ __forceinline__ void stage_rc(int b, int& R, int& C) { const int st = b / 1024, sb = b % 1024, swz = sb ^ (((sb >> 9) & 1) << 5); R = (st >> 1) * 16 + swz / 64; C = (st & 1) * 32 + (swz % 64) / 2; }
__host__ __device__ __forceinline__ int perm32(int rho) { const int n = rho >> 4, i = rho & 15; return 8 * (i >> 2) + 4 * n + (i & 3); }

struct Unit { int pm, pn; };
struct Gemm { const bf16_t* A; const bf16_t* Bt; int M, N, K; };

struct StaticOrder {
    int nM, nN, nwg, G, c;
    __host__ __device__ void init(int M, int N, int G_, int c_) { nM = M / BM; nN = N / BM; nwg = nM * nN; G = G_; c = c_; }
    __host__ __device__ bool next(int i, Unit& u) const {
        const long L = (long)i * G + c; if (L >= nwg) return false;
        int wgid = (int)L; { const int q = nwg / NXCD, r = nwg % NXCD, xcd = wgid % NXCD, off = wgid / NXCD; wgid = (xcd < r ? xcd * (q + 1) : r * (q + 1) + (xcd - r) * q) + off; }
        const int nig = WGM * nN, gid = wgid / nig, fm = gid * WGM, gsz = (nM - fm) < WGM ? (nM - fm) : WGM;
        u.pm = fm + ((wgid % nig) % gsz); u.pn = (wgid % nig) / gsz; return true;
    }
    __device__ __forceinline__ void a_ready(const Unit&) const {}
    __device__ __forceinline__ void done(const Unit&) const {}
};

__device__ __forceinline__ unsigned cvt_pk_bf16(float lo, float hi) { unsigned r; asm volatile("v_cvt_pk_bf16_f32 %0, %1, %2" : "=v"(r) : "v"(lo), "v"(hi)); return r; }
__device__ __forceinline__ float silu_f(float v) { return v * __builtin_amdgcn_rcpf(1.0f + __builtin_amdgcn_exp2f(-1.4426950408889634f * v)); }

struct EpiIn {
    static constexpr bool PERM = true, AFTER_DRAIN = false;
    bf16_t* act; size_t act_stride;
    float* kout_p; float* vout_p; float* kout_s; float* vout_s; float* conv_p; float* conv_s;
    __device__ __forceinline__ void operator()(const f32x4 (&acc)[2][2][4][2], const Unit& u, int wr, int wc, int fr, int fq) const {
        const int ty = u.pn >> 2, colt = (u.pn & 3) * BM;
        const int row0 = u.pm * BM + wr * 64 + fr, col0 = colt + wc * 32 + 8 * fq;
        const bool samp = u.pm >= 128; const int rofs = samp ? 32768 : 0;
        bf16_t* base = act + (size_t)ty * act_stride;
        float* fo = (ty == 1) ? (samp ? kout_s : kout_p) : ((ty == 2) ? (samp ? vout_s : vout_p) : nullptr);
        const bool do_silu = (ty == 3) || (ty == 5);
#pragma unroll
        for (int ai = 0; ai < 2; ++ai)
#pragma unroll
            for (int m = 0; m < 4; ++m) { const int row = row0 + ai * HALF + m * 16; bf16_t* rowp = base + (size_t)row * 1024 + col0;
#pragma unroll
                for (int bj = 0; bj < 2; ++bj) { f32x4 v0 = acc[ai][bj][m][0], v1 = acc[ai][bj][m][1];
                    if (fo) { float* fp = fo + (size_t)(row - rofs) * 1024 + col0 + bj * HALF; *(f32x4*)fp = v0; *(f32x4*)(fp + 4) = v1; }
                    if (ty == 4) {
                        const int rl = row - rofs; const int t = samp ? (rl & 31) : (rl & 2047); const int tl = samp ? 29 : 2045;
                        if (t >= tl) { float* cp = (samp ? conv_s + (size_t)((rl >> 5) * 3 + (t - tl)) * 1024 : conv_p + (size_t)((rl >> 11) * 3 + (t - tl)) * 1024) + col0 + bj * HALF;
                            *(f32x4*)cp = v0; *(f32x4*)(cp + 4) = v1; }
                    }
                    if (do_silu) { v0[0] = silu_f(v0[0]); v0[1] = silu_f(v0[1]); v0[2] = silu_f(v0[2]); v0[3] = silu_f(v0[3]); v1[0] = silu_f(v1[0]); v1[1] = silu_f(v1[1]); v1[2] = silu_f(v1[2]); v1[3] = silu_f(v1[3]); }
                    u32x4 w; w.x = cvt_pk_bf16(v0[0], v0[1]); w.y = cvt_pk_bf16(v0[2], v0[3]); w.z = cvt_pk_bf16(v1[0], v1[1]); w.w = cvt_pk_bf16(v1[2], v1[3]);
                    *(u32x4*)(rowp + bj * HALF) = w; } }
    }
};
struct EpiRes {
    static constexpr bool PERM = false, AFTER_DRAIN = false;
    const float* xp; const float* xs; float* y; float alpha;
    __device__ __forceinline__ void operator()(const f32x4 (&acc)[2][2][4][2], const Unit& u, int wr, int wc, int fr, int fq) const {
        const int row0 = u.pm * BM + wr * 64 + fr, col0 = u.pn * BM + wc * 32 + 4 * fq;
        const bool samp = u.pm >= 128; const float* xb = samp ? xs - (size_t)0 : xp; const int rofs = samp ? 32768 : 0;
#pragma unroll
        for (int ai = 0; ai < 2; ++ai)
#pragma unroll
            for (int m = 0; m < 4; ++m) { const int row = row0 + ai * HALF + m * 16; const float* xr = xb + (size_t)(row - rofs) * 2048 + col0; float* yr = y + (size_t)row * 2048 + col0;
#pragma unroll
                for (int bj = 0; bj < 2; ++bj)
#pragma unroll
                    for (int n = 0; n < 2; ++n) { const f32x4 xv = *(const f32x4*)(xr + bj * HALF + n * 16); *(f32x4*)(yr + bj * HALF + n * 16) = xv * alpha + acc[ai][bj][m][n]; } }
    }
};
template <class Epi, class Sched, bool ALIGN_EPI = false, bool SP2 = false>
__device__ __forceinline__ void gemm_phase(PG8_LAS unsigned char* lds, const Gemm g, const Sched& S, const Epi& E) {
    const int tid = threadIdx.x, wid = __builtin_amdgcn_readfirstlane(tid >> 6), lane = tid & 63, wr = wid >> 2, wc = wid & 3, fr = lane & 15, fq = lane >> 4;
    const int K = g.K, nt = K / BK;
    unsigned voffA[2], voffB[2];
#pragma unroll
    for (int i = 0; i < 2; ++i) { int R, C; stage_rc(tid * 16 + i * 8192, R, C); const int Rb = Epi::PERM ? ((R & ~31) + perm32(R & 31)) : R;
        voffA[i] = (unsigned)(R * K + C) * 2u; voffB[i] = (unsigned)(Rb * K + C) * 2u; }
    const size_t kstep = (size_t)(BK * 2);
    const size_t hstep = (size_t)HALF * K * 2;
    const size_t tstep = 2 * hstep;
    const unsigned ldsw = (unsigned)wid * 1024u;
    const int aoff = lds_byte(wr * 64 + fr, fq * 8), boff = lds_byte(wc * 32 + fr, fq * 8);
#define PG8_SA(b, h) (((b) * 2 + (h)) * HTB)
#define PG8_SB(b, h) ((4 + (b) * 2 + (h)) * HTB)
#define PG8_STAGE(bufoff, gbase, voff) do { _Pragma("unroll") for (int _i = 0; _i < 2; ++_i) \
        __builtin_amdgcn_global_load_lds((const unsigned*)((const char*)(gbase) + (voff)[_i]), (PG8_LAS unsigned*)(lds + (bufoff) + ldsw + _i * 8192), 16, 0, 0); } while (0)
#define PG8_LDA(dst, b, h) do { _Pragma("unroll") for (int m = 0; m < 4; ++m) _Pragma("unroll") for (int k = 0; k < 2; ++k) dst[m][k] = *(const PG8_LAS bf16x8*)(lds + PG8_SA(b, h) + aoff + m * 2048 + k * 1024); } while (0)
#define PG8_LDB(dst, b, h) do { _Pragma("unroll") for (int n = 0; n < 2; ++n) _Pragma("unroll") for (int k = 0; k < 2; ++k) dst[n][k] = *(const PG8_LAS bf16x8*)(lds + PG8_SB(b, h) + boff + n * 2048 + k * 1024); } while (0)
#define PG8_MMA(ai, bj, At, Bt) do { __builtin_amdgcn_s_setprio(1); _Pragma("unroll") for (int m = 0; m < 4; ++m) _Pragma("unroll") for (int n = 0; n < 2; ++n) _Pragma("unroll") for (int k = 0; k < 2; ++k) \
        acc[ai][bj][m][n] = __builtin_amdgcn_mfma_f32_16x16x32_bf16(Bt[n][k], At[m][k], acc[ai][bj][m][n], 0, 0, 0); __builtin_amdgcn_s_setprio(0); } while (0)
#define PG8_WAIT_V(n) asm volatile("s_waitcnt vmcnt(" #n ")" ::: "memory")
#define PG8_WAIT_L(n) asm volatile("s_waitcnt lgkmcnt(" #n ")" ::: "memory")
#define PG8_BAR __builtin_amdgcn_s_barrier()
#define PG8_SCHED __builtin_amdgcn_sched_barrier(0)
    Unit cur, nxt; int ui = 0;
    if (!S.next(0, cur)) return;
    f32x4 acc[2][2][4][2];
#pragma unroll
    for (int a = 0; a < 2; ++a)
#pragma unroll
        for (int b = 0; b < 2; ++b)
#pragma unroll
            for (int m = 0; m < 4; ++m)
#pragma unroll
                for (int n = 0; n < 2; ++n) acc[a][b][m][n] = (f32x4){0.f, 0.f, 0.f, 0.f};
    bf16x8 At[4][2], B0[2][2], B1[2][2];
    const char* cA = (const char*)g.A + (size_t)cur.pm * tstep; const char* cB = (const char*)g.Bt + (size_t)cur.pn * tstep;
    S.a_ready(cur);
    if constexpr (SP2) {
        PG8_STAGE(PG8_SB(0, 0), cB, voffB); PG8_STAGE(PG8_SB(0, 1), cB + hstep, voffB); PG8_STAGE(PG8_SA(0, 0), cA, voffA); PG8_STAGE(PG8_SA(0, 1), cA + hstep, voffA);
        if (wr == 1) PG8_BAR;
        PG8_WAIT_V(2); PG8_BAR;
        PG8_STAGE(PG8_SB(1, 0), cB + kstep, voffB); PG8_STAGE(PG8_SA(1, 0), cA + kstep, voffA); PG8_STAGE(PG8_SB(1, 1), cB + hstep + kstep, voffB);
        PG8_WAIT_V(6); PG8_BAR;
    } else {
        PG8_STAGE(PG8_SB(0, 0), cB, voffB); PG8_STAGE(PG8_SA(0, 0), cA, voffA); PG8_STAGE(PG8_SB(0, 1), cB + hstep, voffB); PG8_STAGE(PG8_SA(0, 1), cA + hstep, voffA);
        if (wr == 1) PG8_BAR;
        PG8_WAIT_V(4); PG8_BAR;
        PG8_STAGE(PG8_SB(1, 0), cB + kstep, voffB); PG8_STAGE(PG8_SA(1, 0), cA + kstep, voffA); PG8_STAGE(PG8_SB(1, 1), cB + hstep + kstep, voffB);
        PG8_WAIT_V(6); PG8_BAR;
    }
    for (;;) {
        const bool has_next = S.next(ui + 1, nxt);
        const char* nA = has_next ? (const char*)g.A + (size_t)nxt.pm * tstep : cA; const char* nB = has_next ? (const char*)g.Bt + (size_t)nxt.pn * tstep : cB;
        for (int t = 0; t < nt; t += 2) {
            const bool last = (t == nt - 2);
            const char* a1 = cA + (size_t)(t + 1) * kstep;
            const char* a2 = last ? nA : cA + (size_t)(t + 2) * kstep; const char* b2 = last ? nB : cB + (size_t)(t + 2) * kstep;
            const char* a3 = a2 + kstep; const char* b3 = b2 + kstep;
            if (last && has_next) S.a_ready(nxt);
            if constexpr (SP2) {
            PG8_LDB(B0, 0, 0); PG8_LDB(B1, 0, 1); PG8_SCHED; PG8_LDA(At, 0, 0); PG8_STAGE(PG8_SA(1, 1), a1 + hstep, voffA);
            PG8_WAIT_V(8); PG8_WAIT_L(0); PG8_BAR; PG8_MMA(0, 0, At, B0); PG8_MMA(0, 1, At, B1); PG8_BAR; PG8_SCHED;
            PG8_LDA(At, 0, 1); PG8_STAGE(PG8_SB(0, 0), b2, voffB); PG8_STAGE(PG8_SB(0, 1), b2 + hstep, voffB); PG8_STAGE(PG8_SA(0, 0), a2, voffA);
            PG8_WAIT_V(8); PG8_WAIT_L(0); PG8_BAR; PG8_MMA(1, 0, At, B0); PG8_MMA(1, 1, At, B1); PG8_BAR; PG8_SCHED;
            PG8_LDB(B0, 1, 0); PG8_LDB(B1, 1, 1); PG8_SCHED; PG8_LDA(At, 1, 0); PG8_STAGE(PG8_SA(0, 1), a2 + hstep, voffA);
            PG8_WAIT_V(8); PG8_WAIT_L(0); PG8_BAR; PG8_MMA(0, 0, At, B0); PG8_MMA(0, 1, At, B1); PG8_BAR; PG8_SCHED;
            PG8_LDA(At, 1, 1); PG8_STAGE(PG8_SB(1, 0), b3, voffB); PG8_STAGE(PG8_SB(1, 1), b3 + hstep, voffB); PG8_STAGE(PG8_SA(1, 0), a3, voffA);
            PG8_WAIT_V(8); PG8_WAIT_L(0); PG8_BAR; PG8_MMA(1, 0, At, B0); PG8_MMA(1, 1, At, B1); PG8_BAR; PG8_SCHED;
            } else {
            PG8_LDB(B0, 0, 0); PG8_SCHED; PG8_LDA(At, 0, 0); PG8_STAGE(PG8_SA(1, 1), a1 + hstep, voffA);
            PG8_WAIT_L(8); PG8_BAR; PG8_WAIT_L(0); PG8_MMA(0, 0, At, B0); PG8_BAR; PG8_SCHED;
            PG8_LDB(B1, 0, 1); PG8_STAGE(PG8_SB(0, 0), b2, voffB);
            PG8_BAR; PG8_WAIT_L(0); PG8_MMA(0, 1, At, B1); PG8_BAR;
            PG8_LDA(At, 0, 1); PG8_STAGE(PG8_SA(0, 0), a2, voffA);
            PG8_BAR; PG8_WAIT_L(0); PG8_MMA(1, 0, At, B0); PG8_BAR; PG8_SCHED;
            PG8_STAGE(PG8_SB(0, 1), b2 + hstep, voffB);
            PG8_WAIT_V(6); PG8_BAR; PG8_MMA(1, 1, At, B1); PG8_BAR;
            PG8_LDB(B0, 1, 0); PG8_SCHED; PG8_LDA(At, 1, 0); PG8_STAGE(PG8_SA(0, 1), a2 + hstep, voffA);
            PG8_WAIT_L(8); PG8_BAR; PG8_WAIT_L(0); PG8_MMA(0, 0, At, B0); PG8_BAR; PG8_SCHED;
            PG8_LDB(B1, 1, 1); PG8_STAGE(PG8_SB(1, 0), b3, voffB);
            PG8_BAR; PG8_WAIT_L(0); PG8_MMA(0, 1, At, B1); PG8_BAR;
            PG8_LDA(At, 1, 1); PG8_STAGE(PG8_SA(1, 0), a3, voffA);
            PG8_BAR; PG8_WAIT_L(0); PG8_MMA(1, 0, At, B0); PG8_BAR; PG8_SCHED;
            PG8_STAGE(PG8_SB(1, 1), b3 + hstep, voffB);
            PG8_WAIT_V(6); PG8_BAR; PG8_MMA(1, 1, At, B1); PG8_BAR;
            }
        }
        if constexpr (ALIGN_EPI) { if (wr == 0) PG8_BAR; }
        if constexpr (!Epi::AFTER_DRAIN) { E(acc, cur, wr, wc, fr, fq); S.done(cur); }
        if (!has_next) break;
#pragma unroll
        for (int a = 0; a < 2; ++a)
#pragma unroll
            for (int b = 0; b < 2; ++b)
#pragma unroll
                for (int m = 0; m < 4; ++m)
#pragma unroll
                    for (int n = 0; n < 2; ++n) acc[a][b][m][n] = (f32x4){0.f, 0.f, 0.f, 0.f};
        cur = nxt; cA = nA; cB = nB; ++ui;
        if constexpr (ALIGN_EPI) { if (wr == 1) PG8_BAR; }
    }
    PG8_WAIT_V(0);
    if constexpr (!ALIGN_EPI) { if (wr == 0) PG8_BAR; }
    PG8_BAR;
    if constexpr (Epi::AFTER_DRAIN) { E.fused(acc, cur, wr, wc, fr, fq, lds, wid, lane); S.done(cur); }
#undef PG8_SA
#undef PG8_SB
#undef PG8_STAGE
#undef PG8_LDA
#undef PG8_LDB
#undef PG8_MMA
#undef PG8_WAIT_V
#undef PG8_WAIT_L
#undef PG8_BAR
#undef PG8_SCHED
}
}

namespace pa {
using bf16 = __hip_bfloat16;
typedef short bf16x8 __attribute__((ext_vector_type(8)));
typedef short s16x4 __attribute__((ext_vector_type(4)));
typedef float f32x16 __attribute__((ext_vector_type(16)));
typedef float f32x4 __attribute__((ext_vector_type(4)));
typedef unsigned u32x4 __attribute__((ext_vector_type(4)));
template <class A, class Bt> struct same_t { static constexpr bool v = false; };
template <class A> struct same_t<A, A> { static constexpr bool v = true; };
constexpr int D = 128, LDR = 1024, LDY = 2048;
constexpr float SCALE = 0.08838834764831845f;
constexpr float THR = 8.f;
constexpr int NW = 8, QBLK = 32, KVBLK = 64, QB = NW * QBLK;
constexpr int SHM_V = KVBLK * D * 2, SHM_K = KVBLK * D * 2;
constexpr int LDS_WS = 2 * SHM_V + 2 * SHM_K, LDS_BIAS = LDS_WS + NW * 64 * 4, LDS_BYTES = LDS_BIAS + 2 * 2048 * 4;
enum { ORDER_NATURAL = 0, ORDER_REVERSED = 1, ORDER_PAIRED = 2, ORDER_XCD = 4 };
#define KSWZ(row, colB) ((row) * 256 + ((colB) ^ (((row) & 7) << 4)))
#define SBAR() __builtin_amdgcn_sched_barrier(0)
__device__ __forceinline__ int v_st(int k, int c) { const int kk = (k & ~0xC) | ((k & 4) << 1) | ((k & 8) >> 1); return ((kk >> 3) * 4 + (c >> 5)) * 512 + ((kk & 7) * 32 + (c & 31)) * 2; }
__device__ __forceinline__ int v_rd_base(int lane) { return ((lane & 3) << 3) | (((lane >> 2) & 3) << 6) | (((lane >> 4) & 1) << 5) | (((lane >> 5) & 1) << 8); }
constexpr int v_rd_off(int d0, int ks, int half) { return d0 * 512 + ks * 4096 + half * 2048; }
__device__ __forceinline__ int crow(int r, int hi) { return (r & 3) + 8 * (r >> 2) + 4 * hi; }
__device__ __forceinline__ unsigned cvtpk(float lo, float hi) {
    unsigned r; asm volatile("v_cvt_pk_bf16_f32 %0, %1, %2" : "=v"(r) : "v"(lo), "v"(hi)); return r;
}
__device__ __forceinline__ bf16x8 pack8(f32x4 a, f32x4 b) {
    u32x4 w = {cvtpk(a[0], a[1]), cvtpk(a[2], a[3]), cvtpk(b[0], b[1]), cvtpk(b[2], b[3])};
    return *reinterpret_cast<bf16x8*>(&w);
}
template <class T> __device__ __forceinline__ bf16x8 load8(const T* p) {
    if constexpr (same_t<T, float>::v) { return pack8(*(const f32x4*)p, *(const f32x4*)(p + 4)); }
    else { return *reinterpret_cast<const bf16x8*>(p); }
}
__device__ __forceinline__ void mask_tile(f32x16& p0, f32x16& p1, int dq, unsigned W) {
    const float NEG = -__builtin_inff();
#pragma unroll
    for (int r = 0; r < 16; ++r) {
        const int c = (r & 3) + 8 * (r >> 2);
        if ((unsigned)(dq - c) >= W) p0[r] = NEG;
        if ((unsigned)(dq - c - 32) >= W) p1[r] = NEG;
    }
}
__device__ __forceinline__ void partialSM(f32x16& p0, f32x16& p1, float& m_reg, float& mn, float& alpha) {
    float pmax = p0[0]; for (int r = 1; r < 16; ++r) pmax = fmaxf(pmax, p0[r]); for (int r = 0; r < 16; ++r) pmax = fmaxf(pmax, p1[r]);
    { auto rr = __builtin_amdgcn_permlane32_swap(__float_as_uint(pmax), __float_as_uint(pmax), false, false);
      pmax = fmaxf(__uint_as_float(rr[0]), __uint_as_float(rr[1])); }
    constexpr float C2 = 1.4426950408889634f * SCALE;
    if (__builtin_expect(__all((pmax - m_reg) * SCALE <= THR), 1)) { mn = m_reg; alpha = 1.f; }
    else { mn = fmaxf(m_reg, pmax); alpha = __builtin_amdgcn_exp2f((m_reg - mn) * C2); m_reg = mn; }
    const float mnL = -mn * C2;
    for (int r = 0; r < 16; ++r) p0[r] = fmaf(p0[r], C2, mnL); for (int r = 0; r < 16; ++r) p1[r] = fmaf(p1[r], C2, mnL);
    for (int r = 0; r < 16; ++r) p0[r] = __builtin_amdgcn_exp2f(p0[r]);
}
__device__ __forceinline__ void finishSM(f32x16& p0, f32x16& p1, float alpha, float& l_reg, bf16x8& pa0, bf16x8& pa1, bf16x8& pa2, bf16x8& pa3) {
    for (int r = 0; r < 16; ++r) p1[r] = __builtin_amdgcn_exp2f(p1[r]);
    float ps = 0; for (int r = 0; r < 16; ++r) ps += p0[r]; for (int r = 0; r < 16; ++r) ps += p1[r];
    { auto rr = __builtin_amdgcn_permlane32_swap(__float_as_uint(ps), __float_as_uint(ps), false, false);
      ps = __uint_as_float(rr[0]) + __uint_as_float(rr[1]); }
    l_reg = l_reg * alpha + ps;
#define PK4(P, B_, OUT) do { unsigned a0 = cvtpk(P[B_+0], P[B_+1]), a1 = cvtpk(P[B_+2], P[B_+3]);                          \
        unsigned b0 = cvtpk(P[B_+4], P[B_+5]), b1 = cvtpk(P[B_+6], P[B_+7]);                                             \
        auto r0 = __builtin_amdgcn_permlane32_swap(a0, b0, false, false); auto r1 = __builtin_amdgcn_permlane32_swap(a1, b1, false, false); \
        u32x4 w = {r0[0], r1[0], r0[1], r1[1]}; OUT = *reinterpret_cast<bf16x8*>(&w); } while (0)
    PK4(p0, 0, pa0); PK4(p0, 8, pa1); PK4(p1, 0, pa2); PK4(p1, 8, pa3);
#undef PK4
}
template <int KB>
__device__ __forceinline__ void qkt(f32x16& p0, f32x16& p1, const char* K_lds, const char* bias_t, int r32, int hi, const bf16x8* qr) {
    { const f32x4 b0 = *(const f32x4*)(bias_t), b1 = *(const f32x4*)(bias_t + 32), b2 = *(const f32x4*)(bias_t + 64), b3 = *(const f32x4*)(bias_t + 96);
      const f32x4 c0 = *(const f32x4*)(bias_t + 128), c1 = *(const f32x4*)(bias_t + 160), c2 = *(const f32x4*)(bias_t + 192), c3 = *(const f32x4*)(bias_t + 224);
      p0 = (f32x16){b0[0], b0[1], b0[2], b0[3], b1[0], b1[1], b1[2], b1[3], b2[0], b2[1], b2[2], b2[3], b3[0], b3[1], b3[2], b3[3]};
      p1 = (f32x16){c0[0], c0[1], c0[2], c0[3], c1[0], c1[1], c1[2], c1[3], c2[0], c2[1], c2[2], c2[3], c3[0], c3[1], c3[2], c3[3]}; }
    const char* kb[4];
#pragma unroll
    for (int dd = 0; dd < 4; ++dd) kb[dd] = K_lds + KB * SHM_K + KSWZ(r32, (dd * 16 + hi * 8) * 2);
#pragma unroll
    for (int d0 = 0; d0 < 8; ++d0) { const char* a = kb[d0 & 3] + (d0 >> 2) * 128;
        bf16x8 b0 = *reinterpret_cast<const bf16x8*>(a);
        bf16x8 b1 = *reinterpret_cast<const bf16x8*>(a + 32 * 256);
        p0 = __builtin_amdgcn_mfma_f32_32x32x16_bf16(b0, qr[d0], p0, 0, 0, 0);
        p1 = __builtin_amdgcn_mfma_f32_32x32x16_bf16(b1, qr[d0], p1, 0, 0, 0); }
}
template <int VB>
__device__ __forceinline__ void pv_tile(f32x16* o, int vb0, bf16x8 pa0, bf16x8 pa1, bf16x8 pa2, bf16x8 pa3) {
#define TRRD(dst, off) asm volatile("ds_read_b64_tr_b16 %0, %1 offset:%2" : "=&v"(dst) : "v"(vb0), "i"(off) : "memory")
#define PV_D0(d0) do { s16x4 l0, l1, l2, l3, h0, h1, h2, h3; constexpr int b_ = VB * SHM_V + v_rd_off(d0, 0, 0);     \
        TRRD(l0, b_); TRRD(h0, b_ + 2048); TRRD(l1, b_ + 4096); TRRD(h1, b_ + 6144); TRRD(l2, b_ + 8192); TRRD(h2, b_ + 10240); TRRD(l3, b_ + 12288); TRRD(h3, b_ + 14336); \
        asm volatile("s_waitcnt lgkmcnt(0)" ::: "memory"); SBAR();                 \
        o[d0] = __builtin_amdgcn_mfma_f32_32x32x16_bf16(pa0, (bf16x8){l0[0], l0[1], l0[2], l0[3], h0[0], h0[1], h0[2], h0[3]}, o[d0], 0, 0, 0);   \
        o[d0] = __builtin_amdgcn_mfma_f32_32x32x16_bf16(pa1, (bf16x8){l1[0], l1[1], l1[2], l1[3], h1[0], h1[1], h1[2], h1[3]}, o[d0], 0, 0, 0);   \
        o[d0] = __builtin_amdgcn_mfma_f32_32x32x16_bf16(pa2, (bf16x8){l2[0], l2[1], l2[2], l2[3], h2[0], h2[1], h2[2], h2[3]}, o[d0], 0, 0, 0);   \
        o[d0] = __builtin_amdgcn_mfma_f32_32x32x16_bf16(pa3, (bf16x8){l3[0], l3[1], l3[2], l3[3], h3[0], h3[1], h3[2], h3[3]}, o[d0], 0, 0, 0); } while (0)
    PV_D0(0); PV_D0(1); PV_D0(2); PV_D0(3);
#undef PV_D0
#undef TRRD
}

struct BlockRef { const bf16* Q; const bf16* K; const bf16* V; const float* Bias; const bf16* GA; bf16* Y; const float* gattn; int P0; };
struct Seam { bf16x8 qr[8]; bf16x8 st_v0, st_v1, st_k0, st_k1; };
#define ROW(p, k0, rr) ((p) + (size_t)((k0) + (rr)) * LDR + sc)
#define VMW() asm volatile("s_waitcnt vmcnt(0)" ::: "memory")
#define VMWN(n) asm volatile("s_waitcnt vmcnt(%0)" :: "i"(n) : "memory")
#define SLOAD_H(Kp, Vp, k0) do { S.st_v0 = load8<bf16>(ROW(Vp, k0, sr)); S.st_v1 = load8<bf16>(ROW(Vp, k0, 32 + sr));              \
                         S.st_k0 = load8<bf16>(ROW(Kp, k0, sr)); S.st_k1 = load8<bf16>(ROW(Kp, k0, 32 + sr)); } while (0)
#define SWRITE_HK(bf) do { *(bf16x8*)(K_lds + (bf) * SHM_K + kws) = S.st_k0; *(bf16x8*)(K_lds + (bf) * SHM_K + kws + 32 * 256) = S.st_k1; } while (0)
#define SWRITE_HV(bf) do { *(bf16x8*)(V_lds + (bf) * SHM_V + vst0) = S.st_v0; *(bf16x8*)(V_lds + (bf) * SHM_V + vst1) = S.st_v1; } while (0)
#define SWRITE_H(bf) do { SWRITE_HV(bf); SWRITE_HK(bf); } while (0)
__device__ __forceinline__ void causal_prime(const BlockRef& cur, char* lds, Seam& S) {
    const int tid = threadIdx.x, wid = __builtin_amdgcn_readfirstlane(tid >> 6), lane = tid & 63, r32 = lane & 31, hi = lane >> 5;
    const int sr = tid >> 4, sc = (tid & 15) * 8, kws = KSWZ(sr, sc * 2); char* K_lds = lds + 2 * SHM_V;
#pragma unroll
    for (int d0 = 0; d0 < 8; ++d0) S.qr[d0] = load8<bf16>(cur.Q + (size_t)(wid * QBLK + r32) * LDR + d0 * 16 + hi * 8);
    SLOAD_H(cur.K, cur.V, 0);
    if (tid * 4 < cur.P0 + QB) *(f32x4*)(lds + LDS_BIAS + tid * 16) = *(const f32x4*)(cur.Bias + tid * 4);
    VMW(); SWRITE_HK(0);
    __syncthreads();
}
__device__ __forceinline__ void causal_block(const BlockRef& cur, const BlockRef& nxt, char* lds, Seam& S, int par  ) {
    int tid = threadIdx.x; asm volatile("" : "+v"(tid));
    const int wid = __builtin_amdgcn_readfirstlane(tid >> 6), lane = tid & 63, r32 = lane & 31, hi = lane >> 5;
    const int NT = (cur.P0 + QB) / KVBLK;
    const int qlo = cur.P0 + wid * QBLK, qm = qlo + r32 - 4 * hi;
    char* V_lds = lds; char* K_lds = lds + 2 * SHM_V;
    const char* bias_l = lds + LDS_BIAS + par * 8192 + hi * 16;
    float* ws = (float*)(lds + LDS_WS) + wid * 64; float* li_l = ws, * al_l = ws + 32;
    float m_reg = -1e30f, l_reg = 0; f32x16 o[4] = {};
    const int sr = tid >> 4, sc = (tid & 15) * 8, vst0 = v_st(sr, sc), vst1 = v_st(32 + sr, sc), kws = KSWZ(sr, sc * 2);
    const int vb0 = (int)(uintptr_t)V_lds + v_rd_base(lane);
    const bf16* Kh = cur.K; const bf16* Vh = cur.V;
#define RESC(a) do { if (__any((a) < 1.f)) { if (hi == 0) al_l[r32] = (a); asm volatile("s_waitcnt lgkmcnt(0)" ::: "memory");              \
                     for (int d_ = 0; d_ < 4; ++d_) for (int r = 0; r < 16; ++r) o[d_][r] *= al_l[crow(r, hi)]; } } while (0)
#define KBASE(t) ((t) * KVBLK)
#define MASKT(P0_, P1_, t) do { const int kb_ = KBASE(t); if (kb_ + KVBLK - 1 > qlo) mask_tile(P0_, P1_, qm - kb_, 0x40000000u); } while (0)
#define SEAM_K0() do { VMWN(8); SWRITE_HK(0); SBAR(); } while (0)
    f32x16 pA0, pA1, pB0, pB1; float mnA, mnB, alA, alB; bf16x8 pa0, pa1, pa2, pa3;
    SWRITE_HV(0); SBAR();
    if (NT > 1) SLOAD_H(Kh, Vh, KBASE(1));
    SBAR(); qkt<0>(pA0, pA1, K_lds, bias_l + KBASE(0) * 4, r32, hi, S.qr);
    MASKT(pA0, pA1, 0); partialSM(pA0, pA1, m_reg, mnA, alA);
    if (NT > 1) { VMW(); SWRITE_H(1); }
    __syncthreads();
#define HALF_STEP(PX0, PX1, mnX, alX, PY0, PY1, alY, t, KB, VB, SB) do {                                                      \
        SBAR(); qkt<KB>(PX0, PX1, K_lds, bias_l + KBASE(t) * 4, r32, hi, S.qr);                                               \
        finishSM(PY0, PY1, alY, l_reg, pa0, pa1, pa2, pa3); SBAR();                                                           \
        if ((t) + 1 < NT) { SLOAD_H(Kh, Vh, KBASE((t) + 1)); SBAR(); }                                                        \
        pv_tile<VB>(o, vb0, pa0, pa1, pa2, pa3); MASKT(PX0, PX1, (t)); partialSM(PX0, PX1, m_reg, mnX, alX);                  \
        __syncthreads();                                                                                                      \
        if ((t) + 1 < NT) { VMW(); SWRITE_H(SB); }                                                                            \
        RESC(alX); __syncthreads(); } while (0)
    for (int t = 1; t + 1 < NT; t += 2) {
        HALF_STEP(pB0, pB1, mnB, alB, pA0, pA1, alA, t, 1, 0, 0);
        HALF_STEP(pA0, pA1, mnA, alA, pB0, pB1, alB, t + 1, 0, 1, 1);
    }
    const bool even = (NT & 1) == 0;
    if (even) { SBAR(); qkt<1>(pB0, pB1, K_lds, bias_l + KBASE(NT - 1) * 4, r32, hi, S.qr); SBAR(); }
    __builtin_amdgcn_global_load_lds((const __attribute__((address_space(1))) unsigned*)(nxt.Bias + tid * 4), (__attribute__((address_space(3))) unsigned*)(lds + LDS_BIAS + (par ^ 1) * 8192 + wid * 1024), 16, 0, 0);
    SBAR();
    SLOAD_H(nxt.K, nxt.V, 0); SBAR();
#pragma unroll
    for (int d0 = 0; d0 < 8; ++d0) S.qr[d0] = load8<bf16>(nxt.Q + (size_t)(wid * QBLK + r32) * LDR + d0 * 16 + hi * 8);
    SBAR();
    finishSM(pA0, pA1, alA, l_reg, pa0, pa1, pa2, pa3); SBAR();
    pv_tile<0>(o, vb0, pa0, pa1, pa2, pa3);
    if (even) { MASKT(pB0, pB1, NT - 1); partialSM(pB0, pB1, m_reg, mnB, alB); __syncthreads(); RESC(alB);
        finishSM(pB0, pB1, alB, l_reg, pa0, pa1, pa2, pa3); SBAR(); pv_tile<1>(o, vb0, pa0, pa1, pa2, pa3); }
    SBAR(); SEAM_K0();
    if (hi == 0) li_l[r32] = l_reg; asm volatile("s_waitcnt lgkmcnt(0)" ::: "memory");
    float rs[16];
#pragma unroll
    for (int r = 0; r < 16; ++r) { const float rl = __builtin_amdgcn_rcpf(li_l[crow(r, hi)]); float s = 0.f;
#pragma unroll
        for (int d0 = 0; d0 < 4; ++d0) { o[d0][r] *= rl; s = fmaf(o[d0][r], o[d0][r], s); }
        s += __shfl_xor(s, 1); s += __shfl_xor(s, 2); s += __shfl_xor(s, 4); s += __shfl_xor(s, 8); s += __shfl_xor(s, 16);
        rs[r] = __builtin_amdgcn_rsqf(s * (1.0f / 128.0f) + 1e-6f); }
    float gw[4];
#pragma unroll
    for (int d0 = 0; d0 < 4; ++d0) gw[d0] = cur.gattn[d0 * 32 + r32];
#pragma unroll
    for (int rh = 0; rh < 2; ++rh) {
        unsigned short gq[8][4];
#pragma unroll
        for (int r8 = 0; r8 < 8; ++r8) { const int orow = wid * QBLK + crow(rh * 8 + r8, hi);
#pragma unroll
            for (int d0 = 0; d0 < 4; ++d0) gq[r8][d0] = *(const unsigned short*)(cur.GA + (size_t)orow * LDR + d0 * 32 + r32); }
#pragma unroll
        for (int r8 = 0; r8 < 8; ++r8) { const int r = rh * 8 + r8, orow = wid * QBLK + crow(r, hi);
#pragma unroll
            for (int d0 = 0; d0 < 4; ++d0) { const float ga = __uint_as_float((unsigned)gq[r8][d0] << 16);
                const float v = o[d0][r] * rs[r] * gw[d0] * ga; const float vn = __shfl_xor(v, 1);
                if ((r32 & 1) == 0) *(unsigned*)(cur.Y + (size_t)orow * LDY + d0 * 32 + r32) = cvtpk(v, vn); } }
        asm volatile("" ::: "memory"); }
    __syncthreads();
#undef RESC
#undef KBASE
#undef MASKT
#undef SEAM_K0
#undef HALF_STEP
}
#undef ROW
#undef VMW
#undef VMWN
#undef SLOAD_H
#undef SWRITE_HK
#undef SWRITE_HV
#undef SWRITE_H

struct SwaItem { int bh, qb0, qb1; };
__device__ __forceinline__ SwaItem swa_decode(int L, int nbh, int nqb, int nx) {
    SwaItem it; int x;
    { const int xcd = L & 7, k = L >> 3, gi = k / nx, r = k - gi * nx; it.bh = gi * 8 + xcd; x = r; }
    it.qb0 = x; it.qb1 = nqb - 1 - x;
    return it;
}
struct PTensors { const bf16* Q; const bf16* K; const bf16* V; const float* Bias; const bf16* GA; bf16* Y; const float* gattn; };
__device__ __forceinline__ BlockRef swa_ref(const SwaItem& it, int pass, const PTensors& T) {
    const int qb = pass ? it.qb1 : it.qb0, b = it.bh >> 3, h = it.bh & 7; const size_t row0 = (size_t)b * 2048 + (size_t)qb * QB;
    BlockRef r; r.Q = T.Q + row0 * LDR + h * D; r.K = T.K + (size_t)b * 2048 * LDR + h * D; r.V = T.V + (size_t)b * 2048 * LDR + h * D;
    r.Bias = T.Bias + (size_t)it.bh * 2048; r.GA = T.GA + row0 * LDR + h * D; r.Y = T.Y + row0 * LDY + h * D; r.gattn = T.gattn + h * D; r.P0 = qb * QB;
    return r;
}
__device__ __forceinline__ void attn_prompt_phase(char* lds, const PTensors& T, int wg, int nwg) {
    constexpr int nqb = 8, nx = 4, nbh = 128, total = nx * nbh;
    int L = wg; if (L >= total) return;
    SwaItem it = swa_decode(L, nbh, nqb, nx); int pass = 0;
    BlockRef cur = swa_ref(it, 0, T);
    Seam S;
    causal_prime(cur, lds, S);
    int par = 0;
    for (;;) {
        const bool more_pass = pass == 0 && it.qb1 != it.qb0, more_item = L + nwg < total, last = !more_pass && !more_item;
        SwaItem itn = it; int passn = pass + 1, Ln = L;
        if (!more_pass) { passn = 0; Ln = more_item ? L + nwg : L; itn = swa_decode(Ln, nbh, nqb, nx); }
        const BlockRef nxt = last ? cur : swa_ref(itn, passn, T);
        causal_block(cur, nxt, lds, S, par);
        if (last) break;
        cur = nxt; it = itn; pass = passn; L = Ln; par ^= 1;
    }
}
}

namespace sa {
using namespace pa;
constexpr int SA_BIAS = 131072, SA_WS = SA_BIAS + 4160 * 4, SA_M = SA_WS + 2048, SA_L = SA_M + 1024, SA_WT = SA_L + 1024, LDS_BYTES = SA_WT + 64;
constexpr float SQRTD = 11.313708498984761f, C2 = 1.4426950408889634f * SCALE;
struct STensors { const bf16* Q; const bf16* Kn; const bf16* Vn; const float* ck; const float* cv; const float* clogf; const float* logf_s; const bf16* GA; bf16* Y; const float* gattn; };

__device__ __forceinline__ void sm_step(f32x16& p, float& m_reg, float& l_reg, float& alpha, bf16x8& pa0, bf16x8& pa1) {
    float pmax = p[0];
#pragma unroll
    for (int r = 1; r < 16; ++r) pmax = fmaxf(pmax, p[r]);
    { auto rr = __builtin_amdgcn_permlane32_swap(__float_as_uint(pmax), __float_as_uint(pmax), false, false);
      pmax = fmaxf(__uint_as_float(rr[0]), __uint_as_float(rr[1])); }
    float mn;
    if (__builtin_expect(__all((pmax - m_reg) * SCALE <= THR), 1)) { mn = m_reg; alpha = 1.f; }
    else { mn = fmaxf(m_reg, pmax); alpha = __builtin_amdgcn_exp2f((m_reg - mn) * C2); m_reg = mn; }
    const float mnL = -mn * C2;
    float ps = 0.f;
#pragma unroll
    for (int r = 0; r < 16; ++r) { p[r] = __builtin_amdgcn_exp2f(fmaf(p[r], C2, mnL)); ps += p[r]; }
    { auto rr = __builtin_amdgcn_permlane32_swap(__float_as_uint(ps), __float_as_uint(ps), false, false);
      ps = __uint_as_float(rr[0]) + __uint_as_float(rr[1]); }
    l_reg = l_reg * alpha + ps;
#define PK4(P, B_, OUT) do { unsigned a0 = cvtpk(P[B_+0], P[B_+1]), a1 = cvtpk(P[B_+2], P[B_+3]);                          \
        unsigned b0 = cvtpk(P[B_+4], P[B_+5]), b1 = cvtpk(P[B_+6], P[B_+7]);                                             \
        auto r0 = __builtin_amdgcn_permlane32_swap(a0, b0, false, false); auto r1 = __builtin_amdgcn_permlane32_swap(a1, b1, false, false); \
        u32x4 w = {r0[0], r1[0], r0[1], r1[1]}; OUT = *reinterpret_cast<bf16x8*>(&w); } while (0)
    PK4(p, 0, pa0); PK4(p, 8, pa1);
#undef PK4
}

__device__ __forceinline__ void sample_unit(char* lds, int b, int h, const STensors& T) {
    const int tid = threadIdx.x, wid = __builtin_amdgcn_readfirstlane(tid >> 6); int lane = tid & 63; asm volatile("" : "+v"(lane));
    const int r32 = lane & 31, hi = lane >> 5;
    char* Kt = lds + wid * 16384; char* Vt = Kt + 8192;
    float* biasL = (float*)(lds + SA_BIAS);
    float* ws = (float*)(lds + SA_WS) + wid * 64; float* li_l = ws; float* al_l = ws + 32;
    float* Mx = (float*)(lds + SA_M); float* Lx = (float*)(lds + SA_L); float* wt = (float*)(lds + SA_WT);
    {
        const float* lf = T.clogf + ((size_t)b * 4096 + 512 * wid + 8 * lane) * 8 + h;
        float v[8], e[8];
#pragma unroll
        for (int k = 0; k < 8; ++k) v[k] = lf[k * 8];
        float run = 0.f;
#pragma unroll
        for (int k = 7; k >= 0; --k) { e[k] = run; run += v[k]; }
        float incl = run;
#pragma unroll
        for (int off = 1; off < 64; off <<= 1) { const float t = __shfl_down(incl, off); if (lane + off < 64) incl += t; }
        const float excl = incl - run;
        if (lane == 0) wt[wid] = incl;
        float nv = 0.f;
        if (wid == 0) { if (lane < 32) nv = T.logf_s[((size_t)b * 32 + lane) * 8 + h];
#pragma unroll
            for (int off = 1; off < 32; off <<= 1) { const float t = __shfl_up(nv, off); if (lane >= off) nv += t; } }
        __syncthreads();
        float X = 0.f;
        for (int w2 = wid + 1; w2 < 8; ++w2) X += wt[w2];
#pragma unroll
        for (int k = 0; k < 8; ++k) biasL[512 * wid + 8 * lane + k] = (e[k] + excl + X) * SQRTD;
        if (wid == 0 && lane < 32) biasL[4096 + lane] = -nv * SQRTD;
    }
    bf16x8 qr[8];
    { const bf16* qp = T.Q + ((size_t)b * 32 + r32) * 1024 + h * 128 + hi * 8;
#pragma unroll
      for (int d0 = 0; d0 < 8; ++d0) qr[d0] = load8<bf16>(qp + d0 * 16); }
    __syncthreads();
    float m_reg = -1e30f, l_reg = 0.f; f32x16 o[4] = {};
    const int vb0 = (int)(uintptr_t)Vt + v_rd_base(lane);
    const char* ckb = (const char*)(T.ck + (((size_t)b * 4096) * 8 + h) * 128);
    const char* cvb = (const char*)(T.cv + (((size_t)b * 4096) * 8 + h) * 128);
    const unsigned lofs = (unsigned)(hi * 4096 + r32 * 16);
    char* const kwb0 = Kt + KSWZ(0 + hi, r32 * 8); char* const kwb1 = Kt + KSWZ(2 + hi, r32 * 8); char* const kwb2 = Kt + KSWZ(4 + hi, r32 * 8); char* const kwb3 = Kt + KSWZ(6 + hi, r32 * 8);
    char* const vwb = Vt + ((r32 * 4) >> 5) * 512 + hi * 64 + ((r32 * 4) & 31) * 2;
    f32x4 stg[16];
#define SA_ISSUE(src, kb) do { const char* s_ = (src) + (size_t)(kb) * 4096; _Pragma("unroll") for (int i = 0; i < 16; ++i) stg[i] = *(const f32x4*)(s_ + (size_t)i * 8192 + lofs); } while (0)
#define SA_WRITE_K() do { _Pragma("unroll") for (int i = 0; i < 16; ++i) { uint2 w_; w_.x = cvtpk(stg[i][0], stg[i][1]); w_.y = cvtpk(stg[i][2], stg[i][3]); \
        char* kb_ = (i & 3) == 0 ? kwb0 : ((i & 3) == 1 ? kwb1 : ((i & 3) == 2 ? kwb2 : kwb3)); *(uint2*)(kb_ + (i >> 2) * 2048) = w_; } } while (0)
#define SA_WRITE_V() do { _Pragma("unroll") for (int i = 0; i < 16; ++i) { uint2 w_; w_.x = cvtpk(stg[i][0], stg[i][1]); w_.y = cvtpk(stg[i][2], stg[i][3]); \
        *(uint2*)(vwb + (i & 1) * 128 + ((i >> 1) & 1) * 2048 + ((i >> 2) & 1) * 256 + ((i >> 3) & 1) * 4096) = w_; } } while (0)
#define SA_VMW() asm volatile("s_waitcnt vmcnt(0)" ::: "memory")
#define SA_LGW() asm volatile("s_waitcnt lgkmcnt(0)" ::: "memory")
#define SA_QKT(p, kb) do { const char* bt_ = (const char*)(biasL + (kb) + 4 * hi); \
        { const f32x4 b0 = *(const f32x4*)(bt_), b1 = *(const f32x4*)(bt_ + 32), b2 = *(const f32x4*)(bt_ + 64), b3 = *(const f32x4*)(bt_ + 96); \
          p = (f32x16){b0[0], b0[1], b0[2], b0[3], b1[0], b1[1], b1[2], b1[3], b2[0], b2[1], b2[2], b2[3], b3[0], b3[1], b3[2], b3[3]}; } \
        _Pragma("unroll") for (int d0 = 0; d0 < 8; ++d0) { const bf16x8 kf = *(const bf16x8*)(Kt + KSWZ(r32, ((d0 & 3) * 16 + hi * 8) * 2) + (d0 >> 2) * 128); \
            p = __builtin_amdgcn_mfma_f32_32x32x16_bf16(kf, qr[d0], p, 0, 0, 0); } } while (0)
#define SA_RESC(a) do { if (__any((a) < 1.f)) { if (hi == 0) al_l[r32] = (a); SA_LGW();              \
        _Pragma("unroll") for (int d_ = 0; d_ < 4; ++d_) _Pragma("unroll") for (int r = 0; r < 16; ++r) o[d_][r] *= al_l[crow(r, hi)]; } } while (0)
#define SA_TRRD(dst, off) asm volatile("ds_read_b64_tr_b16 %0, %1 offset:%2" : "=&v"(dst) : "v"(vb0), "i"(off) : "memory")
#define SA_PV() do { _Pragma("unroll") for (int d0 = 0; d0 < 4; ++d0) { s16x4 l0, h0, l1, h1; \
        if (d0 == 0) { SA_TRRD(l0, 0); SA_TRRD(h0, 2048); SA_TRRD(l1, 4096); SA_TRRD(h1, 6144); } \
        else if (d0 == 1) { SA_TRRD(l0, 512); SA_TRRD(h0, 2560); SA_TRRD(l1, 4608); SA_TRRD(h1, 6656); } \
        else if (d0 == 2) { SA_TRRD(l0, 1024); SA_TRRD(h0, 3072); SA_TRRD(l1, 5120); SA_TRRD(h1, 7168); } \
        else { SA_TRRD(l0, 1536); SA_TRRD(h0, 3584); SA_TRRD(l1, 5632); SA_TRRD(h1, 7680); } \
        SA_LGW(); SBAR(); \
        o[d0] = __builtin_amdgcn_mfma_f32_32x32x16_bf16(pa0, (bf16x8){l0[0], l0[1], l0[2], l0[3], h0[0], h0[1], h0[2], h0[3]}, o[d0], 0, 0, 0); \
        o[d0] = __builtin_amdgcn_mfma_f32_32x32x16_bf16(pa1, (bf16x8){l1[0], l1[1], l1[2], l1[3], h1[0], h1[1], h1[2], h1[3]}, o[d0], 0, 0, 0); } } while (0)
    const int kw0 = 512 * wid;
    SA_ISSUE(ckb, kw0);
#pragma unroll 1
    for (int i = 0; i < 16; ++i) {
        const int kb = kw0 + 32 * i;
        f32x16 p; float alpha; bf16x8 pa0, pa1;
        SA_VMW(); SA_WRITE_K(); SBAR();
        SA_ISSUE(cvb, kb); SBAR();
        SA_LGW(); SA_QKT(p, kb);
        sm_step(p, m_reg, l_reg, alpha, pa0, pa1);
        SA_VMW(); SA_WRITE_V(); SBAR();
        if (i + 1 < 16) SA_ISSUE(ckb, kb + 32);
        SBAR();
        SA_RESC(alpha);
        SA_LGW(); SA_PV();
    }
    if (wid == 0) {
        const bf16* kn = T.Kn + ((size_t)b * 32 + (lane >> 4)) * 1024 + h * 128 + (lane & 15) * 8;
        const bf16* vn = T.Vn + ((size_t)b * 32 + (lane >> 4)) * 1024 + h * 128 + (lane & 15) * 8;
        bf16x8 kk[8], vv[8];
#pragma unroll
        for (int i = 0; i < 8; ++i) { kk[i] = load8<bf16>(kn + (size_t)i * 4096); vv[i] = load8<bf16>(vn + (size_t)i * 4096); }
#pragma unroll
        for (int i = 0; i < 8; ++i) { const int row = 4 * i + (lane >> 4); *(bf16x8*)(Kt + KSWZ(row, (lane & 15) * 16)) = kk[i]; *(bf16x8*)(Vt + v_st(row, (lane & 15) * 8)) = vv[i]; }
        f32x16 p; float alpha; bf16x8 pa0, pa1;
        SA_LGW(); SA_QKT(p, 4096);
        { const float NEG = -__builtin_inff();
#pragma unroll
          for (int r = 0; r < 16; ++r) if (crow(r, hi) > r32) p[r] = NEG; }
        sm_step(p, m_reg, l_reg, alpha, pa0, pa1);
        SA_RESC(alpha);
        SA_LGW(); SA_PV();
    }
    if (hi == 0) Mx[wid * 32 + r32] = m_reg;
    __syncthreads();
    { float ms = Mx[r32];
#pragma unroll
      for (int w2 = 1; w2 < 8; ++w2) ms = fmaxf(ms, Mx[w2 * 32 + r32]);
      const float f = __builtin_amdgcn_exp2f((m_reg - ms) * C2);
      l_reg *= f;
      if (hi == 0) { al_l[r32] = f; Lx[wid * 32 + r32] = l_reg; }
      SA_LGW();
#pragma unroll
      for (int d_ = 0; d_ < 4; ++d_)
#pragma unroll
          for (int r = 0; r < 16; ++r) o[d_][r] *= al_l[crow(r, hi)]; }
#define SA_OWR(slot) do { char* sp_ = lds + (slot) * 16384 + lane * 16; _Pragma("unroll") for (int d_ = 0; d_ < 4; ++d_) _Pragma("unroll") for (int g = 0; g < 4; ++g) \
        *(f32x4*)(sp_ + (d_ * 4 + g) * 1024) = (f32x4){o[d_][4 * g], o[d_][4 * g + 1], o[d_][4 * g + 2], o[d_][4 * g + 3]}; } while (0)
#define SA_OAD(slot) do { const char* sp_ = lds + (slot) * 16384 + lane * 16; _Pragma("unroll") for (int d_ = 0; d_ < 4; ++d_) _Pragma("unroll") for (int g = 0; g < 4; ++g) { \
        const f32x4 t_ = *(const f32x4*)(sp_ + (d_ * 4 + g) * 1024); o[d_][4 * g] += t_[0]; o[d_][4 * g + 1] += t_[1]; o[d_][4 * g + 2] += t_[2]; o[d_][4 * g + 3] += t_[3]; } } while (0)
    if (wid >= 4) SA_OWR(wid - 4);
    __syncthreads();
    if (wid < 4) SA_OAD(wid);
    __syncthreads();
    if (wid == 2 || wid == 3) SA_OWR(wid - 2);
    __syncthreads();
    if (wid < 2) SA_OAD(wid);
    __syncthreads();
    if (wid == 1) SA_OWR(0);
    __syncthreads();
    if (wid == 0) {
        SA_OAD(0);
        int r32 = lane & 31, hi = lane >> 5; asm volatile("" : "+v"(r32), "+v"(hi));
        float lt = Lx[r32];
#pragma unroll
        for (int w2 = 1; w2 < 8; ++w2) lt += Lx[w2 * 32 + r32];
        if (hi == 0) li_l[r32] = lt;
        SA_LGW();
        float rs[16];
#pragma unroll
        for (int r = 0; r < 16; ++r) { const float rl = __builtin_amdgcn_rcpf(li_l[crow(r, hi)]); float s = 0.f;
#pragma unroll
            for (int d0 = 0; d0 < 4; ++d0) { o[d0][r] *= rl; s = fmaf(o[d0][r], o[d0][r], s); }
            s += __shfl_xor(s, 1); s += __shfl_xor(s, 2); s += __shfl_xor(s, 4); s += __shfl_xor(s, 8); s += __shfl_xor(s, 16);
            rs[r] = __builtin_amdgcn_rsqf(s * (1.0f / 128.0f) + 1e-6f); }
        float gw[4];
#pragma unroll
        for (int d0 = 0; d0 < 4; ++d0) gw[d0] = T.gattn[h * 128 + d0 * 32 + r32];
        const bf16* gap = T.GA + (size_t)b * 32 * 1024 + h * 128; bf16* yp = T.Y + (size_t)b * 32 * 2048 + h * 128;
        unsigned short gq[16][4];
#pragma unroll
        for (int r = 0; r < 16; ++r) { const int orow = crow(r, hi);
#pragma unroll
            for (int d0 = 0; d0 < 4; ++d0) gq[r][d0] = *(const unsigned short*)(gap + (size_t)orow * 1024 + d0 * 32 + r32); }
#pragma unroll
        for (int r = 0; r < 16; ++r) { const int orow = crow(r, hi);
#pragma unroll
            for (int d0 = 0; d0 < 4; ++d0) { const float ga = __uint_as_float((unsigned)gq[r][d0] << 16);
                const float v = o[d0][r] * rs[r] * gw[d0] * ga; const float vn = __shfl_xor(v, 1);
                if ((r32 & 1) == 0) *(unsigned*)(yp + (size_t)orow * 2048 + d0 * 32 + r32) = cvtpk(v, vn); } }
    }
    __syncthreads();
#undef SA_ISSUE
#undef SA_WRITE_K
#undef SA_WRITE_V
#undef SA_VMW
#undef SA_LGW
#undef SA_QKT
#undef SA_RESC
#undef SA_TRRD
#undef SA_PV
#undef SA_OWR
#undef SA_OAD
}
}

namespace lru {
using namespace pa;
constexpr int WP = 272;
constexpr int L_WR = 0, L_WI = 128 * WP, L_CW = 2 * 128 * WP, L_CST = L_CW + 5 * 128 * 4, L_XA = L_CST + 4 * 128 * 4, L_XU = L_XA + 2 * 8 * 32 * 4, L_CAR = L_XU + 2 * 8 * 32 * 4, LDS_BYTES = L_CAR + 2 * 128 * 4;
struct LTensors { const bf16* XL; const bf16* GL; bf16* Y; const bf16* WrT; const bf16* WiT; const float* conv_w; const float* conv_b; const float* b_r; const float* b_i; const float* lam; const float* g_lru;
                  const float* state_h; const float* state_conv; float* h_p; float* h_s; };

__device__ __forceinline__ void load_weights(char* lds, const LTensors& T, int n) {
    int tid = threadIdx.x; asm volatile("" : "+v"(tid));
#pragma unroll
    for (int i = 0; i < 4; ++i) { const int ch = tid + 512 * i, row = ch >> 4, c16 = ch & 15;
        *(u32x4*)(lds + L_WR + row * WP + c16 * 16) = *(const u32x4*)((const char*)(T.WrT + (size_t)n * 16384) + row * 256 + c16 * 16);
        *(u32x4*)(lds + L_WI + row * WP + c16 * 16) = *(const u32x4*)((const char*)(T.WiT + (size_t)n * 16384) + row * 256 + c16 * 16); }
    for (int i = tid; i < 5 * 128; i += 512) { const int d = i >> 7, c = i & 127; ((float*)(lds + L_CW))[i] = (d < 4) ? T.conv_w[d * 1024 + n * 128 + c] : T.conv_b[n * 128 + c]; }
    if (tid < 128) { const int c = n * 128 + tid; float* cst = (float*)(lds + L_CST);
        cst[tid] = T.b_r[c]; cst[128 + tid] = T.b_i[c]; const float lam = T.lam[c]; cst[256 + tid] = 8.0f * (fmaxf(-lam, 0.f) + log1pf(expf(-fabsf(lam)))); cst[384 + tid] = T.g_lru[c]; }
    if (tid < 256) ((float*)(lds + L_CAR))[tid] = 0.f;
}
template <bool SAMPLE>
__device__ __forceinline__ void tile_afrags(const char* lds, const bf16* xl, int t0, const float* hist, bf16x8 (&af)[8], int r32, int hi) {
    const float* cw = (const float*)(lds + L_CW);
#pragma unroll
    for (int kh = 0; kh < 2; ++kh) {
        bf16x8 raw[4][4];
#pragma unroll
        for (int k4 = 0; k4 < 4; ++k4)
#pragma unroll
            for (int d = 0; d < 4; ++d) { const int tt = r32 - 3 + d; raw[k4][d] = (bf16x8){0, 0, 0, 0, 0, 0, 0, 0};
                if (t0 + tt >= 0) raw[k4][d] = *(const bf16x8*)(xl + (ptrdiff_t)tt * 1024 + (kh * 4 + k4) * 16 + hi * 8); }
#pragma unroll
        for (int k4 = 0; k4 < 4; ++k4) { const int ks = kh * 4 + k4, c8 = ks * 16 + hi * 8;
            f32x4 x0 = *(const f32x4*)(cw + 4 * 128 + c8), x1 = *(const f32x4*)(cw + 4 * 128 + c8 + 4);
#pragma unroll
            for (int d = 0; d < 4; ++d) { const int tt = r32 - 3 + d; const bf16x8 rw = raw[k4][d];
                f32x4 v0 = (f32x4){__uint_as_float((unsigned)(unsigned short)rw[0] << 16), __uint_as_float((unsigned)(unsigned short)rw[1] << 16), __uint_as_float((unsigned)(unsigned short)rw[2] << 16), __uint_as_float((unsigned)(unsigned short)rw[3] << 16)};
                f32x4 v1 = (f32x4){__uint_as_float((unsigned)(unsigned short)rw[4] << 16), __uint_as_float((unsigned)(unsigned short)rw[5] << 16), __uint_as_float((unsigned)(unsigned short)rw[6] << 16), __uint_as_float((unsigned)(unsigned short)rw[7] << 16)};
                if (SAMPLE) { if (t0 + tt < 0) { const float* hp = hist + (size_t)(tt + 3) * 1024 + c8; v0 = *(const f32x4*)hp; v1 = *(const f32x4*)(hp + 4); } }
                const f32x4 w0 = *(const f32x4*)(cw + d * 128 + c8), w1 = *(const f32x4*)(cw + d * 128 + c8 + 4);
                x0 += w0 * v0; x1 += w1 * v1; }
            af[ks] = pack8(x0, x1); }
        asm volatile("" ::: "memory"); }
}
__device__ __forceinline__ void cb_maps(const char* lds, const bf16x8 (&af)[8], int cb, bool first0, f32x16& PA, f32x16& PU, float& tA, float& tU, int r32, int hi) {
    f32x16 ar = {}, ai = {}, ax = {};
    const char* wp = lds + (cb * 32 + r32) * WP + hi * 16;
#pragma unroll
    for (int ks = 0; ks < 8; ++ks) {
        const bf16x8 br = *(const bf16x8*)(wp + L_WR + ks * 32), bi = *(const bf16x8*)(wp + L_WI + ks * 32);
        ar = __builtin_amdgcn_mfma_f32_32x32x16_bf16(af[ks], br, ar, 0, 0, 0);
        ai = __builtin_amdgcn_mfma_f32_32x32x16_bf16(af[ks], bi, ai, 0, 0, 0);
        if ((ks & 1) == 1) asm volatile("" ::: "memory"); }
    {
        const int j = r32 & 7; const unsigned one = (j & 1) ? 0x3F800000u : 0x00003F80u; const bool hm = (hi == ((r32 >> 3) & 1));
        const bool c0 = hm && ((r32 >> 4) == 0), c1 = hm && ((r32 >> 4) == 1);
        u32x4 f0, f1;
        f0.x = (c0 && (j >> 1) == 0) ? one : 0u; f0.y = (c0 && (j >> 1) == 1) ? one : 0u; f0.z = (c0 && (j >> 1) == 2) ? one : 0u; f0.w = (c0 && (j >> 1) == 3) ? one : 0u;
        f1.x = (c1 && (j >> 1) == 0) ? one : 0u; f1.y = (c1 && (j >> 1) == 1) ? one : 0u; f1.z = (c1 && (j >> 1) == 2) ? one : 0u; f1.w = (c1 && (j >> 1) == 3) ? one : 0u;
        ax = __builtin_amdgcn_mfma_f32_32x32x16_bf16(af[2 * cb], *reinterpret_cast<bf16x8*>(&f0), ax, 0, 0, 0);
        ax = __builtin_amdgcn_mfma_f32_32x32x16_bf16(af[2 * cb + 1], *reinterpret_cast<bf16x8*>(&f1), ax, 0, 0, 0); }
    const float* cst = (const float*)(lds + L_CST) + cb * 32 + r32;
    const float cbr = cst[0], cbi = cst[128], csp = cst[256];
    const bool first = first0 && (hi == 0);
#pragma unroll
    for (int r = 0; r < 16; ++r) {
        const float rg = __builtin_amdgcn_rcpf(1.0f + __builtin_amdgcn_exp2f(-1.4426950408889634f * (ar[r] + cbr)));
        const float ig = __builtin_amdgcn_rcpf(1.0f + __builtin_amdgcn_exp2f(-1.4426950408889634f * (ai[r] + cbi)));
        const float av = __builtin_amdgcn_exp2f(-1.4426950408889634f * csp * rg);
        float mult = __builtin_amdgcn_sqrtf(fmaxf(fmaf(-av, av, 1.0f), 0.f));
        if (r == 0 && first) mult = 1.0f;
        ar[r] = av; ai[r] = mult * ig * ax[r]; }
    float Ag[4], Ug[4];
#pragma unroll
    for (int gl = 0; gl < 4; ++gl) { const int r0 = 4 * gl;
        float pa = ar[r0], pu = ai[r0];
#pragma unroll
        for (int k = 1; k < 4; ++k) { pu = fmaf(ar[r0 + k], pu, ai[r0 + k]); pa = ar[r0 + k] * pa; ar[r0 + k] = pa; ai[r0 + k] = pu; }
        Ag[gl] = pa; Ug[gl] = pu; }
    float GA = 1.0f, GU = 0.f;
#pragma unroll
    for (int gl = 0; gl < 4; ++gl) { const int r0 = 4 * gl;
        const float oA = __shfl_xor(Ag[gl], 32), oU = __shfl_xor(Ug[gl], 32);
        const float sA0 = hi ? oA : Ag[gl], sU0 = hi ? oU : Ug[gl], sA1 = hi ? Ag[gl] : oA, sU1 = hi ? Ug[gl] : oU;
        const float GA1 = sA0 * GA, GU1 = fmaf(sA0, GU, sU0);
        const float mA = hi ? GA1 : GA, mU = hi ? GU1 : GU;
#pragma unroll
        for (int k = 0; k < 4; ++k) { PU[r0 + k] = fmaf(ar[r0 + k], mU, ai[r0 + k]); PA[r0 + k] = ar[r0 + k] * mA; }
        GA = sA1 * GA1; GU = fmaf(sA1, GU1, sU1); }
    tA = GA; tU = GU;
}
__device__ __forceinline__ void tile_out(const char* lds, f32x16 (&H)[4], const bf16* gl, bf16* y, int r32, int hi) {
    const float* cst = (const float*)(lds + L_CST) + 384 + r32;
    const float cg0 = cst[0], cg1 = cst[32], cg2 = cst[64], cg3 = cst[96];
#pragma unroll
    for (int rh = 0; rh < 2; ++rh) {
        unsigned short gq[8][4];
#pragma unroll
        for (int r8 = 0; r8 < 8; ++r8) { const int tt = crow(rh * 8 + r8, hi);
#pragma unroll
            for (int cb = 0; cb < 4; ++cb) gq[r8][cb] = *(const unsigned short*)(gl + (size_t)tt * 1024 + cb * 32 + r32); }
#pragma unroll
        for (int r8 = 0; r8 < 8; ++r8) { const int r = rh * 8 + r8; float s = 0.f;
#pragma unroll
            for (int cb = 0; cb < 4; ++cb) s = fmaf(H[cb][r], H[cb][r], s);
            s += __shfl_xor(s, 1); s += __shfl_xor(s, 2); s += __shfl_xor(s, 4); s += __shfl_xor(s, 8); s += __shfl_xor(s, 16);
            const float rs = __builtin_amdgcn_rsqf(s * (1.0f / 128.0f) + 1e-6f); const int tt = crow(r, hi);
#pragma unroll
            for (int cb = 0; cb < 4; ++cb) { const float g = __uint_as_float((unsigned)gq[r8][cb] << 16);
                const float v = H[cb][r] * rs * (cb == 0 ? cg0 : (cb == 1 ? cg1 : (cb == 2 ? cg2 : cg3))) * g; const float vn = __shfl_xor(v, 1);
                if ((r32 & 1) == 0) *(unsigned*)(y + (size_t)tt * 2048 + cb * 32 + r32) = cvtpk(v, vn); } }
        asm volatile("" ::: "memory"); }
}
__device__ __forceinline__ void prompt_unit(char* lds, const LTensors& T, int b, int n) {
    const int tid = threadIdx.x, wid = __builtin_amdgcn_readfirstlane(tid >> 6); const int lane0 = tid & 63;
    load_weights(lds, T, n);
    __syncthreads();
    float* XA = (float*)(lds + L_XA); float* XU = (float*)(lds + L_XU); float* CAR = (float*)(lds + L_CAR);
#pragma unroll 1
    for (int ch = 0; ch < 8; ++ch) {
        int lane = lane0; asm volatile("" : "+v"(lane)); const int r32 = lane & 31, hi = lane >> 5;
        const int t0 = ch * 256 + wid * 32; const size_t row = (size_t)b * 2048 + t0;
        bf16x8 af[8];
        tile_afrags<false>(lds, T.XL + row * 1024 + n * 128, t0, nullptr, af, r32, hi);
        f32x16 H[4];
#pragma unroll
        for (int cb = 0; cb < 4; ++cb) { const int par = cb & 1, c = cb * 32 + r32;
            f32x16 PA, PU; float tA, tU;
            cb_maps(lds, af, cb, t0 == 0, PA, PU, tA, tU, r32, hi);
            if (hi == 0) { XA[(par * 8 + wid) * 32 + r32] = tA; XU[(par * 8 + wid) * 32 + r32] = tU; }
            __syncthreads();
            float hin = CAR[(ch & 1) * 128 + c];
            for (int w2 = 0; w2 < wid; ++w2) hin = fmaf(XA[(par * 8 + w2) * 32 + r32], hin, XU[(par * 8 + w2) * 32 + r32]);
#pragma unroll
            for (int r = 0; r < 16; ++r) H[cb][r] = fmaf(PA[r], hin, PU[r]);
            if (wid == 7 && hi == 1) { CAR[((ch + 1) & 1) * 128 + c] = H[cb][15]; if (ch == 7) T.h_p[(size_t)b * 1024 + n * 128 + c] = H[cb][15]; } }
        { int r32v = r32, hiv = hi; asm volatile("" : "+v"(r32v), "+v"(hiv)); tile_out(lds, H, T.GL + row * 1024 + n * 128, T.Y + row * 2048 + 1024 + n * 128, r32v, hiv); }
    }
    __syncthreads();
}
__device__ __forceinline__ void sample_unit(char* lds, const LTensors& T, int n) {
    const int tid = threadIdx.x, wid = __builtin_amdgcn_readfirstlane(tid >> 6); const int lane0 = tid & 63;
    load_weights(lds, T, n);
    __syncthreads();
#pragma unroll 1
    for (int bi = 0; bi < 4; ++bi) { const int b = wid + 8 * bi;
        int lane = lane0; asm volatile("" : "+v"(lane)); const int r32 = lane & 31, hi = lane >> 5; const size_t row = 32768 + (size_t)b * 32;
        bf16x8 af[8];
        tile_afrags<true>(lds, T.XL + row * 1024 + n * 128, 0, T.state_conv + (size_t)b * 3 * 1024 + n * 128, af, r32, hi);
        f32x16 H[4];
#pragma unroll
        for (int cb = 0; cb < 4; ++cb) { const int c = n * 128 + cb * 32 + r32;
            f32x16 PA, PU; float tA, tU;
            cb_maps(lds, af, cb, false, PA, PU, tA, tU, r32, hi);
            const float hin = T.state_h[(size_t)b * 1024 + c];
#pragma unroll
            for (int r = 0; r < 16; ++r) H[cb][r] = fmaf(PA[r], hin, PU[r]);
            if (hi == 1) T.h_s[(size_t)b * 1024 + c] = H[cb][15]; }
        { int r32v = r32, hiv = hi; asm volatile("" : "+v"(r32v), "+v"(hiv)); tile_out(lds, H, T.GL + row * 1024 + n * 128, T.Y + row * 2048 + 1024 + n * 128, r32v, hiv); }
    }
    __syncthreads();
}
}

constexpr int NWAVES = 8;
constexpr int N_LAUNCHES = MK_N_LAUNCHES;
constexpr int PER_PHASE = 6;
constexpr int DM = 2048, SEQ = 2048, NB = 16, DB = 32, DS = 32, PAST = 4096, NH = 8, HD = 128, DA = 1024, DL = 1024;
constexpr int MP = NB * SEQ, MS = DB * DS, M = MP + MS;
constexpr int D_IN = 6152, NIN = 6144;
constexpr float LN_EPS = 1e-5f, ALPHA = 1.189207115002721f;
constexpr size_t O_YP = 0, O_YS = O_YP + (size_t)MP * DM, O_KP = O_YS + (size_t)MS * DM, O_VP = O_KP + (size_t)MP * DA, O_FP = O_VP + (size_t)MP * DA,
                 O_HP = O_FP + (size_t)MP * NH, O_CP = O_HP + (size_t)NB * DL, O_KS = O_CP + (size_t)NB * 3 * DL, O_VS = O_KS + (size_t)MS * DA, O_FS = O_VS + (size_t)MS * DA,
                 O_HS = O_FS + (size_t)MS * NH, O_CS = O_HS + (size_t)DB * DL, O_END = O_CS + (size_t)DB * 3 * DL;
static_assert(O_END == 138878976, "d_out size");
constexpr size_t MiB = 1u << 20;
constexpr size_t WS_CTL = 0, CTL_ZERO_BYTES = 1 * MiB;
constexpr size_t WS_WIN = 2 * MiB;
constexpr size_t WS_WOUT = 26 * MiB;
constexpr size_t WS_WR = 34 * MiB, WS_WI = 34 * MiB + 512 * 1024;
constexpr size_t WS_BIAS = 35 * MiB;
constexpr size_t WS_XB = 40 * MiB;
constexpr size_t ACT_BYTES = (size_t)M * 1024 * 2;
constexpr size_t WS_ACT = 172 * MiB;
constexpr size_t WS_YC = WS_ACT + 6 * ACT_BYTES;
constexpr size_t WS_END = WS_YC + (size_t)M * 2048 * 2;
static_assert(ACT_BYTES == 66 * MiB && WS_XB + (size_t)M * 2048 * 2 <= WS_ACT, "ws map");
constexpr int CW_TMO = 0, CW_CODE = 1, CW_BAR = 4096;
constexpr int PH_BYTES = 153600;
constexpr int LDSCTL_OFF = PH_BYTES, MISC_OFF = LDSCTL_OFF + 320, LDS_BYTES = 155648;
static_assert(MISC_OFF + 128 <= LDS_BYTES && sa::LDS_BYTES <= PH_BYTES && lru::LDS_BYTES <= PH_BYTES && pa::LDS_BYTES <= PH_BYTES && pg8::STAGE_BYTES <= PH_BYTES, "LDS map");

#define GAS __attribute__((address_space(1)))
#define LAS __attribute__((address_space(3)))
typedef unsigned short bf16;
typedef unsigned v4u __attribute__((ext_vector_type(4)));
typedef float f32x4 __attribute__((ext_vector_type(4)));
typedef GAS unsigned gu32;
#define RLX_AGENT __ATOMIC_RELAXED, __HIP_MEMORY_SCOPE_AGENT
#define LDS_WAIT() asm volatile("s_waitcnt lgkmcnt(0)" ::: "memory")
#define VM_WAIT() asm volatile("s_waitcnt vmcnt(0)" ::: "memory")
__device__ __forceinline__ unsigned f2bf(float f) { unsigned u = __builtin_bit_cast(unsigned, f); return (u + 0x7fffu + ((u >> 16) & 1u)) >> 16; }
__device__ __forceinline__ unsigned pk2(float lo, float hi) { return f2bf(lo) | (f2bf(hi) << 16); }

#define XB_TMO      128
#define XB_XCNT(j)  (256  + 64 * (j))
#define XB_XSUB(j)  (1280 + 64 * (j))
#define XB_XGEN(j)  (2304 + 64 * (j))
#define XB_TOP      3328
#define XB_TOPGEN   3392
#define XCD_BAR_WORDS 3456
#define XB_SPIN_CAP (1u << 18)

__device__ __forceinline__ unsigned xb_ld(unsigned* p)              { return __hip_atomic_load(p, __ATOMIC_RELAXED, __HIP_MEMORY_SCOPE_AGENT); }
__device__ __forceinline__ unsigned xb_add(unsigned* p, unsigned v) { return __hip_atomic_fetch_add(p, v, __ATOMIC_RELAXED, __HIP_MEMORY_SCOPE_AGENT); }
__device__ __forceinline__ unsigned xb_xcc_id() { return (unsigned)__builtin_amdgcn_s_getreg((3 << 11) | 20) & 0xFu; }
#define XB_SPIN(cond, bar) do { unsigned _sp = 0; while (cond) { __builtin_amdgcn_s_sleep(1); \
    if ((++_sp & 255u) == 0u) { if (xb_ld(&(bar)[XB_TMO])) break; if (_sp > XB_SPIN_CAP) { atomicAdd(&(bar)[XB_TMO], 1u); break; } } } } while (0)

struct XcdBarrier {
    unsigned* bar; unsigned x;
    volatile LAS unsigned* st;
};

__device__ __forceinline__ XcdBarrier xcd_barrier_post(unsigned* bar, volatile LAS unsigned* st) {
    XcdBarrier b; b.bar = bar; b.x = xb_xcc_id(); b.st = st;
    if (threadIdx.x == 0) (void)xb_add(&bar[XB_XCNT(b.x)], 1u);
    return b;
}
__device__ __forceinline__ void xcd_barrier_complete(unsigned* bar, unsigned x, unsigned& nloc, unsigned& nx) {
    const unsigned G = gridDim.x * gridDim.y * gridDim.z;
    unsigned sum, cnt, mine, sp = 0u;
    for (;;) {
        sum = 0u; cnt = 0u; mine = 0u;
#pragma unroll
        for (unsigned j = 0; j < 16; ++j) { const unsigned c = xb_ld(&bar[XB_XCNT(j)]); sum += c; cnt += (c > 0u) ? 1u : 0u; mine = (j == x) ? c : mine; }
        if (sum == G) break;
        __builtin_amdgcn_s_sleep(1);
        if ((++sp & 255u) == 0u) { if (xb_ld(&bar[XB_TMO])) break; if (sp > XB_SPIN_CAP) { atomicAdd(&bar[XB_TMO], 1u); break; } }
    }
    nloc = mine > 0u ? mine : 1u; nx = cnt > 0u ? cnt : 1u;
}

__device__ __forceinline__ void xcd_barrier(const XcdBarrier& b) {
    asm volatile("s_waitcnt vmcnt(0)" ::: "memory");
    __syncthreads();
    if (threadIdx.x == 0) {
        unsigned* bar = b.bar;
        __builtin_amdgcn_s_waitcnt(0);
        unsigned nloc = b.st[0], nx = b.st[1];
        if (nloc == 0u) { xcd_barrier_complete(bar, b.x, nloc, nx); b.st[0] = nloc; b.st[1] = nx; }
        const unsigned old = xb_add(&bar[XB_XSUB(b.x)], 1u);
        const unsigned gen = old / nloc;
        if (old + 1u == (gen + 1u) * nloc) {
            __builtin_amdgcn_fence(__ATOMIC_RELEASE, "agent");
            asm volatile("s_waitcnt vmcnt(0)" ::: "memory");
            const unsigned og = xb_add(&bar[XB_TOP], 1u);
            const unsigned tg = og / nx;
            if (og + 1u == (tg + 1u) * nx) xb_add(&bar[XB_TOPGEN], 1u);
            else XB_SPIN(xb_ld(&bar[XB_TOPGEN]) == tg, bar);
            __builtin_amdgcn_fence(__ATOMIC_ACQUIRE, "agent");
            xb_add(&bar[XB_XGEN(b.x)], 1u);
            asm volatile("s_waitcnt vmcnt(0)" ::: "memory");
        } else {
            XB_SPIN(xb_ld(&bar[XB_XGEN(b.x)]) == gen, bar);
            __builtin_amdgcn_fence(__ATOMIC_ACQUIRE, "agent");
            asm volatile("s_waitcnt vmcnt(0)" ::: "memory");
        }
    }
    __syncthreads();
}

__device__ __forceinline__ float wave_sum(float v) {
#pragma unroll
    for (int o = 1; o < 64; o <<= 1) v += __shfl_xor(v, o);
    return v;
}
__device__ __forceinline__ void p0_transpose_item(const float* W, int ldw, int scol, bf16* WT, int K, int drow, int k0, LAS float* scr, int lane) {
#pragma unroll 8
    for (int i = 0; i < 32; ++i) { const int kk = 2 * i + (lane >> 5); scr[kk * 33 + (lane & 31)] = W[(size_t)(k0 + kk) * ldw + scol + (lane & 31)]; }
    LDS_WAIT(); asm volatile("" ::: "memory");
    const int c = lane & 7;
#pragma unroll
    for (int j = 0; j < 4; ++j) { const int n = (lane >> 3) + 8 * j; const LAS float* s = scr + (8 * c) * 33 + n;
        v4u o; o.x = pk2(s[0 * 33], s[1 * 33]); o.y = pk2(s[2 * 33], s[3 * 33]); o.z = pk2(s[4 * 33], s[5 * 33]); o.w = pk2(s[6 * 33], s[7 * 33]);
        *(GAS v4u*)(WT + (size_t)(drow + n) * K + k0 + 8 * c) = o; }
    LDS_WAIT(); asm volatile("" ::: "memory");
}

struct Args { const float* in[21]; float* out; unsigned char* ws; int ph_lo, ph_hi; };

__global__ void __launch_bounds__(NWAVES * 64, 2) fwd_kernel(Args args) {
    extern __shared__ __attribute__((aligned(16))) unsigned char lds[];
    LAS unsigned char* ldsl = (LAS unsigned char*)lds;
    volatile LAS unsigned* MISC = (volatile LAS unsigned*)(ldsl + MISC_OFF);
    const int tid = threadIdx.x, lane = tid & 63, wave = __builtin_amdgcn_readfirstlane(tid >> 6);
    const int G = gridDim.x, bx = blockIdx.x;
    unsigned char* ws = args.ws;
    gu32* ctl = (gu32*)(ws + WS_CTL);
    float* out = args.out;
    const float* x_p = args.in[0]; const float* x_s = args.in[1];
    bf16* WinT = (bf16*)(ws + WS_WIN); bf16* WoutT = (bf16*)(ws + WS_WOUT); bf16* WrT = (bf16*)(ws + WS_WR); bf16* WiT = (bf16*)(ws + WS_WI);
    float* BIAS = (float*)(ws + WS_BIAS); bf16* XB = (bf16*)(ws + WS_XB); bf16* ACT = (bf16*)(ws + WS_ACT); bf16* YC = (bf16*)(ws + WS_YC);
    constexpr size_t ACT_EL = ACT_BYTES / 2;
    bf16* QB = ACT; bf16* KBf = ACT + ACT_EL; bf16* VBf = ACT + 2 * ACT_EL; bf16* GA = ACT + 3 * ACT_EL; bf16* XL = ACT + 4 * ACT_EL; bf16* GL = ACT + 5 * ACT_EL;

    for (int u = tid; u < (LDS_BYTES - LDSCTL_OFF) / 4; u += NWAVES * 64) ((LAS unsigned*)(ldsl + LDSCTL_OFF))[u] = 0u;
    __syncthreads();
    XcdBarrier bar; bar.bar = (unsigned*)(ctl + CW_BAR); bar.x = 0; bar.st = nullptr;
    if (N_LAUNCHES != PER_PHASE) bar = xcd_barrier_post((unsigned*)(ctl + CW_BAR), MISC + 8);
#define GRID_BAR(seam) do { if (N_LAUNCHES == PER_PHASE) { if (tid == 0) __hip_atomic_store(ctl + CW_TMO, 0xBADBA0u | (unsigned)(seam), RLX_AGENT); } else { xcd_barrier(bar); } } while (0)
    const int lo = args.ph_lo, hi_ph = args.ph_hi;
#ifndef ONLY_PHASE
#define ONLY_PHASE -1
#endif
#define IN(k) (lo <= (k) && (k) < hi_ph && (ONLY_PHASE < 0 || ONLY_PHASE == (k)))
#define BOTH(k) (IN(k) && IN((k) + 1))
#ifndef PROBE_REPEAT
#define PROBE_REPEAT -1
#endif
#define REP(k) for (int rep_ = 0; rep_ < ((PROBE_REPEAT == (k)) ? 2 : 1); ++rep_)

    if (IN(0)) {
        const int gw = bx * NWAVES + wave, NGW = G * NWAVES;
        const float* w_in = args.in[7]; const float* w_out = args.in[18]; const float* w_r = args.in[11]; const float* w_i = args.in[13]; const float* b_f = args.in[8];
        LAS float* scr = (LAS float*)(ldsl + wave * 16384);
        constexpr int I_IN = 32 * 192, I_OUT = 32 * 64, I_R = 64, NITEMS = I_IN + I_OUT + 2 * I_R;
        for (int it = gw; it < NITEMS; it += NGW) {
            int r = it;
            if (r < I_IN) { const int kb = r / 192, nb = r % 192; p0_transpose_item(w_in, D_IN, 32 * nb + (nb >= 96 ? 8 : 0), WinT, 2048, 32 * nb, 64 * kb, scr, lane); continue; } r -= I_IN;
            if (r < I_OUT) { const int kb = r / 64, nb = r % 64; p0_transpose_item(w_out, 2048, 32 * nb, WoutT, 2048, 32 * nb, 64 * kb, scr, lane); continue; } r -= I_OUT;
            if (r < I_R) { const int n = r >> 3, kb = (r >> 2) & 1, nb = r & 3; p0_transpose_item(w_r + (size_t)n * 16384, 128, 32 * nb, WrT + (size_t)n * 16384, 128, 32 * nb, 64 * kb, scr, lane); continue; } r -= I_R;
            { const int n = r >> 3, kb = (r >> 2) & 1, nb = r & 3; p0_transpose_item(w_i + (size_t)n * 16384, 128, 32 * nb, WiT + (size_t)n * 16384, 128, 32 * nb, 64 * kb, scr, lane); }
        }
        __syncthreads();
        LAS float* wf = (LAS float*)ldsl;
#pragma unroll
        for (int i = 0; i < 4; ++i) { const int k = tid + 512 * i; const f32x4 a = *(const f32x4*)(w_in + (size_t)k * D_IN + 3072), b = *(const f32x4*)(w_in + (size_t)k * D_IN + 3076);
            wf[0 * 2048 + k] = a[0]; wf[1 * 2048 + k] = a[1]; wf[2 * 2048 + k] = a[2]; wf[3 * 2048 + k] = a[3]; wf[4 * 2048 + k] = b[0]; wf[5 * 2048 + k] = b[1]; wf[6 * 2048 + k] = b[2]; wf[7 * 2048 + k] = b[3]; }
        __syncthreads();
        const float bfl = (lane < 8) ? b_f[lane] : 0.f;
        for (int m = gw; m < M; m += NGW) {
            const float* xr = (m < MP) ? x_p + (size_t)m * DM : x_s + (size_t)(m - MP) * DM;
            f32x4 v[8];
#pragma unroll
            for (int j = 0; j < 8; ++j) v[j] = *(const f32x4*)(xr + 4 * lane + 256 * j);
            GAS unsigned long long* o8 = (GAS unsigned long long*)(XB + (size_t)m * DM) + lane;
#pragma unroll
            for (int j = 0; j < 8; ++j) o8[64 * j] = (unsigned long long)pk2(v[j][0], v[j][1]) | ((unsigned long long)pk2(v[j][2], v[j][3]) << 32);
            float acc[8];
#pragma unroll
            for (int h = 0; h < 8; ++h) { float a = 0.f;
#pragma unroll
                for (int j = 0; j < 8; ++j) { const f32x4 w = *(const LAS f32x4*)(wf + h * 2048 + 256 * j + 4 * lane); a = fmaf(v[j][0], w[0], a); a = fmaf(v[j][1], w[1], a); a = fmaf(v[j][2], w[2], a); a = fmaf(v[j][3], w[3], a); }
                acc[h] = wave_sum(a); asm volatile("" ::: "memory"); }
            float z = acc[0];
#pragma unroll
            for (int h = 1; h < 8; ++h) z = (lane == h) ? acc[h] : z;
            if (lane < 8) { z += bfl; const float lf = fminf(z, 0.f) - log1pf(expf(-fabsf(z)));
                float* fo = (m < MP) ? out + O_FP + (size_t)m * NH : out + O_FS + (size_t)(m - MP) * NH; fo[lane] = lf; }
        }
        if (BOTH(0)) GRID_BAR(0);
    }

    if (IN(1)) {
        REP(1) {
        pg8::Gemm g{XB, WinT, M, NIN, DM}; pg8::StaticOrder S; S.init(M, NIN, G, bx);
        pg8::EpiIn E{ACT, ACT_EL, out + O_KP, out + O_VP, out + O_KS, out + O_VS, out + O_CP, out + O_CS};
        pg8::gemm_phase<pg8::EpiIn, pg8::StaticOrder, true, true>(ldsl, g, S, E);
        }
        if (BOTH(1)) GRID_BAR(1);
    }

    if (IN(2)) {
        {
            const int gwr = (G - 1 - bx) * NWAVES + wave;
            for (int bh = gwr; bh < NB * NH; bh += G * NWAVES) { const int b = bh >> 3, h = bh & 7;
                const float* lf = out + O_FP + ((size_t)b * SEQ + 32 * lane) * NH + h;
                float v[32];
#pragma unroll
                for (int k = 0; k < 32; ++k) v[k] = lf[k * NH];
#pragma unroll
                for (int k = 1; k < 32; ++k) v[k] += v[k - 1];
                float incl = v[31];
#pragma unroll
                for (int off = 1; off < 64; off <<= 1) { const float t = __shfl_up(incl, off); if (lane >= off) incl += t; }
                const float excl = incl - v[31];
                float* bo = BIAS + (size_t)bh * SEQ + 32 * lane;
#pragma unroll
                for (int k = 0; k < 32; k += 4) *(f32x4*)(bo + k) = (f32x4){-(v[k] + excl) * sa::SQRTD, -(v[k + 1] + excl) * sa::SQRTD, -(v[k + 2] + excl) * sa::SQRTD, -(v[k + 3] + excl) * sa::SQRTD};
            }
        }
        lru::LTensors LT{(const pa::bf16*)XL, (const pa::bf16*)GL, (pa::bf16*)YC, (const pa::bf16*)WrT, (const pa::bf16*)WiT, args.in[9], args.in[10], args.in[12], args.in[14], args.in[15], args.in[17],
                         args.in[5], args.in[6], out + O_HP, out + O_HS};
#if defined(NO_LS)
        for (int u = bx; u < 128; u += G) lru::prompt_unit((char*)lds, LT, u >> 3, u & 7);
#elif defined(NO_LP)
        for (int u = bx; u < 8; u += G) lru::sample_unit((char*)lds, LT, u);
#else
        REP(2) for (int u = bx; u < 136; u += G) { if (u < 128) lru::prompt_unit((char*)lds, LT, u >> 3, u & 7); else lru::sample_unit((char*)lds, LT, u - 128); }
#endif
        if (BOTH(2)) GRID_BAR(2);
    }

    if (IN(3)) {
        const pa::PTensors PT{(const pa::bf16*)QB, (const pa::bf16*)KBf, (const pa::bf16*)VBf, BIAS, (const pa::bf16*)GA, (pa::bf16*)YC, args.in[16]};
#ifndef NO_PA
        REP(30) pa::attn_prompt_phase((char*)lds, PT, bx, G);
#endif
        const sa::STensors ST{(const pa::bf16*)(QB + (size_t)MP * 1024), (const pa::bf16*)(KBf + (size_t)MP * 1024), (const pa::bf16*)(VBf + (size_t)MP * 1024), args.in[2], args.in[3], args.in[4],
                              out + O_FS, (const pa::bf16*)(GA + (size_t)MP * 1024), (pa::bf16*)(YC + (size_t)MP * 2048), args.in[16]};
#ifndef NO_SA
        REP(31) for (int u = bx; u < DB * NH; u += G) sa::sample_unit((char*)lds, u >> 3, u & 7, ST);
#endif
        if (BOTH(3)) GRID_BAR(3);
    }

    if (IN(4)) {
        REP(4) {
        pg8::Gemm g{YC, WoutT, M, DM, DM}; pg8::StaticOrder S; S.init(M, DM, G, bx);
        pg8::EpiRes E{x_p, x_s, out + O_YP, ALPHA};
        pg8::gemm_phase<pg8::EpiRes, pg8::StaticOrder, true, true>(ldsl, g, S, E);
        }
        if (BOTH(4)) GRID_BAR(4);
    }

    if (IN(5)) {
        const int gw = bx * NWAVES + wave, NGW = G * NWAVES;
        const float* ln_g = args.in[19]; const float* ln_b = args.in[20];
        f32x4 gv[8], bv[8];
#pragma unroll
        for (int j = 0; j < 8; ++j) { gv[j] = *(const f32x4*)(ln_g + 4 * lane + 256 * j); bv[j] = *(const f32x4*)(ln_b + 4 * lane + 256 * j); }
        for (int m = gw; m < M; m += NGW) {
            float* yr = out + O_YP + (size_t)m * DM + 4 * lane;
            f32x4 v[8]; float s = 0.f;
#pragma unroll
            for (int j = 0; j < 8; ++j) { v[j] = *(const f32x4*)(yr + 256 * j); s += (v[j][0] + v[j][1]) + (v[j][2] + v[j][3]); }
            const float mean = wave_sum(s) * (1.f / DM); float s2 = 0.f;
#pragma unroll
            for (int j = 0; j < 8; ++j) { v[j] = v[j] - mean; s2 += (v[j][0] * v[j][0] + v[j][1] * v[j][1]) + (v[j][2] * v[j][2] + v[j][3] * v[j][3]); }
            const float rstd = 1.f / sqrtf(wave_sum(s2) * (1.f / DM) + LN_EPS);
#pragma unroll
            for (int j = 0; j < 8; ++j) *(f32x4*)(yr + 256 * j) = v[j] * rstd * gv[j] + bv[j];
        }
    }
#undef IN
#undef BOTH
#undef GRID_BAR
}

extern "C" void kernel_launch(void* const* d_in, const int* in_sizes, int n_in, void* d_out, int out_size, void* d_ws, size_t ws_size, hipStream_t stream) {
    static int grid = 0;
    if (grid == 0) {
        if (n_in != 21 || (size_t)out_size != O_END || ws_size < WS_END) { fprintf(stderr, "kernel_launch: unexpected shapes: n_in %d out %d ws %zu (need >= %zu); nothing launched\n", n_in, out_size, ws_size, (size_t)WS_END); grid = -1; return; }
        int dev = 0, cus = 0, per_cu = 0;
        if (hipGetDevice(&dev) != hipSuccess || hipDeviceGetAttribute(&cus, hipDeviceAttributeMultiprocessorCount, dev) != hipSuccess) { fprintf(stderr, "kernel_launch: device query failed\n"); grid = -1; return; }
        if (hipFuncSetAttribute((const void*)fwd_kernel, hipFuncAttributeMaxDynamicSharedMemorySize, LDS_BYTES) != hipSuccess) { fprintf(stderr, "kernel_launch: hipFuncSetAttribute failed\n"); grid = -1; return; }
        if (hipOccupancyMaxActiveBlocksPerMultiprocessor(&per_cu, (const void*)fwd_kernel, NWAVES * 64, LDS_BYTES) != hipSuccess || per_cu < 1)
            fprintf(stderr, "kernel_launch: note: occupancy query reports %d workgroups per CU\n", per_cu);
        (void)hipGetLastError();
        grid = cus;
    }
    if (grid < 0) return;
    if (hipMemsetAsync((char*)d_ws + WS_CTL, 0, CTL_ZERO_BYTES, stream) != hipSuccess) { fprintf(stderr, "kernel_launch: memset failed\n"); return; }
    Args a{};
    for (int i = 0; i < 21; ++i) a.in[i] = (const float*)d_in[i];
    a.out = (float*)d_out; a.ws = (unsigned char*)d_ws;
    if (N_LAUNCHES == 1) { a.ph_lo = 0; a.ph_hi = PER_PHASE; hipLaunchKernelGGL(fwd_kernel, dim3(grid), dim3(NWAVES * 64), LDS_BYTES, stream, a); }
    else { for (int li = 0; li < PER_PHASE; ++li) { a.ph_lo = li; a.ph_hi = li + 1; hipLaunchKernelGGL(fwd_kernel, dim3(grid), dim3(NWAVES * 64), LDS_BYTES, stream, a); } }
    const hipError_t le = hipPeekAtLastError();
    if (le != hipSuccess) fprintf(stderr, "kernel_launch: launch failed: %s\n", hipGetErrorName(le));
}
```

```cpp
#include <hip/hip_runtime.h>
#include <hip/hip_bf16.h>
#include <cstdio>
#include <cstdint>

#ifndef MK_N_LAUNCHES
#define MK_N_LAUNCHES 1
#endif

namespace pg8 {
#define PG8_LAS __attribute__((address_space(3)))
typedef unsigned short bf16_t;
typedef short bf16x8 __attribute__((ext_vector_type(8)));
typedef float f32x4 __attribute__((ext_vector_type(4)));
typedef unsigned u32x4 __attribute__((ext_vector_type(4)));
constexpr int BM = 256, BK = 64, HALF = 128, HTB = HALF * BK * 2  , STAGE_BYTES = 8 * HTB, NXCD = 8, WGM = 8;

__host__ __device__ __forceinline__ int lds_byte(int r, int c) { const int st = (r >> 4) * 2 + (c >> 5), rr = r & 15, cc = c & 31, ob = rr * 64 + cc * 2; return st * 1024 + (ob ^ (((ob >> 9) & 1) << 5)); }
__host__ __device__ __forceinline__ void stage_rc(int b, int& R, int& C) { const int st = b / 1024, sb = b % 1024, swz = sb ^ (((sb >> 9) & 1) << 5); R = (st >> 1) * 16 + swz / 64; C = (st & 1) * 32 + (swz % 64) / 2; }
__host__ __device__ __forceinline__ int perm32(int rho) { const int n = rho >> 4, i = rho & 15; return 8 * (i >> 2) + 4 * n + (i & 3); }

struct Unit { int pm, pn; };
struct Gemm { const bf16_t* A; const bf16_t* Bt; int M, N, K; };

struct StaticOrder {
    int nM, nN, nwg, G, c;
    __host__ __device__ void init(int M, int N, int G_, int c_) { nM = M / BM; nN = N / BM; nwg = nM * nN; G = G_; c = c_; }
    __host__ __device__ bool next(int i, Unit& u) const {
        const long L = (long)i * G + c; if (L >= nwg) return false;
        int wgid = (int)L; { const int q = nwg / NXCD, r = nwg % NXCD, xcd = wgid % NXCD, off = wgid / NXCD; wgid = (xcd < r ? xcd * (q + 1) : r * (q + 1) + (xcd - r) * q) + off; }
        const int nig = WGM * nN, gid = wgid / nig, fm = gid * WGM, gsz = (nM - fm) < WGM ? (nM - fm) : WGM;
        u.pm = fm + ((wgid % nig) % gsz); u.pn = (wgid % nig) / gsz; return true;
    }
    __device__ __forceinline__ void a_ready(const Unit&) const {}
    __device__ __forceinline__ void done(const Unit&) const {}
};

__device__ __forceinline__ unsigned cvt_pk_bf16(float lo, float hi) { unsigned r; asm volatile("v_cvt_pk_bf16_f32 %0, %1, %2" : "=v"(r) : "v"(lo), "v"(hi)); return r; }
__device__ __forceinline__ float silu_f(float v) { return v * __builtin_amdgcn_rcpf(1.0f + __builtin_amdgcn_exp2f(-1.4426950408889634f * v)); }

struct EpiIn {
    static constexpr bool PERM = true, AFTER_DRAIN = false;
    bf16_t* act; size_t act_stride;
    float* kout_p; float* vout_p; float* kout_s; float* vout_s; float* conv_p; float* conv_s;
    __device__ __forceinline__ void operator()(const f32x4 (&acc)[2][2][4][2], const Unit& u, int wr, int wc, int fr, int fq) const {
        const int ty = u.pn >> 2, colt = (u.pn & 3) * BM;
        const int row0 = u.pm * BM + wr * 64 + fr, col0 = colt + wc * 32 + 8 * fq;
        const bool samp = u.pm >= 128; const int rofs = samp ? 32768 : 0;
        bf16_t* base = act + (size_t)ty * act_stride;
        float* fo = (ty == 1) ? (samp ? kout_s : kout_p) : ((ty == 2) ? (samp ? vout_s : vout_p) : nullptr);
        const bool do_silu = (ty == 3) || (ty == 5);
#pragma unroll
        for (int ai = 0; ai < 2; ++ai)
#pragma unroll
            for (int m = 0; m < 4; ++m) { const int row = row0 + ai * HALF + m * 16; bf16_t* rowp = base + (size_t)row * 1024 + col0;
#pragma unroll
                for (int bj = 0; bj < 2; ++bj) { f32x4 v0 = acc[ai][bj][m][0], v1 = acc[ai][bj][m][1];
                    if (fo) { float* fp = fo + (size_t)(row - rofs) * 1024 + col0 + bj * HALF; *(f32x4*)fp = v0; *(f32x4*)(fp + 4) = v1; }
                    if (ty == 4) {
                        const int rl = row - rofs; const int t = samp ? (rl & 31) : (rl & 2047); const int tl = samp ? 29 : 2045;
                        if (t >= tl) { float* cp = (samp ? conv_s + (size_t)((rl >> 5) * 3 + (t - tl)) * 1024 : conv_p + (size_t)((rl >> 11) * 3 + (t - tl)) * 1024) + col0 + bj * HALF;
                            *(f32x4*)cp = v0; *(f32x4*)(cp + 4) = v1; }
                    }
                    if (do_silu) { v0[0] = silu_f(v0[0]); v0[1] = silu_f(v0[1]); v0[2] = silu_f(v0[2]); v0[3] = silu_f(v0[3]); v1[0] = silu_f(v1[0]); v1[1] = silu_f(v1[1]); v1[2] = silu_f(v1[2]); v1[3] = silu_f(v1[3]); }
                    u32x4 w; w.x = cvt_pk_bf16(v0[0], v0[1]); w.y = cvt_pk_bf16(v0[2], v0[3]); w.z = cvt_pk_bf16(v1[0], v1[1]); w.w = cvt_pk_bf16(v1[2], v1[3]);
                    *(u32x4*)(rowp + bj * HALF) = w; } }
    }
};
struct EpiOut {
    static constexpr bool PERM = true, AFTER_DRAIN = false;
    bf16_t* O;
    __device__ __forceinline__ void operator()(const f32x4 (&acc)[2][2][4][2], const Unit& u, int wr, int wc, int fr, int fq) const {
        const int row0 = u.pm * BM + wr * 64 + fr, col0 = u.pn * BM + wc * 32 + 8 * fq;
#pragma unroll
        for (int ai = 0; ai < 2; ++ai)
#pragma unroll
            for (int m = 0; m < 4; ++m) { bf16_t* rowp = O + (size_t)(row0 + ai * HALF + m * 16) * 2048 + col0;
#pragma unroll
                for (int bj = 0; bj < 2; ++bj) { const f32x4 v0 = acc[ai][bj][m][0], v1 = acc[ai][bj][m][1];
                    u32x4 w; w.x = cvt_pk_bf16(v0[0], v0[1]); w.y = cvt_pk_bf16(v0[2], v0[3]); w.z = cvt_pk_bf16(v1[0], v1[1]); w.w = cvt_pk_bf16(v1[2], v1[3]);
                    *(u32x4*)(rowp + bj * HALF) = w; } }
    }
};
template <class Epi, class Sched, bool ALIGN_EPI = false, bool SP2 = false>
__device__ __forceinline__ void gemm_phase(PG8_LAS unsigned char* lds, const Gemm g, const Sched& S, const Epi& E) {
    const int tid = threadIdx.x, wid = __builtin_amdgcn_readfirstlane(tid >> 6), lane = tid & 63, wr = wid >> 2, wc = wid & 3, fr = lane & 15, fq = lane >> 4;
    const int K = g.K, nt = K / BK;
    unsigned voffA[2], voffB[2];
#pragma unroll
    for (int i = 0; i < 2; ++i) { int R, C; stage_rc(tid * 16 + i * 8192, R, C); const int Rb = Epi::PERM ? ((R & ~31) + perm32(R & 31)) : R;
        voffA[i] = (unsigned)(R * K + C) * 2u; voffB[i] = (unsigned)(Rb * K + C) * 2u; }
    const size_t kstep = (size_t)(BK * 2);
    const size_t hstep = (size_t)HALF * K * 2;
    const size_t tstep = 2 * hstep;
    const unsigned ldsw = (unsigned)wid * 1024u;
    const int aoff = lds_byte(wr * 64 + fr, fq * 8), boff = lds_byte(wc * 32 + fr, fq * 8);
#define PG8_SA(b, h) (((b) * 2 + (h)) * HTB)
#define PG8_SB(b, h) ((4 + (b) * 2 + (h)) * HTB)
#define PG8_STAGE(bufoff, gbase, voff) do { _Pragma("unroll") for (int _i = 0; _i < 2; ++_i) \
        __builtin_amdgcn_global_load_lds((const unsigned*)((const char*)(gbase) + (voff)[_i]), (PG8_LAS unsigned*)(lds + (bufoff) + ldsw + _i * 8192), 16, 0, 0); } while (0)
#define PG8_LDA(dst, b, h) do { _Pragma("unroll") for (int m = 0; m < 4; ++m) _Pragma("unroll") for (int k = 0; k < 2; ++k) dst[m][k] = *(const PG8_LAS bf16x8*)(lds + PG8_SA(b, h) + aoff + m * 2048 + k * 1024); } while (0)
#define PG8_LDB(dst, b, h) do { _Pragma("unroll") for (int n = 0; n < 2; ++n) _Pragma("unroll") for (int k = 0; k < 2; ++k) dst[n][k] = *(const PG8_LAS bf16x8*)(lds + PG8_SB(b, h) + boff + n * 2048 + k * 1024); } while (0)
#define PG8_MMA(ai, bj, At, Bt) do { __builtin_amdgcn_s_setprio(1); _Pragma("unroll") for (int m = 0; m < 4; ++m) _Pragma("unroll") for (int n = 0; n < 2; ++n) _Pragma("unroll") for (int k = 0; k < 2; ++k) \
        acc[ai][bj][m][n] = __builtin_amdgcn_mfma_f32_16x16x32_bf16(Bt[n][k], At[m][k], acc[ai][bj][m][n], 0, 0, 0); __builtin_amdgcn_s_setprio(0); } while (0)
#define PG8_WAIT_V(n) asm volatile("s_waitcnt vmcnt(" #n ")" ::: "memory")
#define PG8_WAIT_L(n) asm volatile("s_waitcnt lgkmcnt(" #n ")" ::: "memory")
#define PG8_BAR __builtin_amdgcn_s_barrier()
#define PG8_SCHED __builtin_amdgcn_sched_barrier(0)
    Unit cur, nxt; int ui = 0;
    if (!S.next(0, cur)) return;
    f32x4 acc[2][2][4][2];
#pragma unroll
    for (int a = 0; a < 2; ++a)
#pragma unroll
        for (int b = 0; b < 2; ++b)
#pragma unroll
            for (int m = 0; m < 4; ++m)
#pragma unroll
                for (int n = 0; n < 2; ++n) acc[a][b][m][n] = (f32x4){0.f, 0.f, 0.f, 0.f};
    bf16x8 At[4][2], B0[2][2], B1[2][2];
    const char* cA = (const char*)g.A + (size_t)cur.pm * tstep; const char* cB = (const char*)g.Bt + (size_t)cur.pn * tstep;
    S.a_ready(cur);
    if constexpr (SP2) {
        PG8_STAGE(PG8_SB(0, 0), cB, voffB); PG8_STAGE(PG8_SB(0, 1), cB + hstep, voffB); PG8_STAGE(PG8_SA(0, 0), cA, voffA); PG8_STAGE(PG8_SA(0, 1), cA + hstep, voffA);
        if (wr == 1) PG8_BAR;
        PG8_WAIT_V(2); PG8_BAR;
        PG8_STAGE(PG8_SB(1, 0), cB + kstep, voffB); PG8_STAGE(PG8_SA(1, 0), cA + kstep, voffA); PG8_STAGE(PG8_SB(1, 1), cB + hstep + kstep, voffB);
        PG8_WAIT_V(6); PG8_BAR;
    } else {
        PG8_STAGE(PG8_SB(0, 0), cB, voffB); PG8_STAGE(PG8_SA(0, 0), cA, voffA); PG8_STAGE(PG8_SB(0, 1), cB + hstep, voffB); PG8_STAGE(PG8_SA(0, 1), cA + hstep, voffA);
        if (wr == 1) PG8_BAR;
        PG8_WAIT_V(4); PG8_BAR;
        PG8_STAGE(PG8_SB(1, 0), cB + kstep, voffB); PG8_STAGE(PG8_SA(1, 0), cA + kstep, voffA); PG8_STAGE(PG8_SB(1, 1), cB + hstep + kstep, voffB);
        PG8_WAIT_V(6); PG8_BAR;
    }
    for (;;) {
        const bool has_next = S.next(ui + 1, nxt);
        const char* nA = has_next ? (const char*)g.A + (size_t)nxt.pm * tstep : cA; const char* nB = has_next ? (const char*)g.Bt + (size_t)nxt.pn * tstep : cB;
        for (int t = 0; t < nt; t += 2) {
            const bool last = (t == nt - 2);
            const char* a1 = cA + (size_t)(t + 1) * kstep;
            const char* a2 = last ? nA : cA + (size_t)(t + 2) * kstep; const char* b2 = last ? nB : cB + (size_t)(t + 2) * kstep;
            const char* a3 = a2 + kstep; const char* b3 = b2 + kstep;
            if (last && has_next) S.a_ready(nxt);
            if constexpr (SP2) {
            PG8_LDB(B0, 0, 0); PG8_LDB(B1, 0, 1); PG8_SCHED; PG8_LDA(At, 0, 0); PG8_STAGE(PG8_SA(1, 1), a1 + hstep, voffA);
            PG8_WAIT_V(8); PG8_WAIT_L(0); PG8_BAR; PG8_MMA(0, 0, At, B0); PG8_MMA(0, 1, At, B1); PG8_BAR; PG8_SCHED;
            PG8_LDA(At, 0, 1); PG8_STAGE(PG8_SB(0, 0), b2, voffB); PG8_STAGE(PG8_SB(0, 1), b2 + hstep, voffB); PG8_STAGE(PG8_SA(0, 0), a2, voffA);
            PG8_WAIT_V(8); PG8_WAIT_L(0); PG8_BAR; PG8_MMA(1, 0, At, B0); PG8_MMA(1, 1, At, B1); PG8_BAR; PG8_SCHED;
            PG8_LDB(B0, 1, 0); PG8_LDB(B1, 1, 1); PG8_SCHED; PG8_LDA(At, 1, 0); PG8_STAGE(PG8_SA(0, 1), a2 + hstep, voffA);
            PG8_WAIT_V(8); PG8_WAIT_L(0); PG8_BAR; PG8_MMA(0, 0, At, B0); PG8_MMA(0, 1, At, B1); PG8_BAR; PG8_SCHED;
            PG8_LDA(At, 1, 1); PG8_STAGE(PG8_SB(1, 0), b3, voffB); PG8_STAGE(PG8_SB(1, 1), b3 + hstep, voffB); PG8_STAGE(PG8_SA(1, 0), a3, voffA);
            PG8_WAIT_V(8); PG8_WAIT_L(0); PG8_BAR; PG8_MMA(1, 0, At, B0); PG8_MMA(1, 1, At, B1); PG8_BAR; PG8_SCHED;
            } else {
            PG8_LDB(B0, 0, 0); PG8_SCHED; PG8_LDA(At, 0, 0); PG8_STAGE(PG8_SA(1, 1), a1 + hstep, voffA);
            PG8_WAIT_L(8); PG8_BAR; PG8_WAIT_L(0); PG8_MMA(0, 0, At, B0); PG8_BAR; PG8_SCHED;
            PG8_LDB(B1, 0, 1); PG8_STAGE(PG8_SB(0, 0), b2, voffB);
            PG8_BAR; PG8_WAIT_L(0); PG8_MMA(0, 1, At, B1); PG8_BAR;
            PG8_LDA(At, 0, 1); PG8_STAGE(PG8_SA(0, 0), a2, voffA);
            PG8_BAR; PG8_WAIT_L(0); PG8_MMA(1, 0, At, B0); PG8_BAR; PG8_SCHED;
            PG8_STAGE(PG8_SB(0, 1), b2 + hstep, voffB);
            PG8_WAIT_V(6); PG8_BAR; PG8_MMA(1, 1, At, B1); PG8_BAR;
            PG8_LDB(B0, 1, 0); PG8_SCHED; PG8_LDA(At, 1, 0); PG8_STAGE(PG8_SA(0, 1), a2 + hstep, voffA);
            PG8_WAIT_L(8); PG8_BAR; PG8_WAIT_L(0); PG8_MMA(0, 0, At, B0); PG8_BAR; PG8_SCHED;
            PG8_LDB(B1, 1, 1); PG8_STAGE(PG8_SB(1, 0), b3, voffB);
            PG8_BAR; PG8_WAIT_L(0); PG8_MMA(0, 1, At, B1); PG8_BAR;
            PG8_LDA(At, 1, 1); PG8_STAGE(PG8_SA(1, 0), a3, voffA);
            PG8_BAR; PG8_WAIT_L(0); PG8_MMA(1, 0, At, B0); PG8_BAR; PG8_SCHED;
            PG8_STAGE(PG8_SB(1, 1), b3 + hstep, voffB);
            PG8_WAIT_V(6); PG8_BAR; PG8_MMA(1, 1, At, B1); PG8_BAR;
            }
        }
        if constexpr (ALIGN_EPI) { if (wr == 0) PG8_BAR; }
        if constexpr (!Epi::AFTER_DRAIN) { E(acc, cur, wr, wc, fr, fq); S.done(cur); }
        if (!has_next) break;
#pragma unroll
        for (int a = 0; a < 2; ++a)
#pragma unroll
            for (int b = 0; b < 2; ++b)
#pragma unroll
                for (int m = 0; m < 4; ++m)
#pragma unroll
                    for (int n = 0; n < 2; ++n) acc[a][b][m][n] = (f32x4){0.f, 0.f, 0.f, 0.f};
        cur = nxt; cA = nA; cB = nB; ++ui;
        if constexpr (ALIGN_EPI) { if (wr == 1) PG8_BAR; }
    }
    PG8_WAIT_V(0);
    if constexpr (!ALIGN_EPI) { if (wr == 0) PG8_BAR; }
    PG8_BAR;
    if constexpr (Epi::AFTER_DRAIN) { E.fused(acc, cur, wr, wc, fr, fq, lds, wid, lane); S.done(cur); }
#undef PG8_SA
#undef PG8_SB
#undef PG8_STAGE
#undef PG8_LDA
#undef PG8_LDB
#undef PG8_MMA
#undef PG8_WAIT_V
#undef PG8_WAIT_L
#undef PG8_BAR
#undef PG8_SCHED
}
}

namespace pa {
using bf16 = __hip_bfloat16;
typedef short bf16x8 __attribute__((ext_vector_type(8)));
typedef short s16x4 __attribute__((ext_vector_type(4)));
typedef float f32x16 __attribute__((ext_vector_type(16)));
typedef float f32x4 __attribute__((ext_vector_type(4)));
typedef unsigned u32x4 __attribute__((ext_vector_type(4)));
template <class A, class Bt> struct same_t { static constexpr bool v = false; };
template <class A> struct same_t<A, A> { static constexpr bool v = true; };
constexpr int D = 128, LDR = 1024, LDY = 2048;
constexpr float SCALE = 0.08838834764831845f;
constexpr float THR = 8.f;
constexpr int NW = 8, QBLK = 32, KVBLK = 64, QB = NW * QBLK;
constexpr int SHM_V = KVBLK * D * 2, SHM_K = KVBLK * D * 2;
constexpr int LDS_WS = 2 * SHM_V + 2 * SHM_K, LDS_BIAS = LDS_WS + NW * 64 * 4, LDS_BYTES = LDS_BIAS + 2 * 2048 * 4;
enum { ORDER_NATURAL = 0, ORDER_REVERSED = 1, ORDER_PAIRED = 2, ORDER_XCD = 4 };
#define KSWZ(row, colB) ((row) * 256 + ((colB) ^ (((row) & 7) << 4)))
#define SBAR() __builtin_amdgcn_sched_barrier(0)
__device__ __forceinline__ int v_st(int k, int c) { const int kk = (k & ~0xC) | ((k & 4) << 1) | ((k & 8) >> 1); return ((kk >> 3) * 4 + (c >> 5)) * 512 + ((kk & 7) * 32 + (c & 31)) * 2; }
__device__ __forceinline__ int v_rd_base(int lane) { return ((lane & 3) << 3) | (((lane >> 2) & 3) << 6) | (((lane >> 4) & 1) << 5) | (((lane >> 5) & 1) << 8); }
constexpr int v_rd_off(int d0, int ks, int half) { return d0 * 512 + ks * 4096 + half * 2048; }
__device__ __forceinline__ int crow(int r, int hi) { return (r & 3) + 8 * (r >> 2) + 4 * hi; }
__device__ __forceinline__ unsigned cvtpk(float lo, float hi) {
    unsigned r; asm volatile("v_cvt_pk_bf16_f32 %0, %1, %2" : "=v"(r) : "v"(lo), "v"(hi)); return r;
}
__device__ __forceinline__ bf16x8 pack8(f32x4 a, f32x4 b) {
    u32x4 w = {cvtpk(a[0], a[1]), cvtpk(a[2], a[3]), cvtpk(b[0], b[1]), cvtpk(b[2], b[3])};
    return *reinterpret_cast<bf16x8*>(&w);
}
template <class T> __device__ __forceinline__ bf16x8 load8(const T* p) {
    if constexpr (same_t<T, float>::v) { return pack8(*(const f32x4*)p, *(const f32x4*)(p + 4)); }
    else { return *reinterpret_cast<const bf16x8*>(p); }
}
__device__ __forceinline__ void mask_tile(f32x16& p0, f32x16& p1, int dq, unsigned W) {
    const float NEG = -__builtin_inff();
#pragma unroll
    for (int r = 0; r < 16; ++r) {
        const int c = (r & 3) + 8 * (r >> 2);
        if ((unsigned)(dq - c) >= W) p0[r] = NEG;
        if ((unsigned)(dq - c - 32) >= W) p1[r] = NEG;
    }
}
__device__ __forceinline__ void partialSM(f32x16& p0, f32x16& p1, float& m_reg, float& mn, float& alpha) {
    float pmax = p0[0]; for (int r = 1; r < 16; ++r) pmax = fmaxf(pmax, p0[r]); for (int r = 0; r < 16; ++r) pmax = fmaxf(pmax, p1[r]);
    { auto rr = __builtin_amdgcn_permlane32_swap(__float_as_uint(pmax), __float_as_uint(pmax), false, false);
      pmax = fmaxf(__uint_as_float(rr[0]), __uint_as_float(rr[1])); }
    constexpr float C2 = 1.4426950408889634f * SCALE;
    if (__builtin_expect(__all((pmax - m_reg) * SCALE <= THR), 1)) { mn = m_reg; alpha = 1.f; }
    else { mn = fmaxf(m_reg, pmax); alpha = __builtin_amdgcn_exp2f((m_reg - mn) * C2); m_reg = mn; }
    const float mnL = -mn * C2;
    for (int r = 0; r < 16; ++r) p0[r] = fmaf(p0[r], C2, mnL); for (int r = 0; r < 16; ++r) p1[r] = fmaf(p1[r], C2, mnL);
    for (int r = 0; r < 16; ++r) p0[r] = __builtin_amdgcn_exp2f(p0[r]);
}
__device__ __forceinline__ void finishSM(f32x16& p0, f32x16& p1, float alpha, float& l_reg, bf16x8& pa0, bf16x8& pa1, bf16x8& pa2, bf16x8& pa3) {
    for (int r = 0; r < 16; ++r) p1[r] = __builtin_amdgcn_exp2f(p1[r]);
    float ps = 0; for (int r = 0; r < 16; ++r) ps += p0[r]; for (int r = 0; r < 16; ++r) ps += p1[r];
    { auto rr = __builtin_amdgcn_permlane32_swap(__float_as_uint(ps), __float_as_uint(ps), false, false);
      ps = __uint_as_float(rr[0]) + __uint_as_float(rr[1]); }
    l_reg = l_reg * alpha + ps;
#define PK4(P, B_, OUT) do { unsigned a0 = cvtpk(P[B_+0], P[B_+1]), a1 = cvtpk(P[B_+2], P[B_+3]);                          \
        unsigned b0 = cvtpk(P[B_+4], P[B_+5]), b1 = cvtpk(P[B_+6], P[B_+7]);                                             \
        auto r0 = __builtin_amdgcn_permlane32_swap(a0, b0, false, false); auto r1 = __builtin_amdgcn_permlane32_swap(a1, b1, false, false); \
        u32x4 w = {r0[0], r1[0], r0[1], r1[1]}; OUT = *reinterpret_cast<bf16x8*>(&w); } while (0)
    PK4(p0, 0, pa0); PK4(p0, 8, pa1); PK4(p1, 0, pa2); PK4(p1, 8, pa3);
#undef PK4
}
template <int KB>
__device__ __forceinline__ void qkt(f32x16& p0, f32x16& p1, const char* K_lds, const char* bias_t, int r32, int hi, const bf16x8* qr) {
    { const f32x4 b0 = *(const f32x4*)(bias_t), b1 = *(const f32x4*)(bias_t + 32), b2 = *(const f32x4*)(bias_t + 64), b3 = *(const f32x4*)(bias_t + 96);
      const f32x4 c0 = *(const f32x4*)(bias_t + 128), c1 = *(const f32x4*)(bias_t + 160), c2 = *(const f32x4*)(bias_t + 192), c3 = *(const f32x4*)(bias_t + 224);
      p0 = (f32x16){b0[0], b0[1], b0[2], b0[3], b1[0], b1[1], b1[2], b1[3], b2[0], b2[1], b2[2], b2[3], b3[0], b3[1], b3[2], b3[3]};
      p1 = (f32x16){c0[0], c0[1], c0[2], c0[3], c1[0], c1[1], c1[2], c1[3], c2[0], c2[1], c2[2], c2[3], c3[0], c3[1], c3[2], c3[3]}; }
    const char* kb[4];
#pragma unroll
    for (int dd = 0; dd < 4; ++dd) kb[dd] = K_lds + KB * SHM_K + KSWZ(r32, (dd * 16 + hi * 8) * 2);
#pragma unroll
    for (int d0 = 0; d0 < 8; ++d0) { const char* a = kb[d0 & 3] + (d0 >> 2) * 128;
        bf16x8 b0 = *reinterpret_cast<const bf16x8*>(a);
        bf16x8 b1 = *reinterpret_cast<const bf16x8*>(a + 32 * 256);
        p0 = __builtin_amdgcn_mfma_f32_32x32x16_bf16(b0, qr[d0], p0, 0, 0, 0);
        p1 = __builtin_amdgcn_mfma_f32_32x32x16_bf16(b1, qr[d0], p1, 0, 0, 0); }
}
template <int VB>
__device__ __forceinline__ void pv_tile(f32x16* o, int vb0, bf16x8 pa0, bf16x8 pa1, bf16x8 pa2, bf16x8 pa3) {
#define TRRD(dst, off) asm volatile("ds_read_b64_tr_b16 %0, %1 offset:%2" : "=&v"(dst) : "v"(vb0), "i"(off) : "memory")
#define PV_D0(d0) do { s16x4 l0, l1, l2, l3, h0, h1, h2, h3; constexpr int b_ = VB * SHM_V + v_rd_off(d0, 0, 0);     \
        TRRD(l0, b_); TRRD(h0, b_ + 2048); TRRD(l1, b_ + 4096); TRRD(h1, b_ + 6144); TRRD(l2, b_ + 8192); TRRD(h2, b_ + 10240); TRRD(l3, b_ + 12288); TRRD(h3, b_ + 14336); \
        asm volatile("s_waitcnt lgkmcnt(0)" ::: "memory"); SBAR();                 \
        o[d0] = __builtin_amdgcn_mfma_f32_32x32x16_bf16(pa0, (bf16x8){l0[0], l0[1], l0[2], l0[3], h0[0], h0[1], h0[2], h0[3]}, o[d0], 0, 0, 0);   \
        o[d0] = __builtin_amdgcn_mfma_f32_32x32x16_bf16(pa1, (bf16x8){l1[0], l1[1], l1[2], l1[3], h1[0], h1[1], h1[2], h1[3]}, o[d0], 0, 0, 0);   \
        o[d0] = __builtin_amdgcn_mfma_f32_32x32x16_bf16(pa2, (bf16x8){l2[0], l2[1], l2[2], l2[3], h2[0], h2[1], h2[2], h2[3]}, o[d0], 0, 0, 0);   \
        o[d0] = __builtin_amdgcn_mfma_f32_32x32x16_bf16(pa3, (bf16x8){l3[0], l3[1], l3[2], l3[3], h3[0], h3[1], h3[2], h3[3]}, o[d0], 0, 0, 0); } while (0)
    PV_D0(0); PV_D0(1); PV_D0(2); PV_D0(3);
#undef PV_D0
#undef TRRD
}

struct BlockRef { const bf16* Q; const bf16* K; const bf16* V; const float* Bias; const bf16* GA; bf16* Y; const float* gattn; int P0; };
struct Seam { bf16x8 qr[8]; bf16x8 st_v0, st_v1, st_k0, st_k1; };
#define ROW(p, k0, rr) ((p) + (size_t)((k0) + (rr)) * LDR + sc)
#define VMW() asm volatile("s_waitcnt vmcnt(0)" ::: "memory")
#define VMWN(n) asm volatile("s_waitcnt vmcnt(%0)" :: "i"(n) : "memory")
#define SLOAD_H(Kp, Vp, k0) do { S.st_v0 = load8<bf16>(ROW(Vp, k0, sr)); S.st_v1 = load8<bf16>(ROW(Vp, k0, 32 + sr));              \
                         S.st_k0 = load8<bf16>(ROW(Kp, k0, sr)); S.st_k1 = load8<bf16>(ROW(Kp, k0, 32 + sr)); } while (0)
#define SWRITE_HK(bf) do { *(bf16x8*)(K_lds + (bf) * SHM_K + kws) = S.st_k0; *(bf16x8*)(K_lds + (bf) * SHM_K + kws + 32 * 256) = S.st_k1; } while (0)
#define SWRITE_HV(bf) do { *(bf16x8*)(V_lds + (bf) * SHM_V + vst0) = S.st_v0; *(bf16x8*)(V_lds + (bf) * SHM_V + vst1) = S.st_v1; } while (0)
#define SWRITE_H(bf) do { SWRITE_HV(bf); SWRITE_HK(bf); } while (0)
__device__ __forceinline__ void causal_prime(const BlockRef& cur, char* lds, Seam& S) {
    const int tid = threadIdx.x, wid = __builtin_amdgcn_readfirstlane(tid >> 6), lane = tid & 63, r32 = lane & 31, hi = lane >> 5;
    const int sr = tid >> 4, sc = (tid & 15) * 8, kws = KSWZ(sr, sc * 2); char* K_lds = lds + 2 * SHM_V;
#pragma unroll
    for (int d0 = 0; d0 < 8; ++d0) S.qr[d0] = load8<bf16>(cur.Q + (size_t)(wid * QBLK + r32) * LDR + d0 * 16 + hi * 8);
    SLOAD_H(cur.K, cur.V, 0);
    if (tid * 4 < cur.P0 + QB) *(f32x4*)(lds + LDS_BIAS + tid * 16) = *(const f32x4*)(cur.Bias + tid * 4);
    VMW(); SWRITE_HK(0);
    __syncthreads();
}
__device__ __forceinline__ void causal_block(const BlockRef& cur, const BlockRef& nxt, char* lds, Seam& S, int par  ) {
    int tid = threadIdx.x; asm volatile("" : "+v"(tid));
    const int wid = __builtin_amdgcn_readfirstlane(tid >> 6), lane = tid & 63, r32 = lane & 31, hi = lane >> 5;
    const int NT = (cur.P0 + QB) / KVBLK;
    const int qlo = cur.P0 + wid * QBLK, qm = qlo + r32 - 4 * hi;
    char* V_lds = lds; char* K_lds = lds + 2 * SHM_V;
    const char* bias_l = lds + LDS_BIAS + par * 8192 + hi * 16;
    float* ws = (float*)(lds + LDS_WS) + wid * 64; float* li_l = ws, * al_l = ws + 32;
    float m_reg = -1e30f, l_reg = 0; f32x16 o[4] = {};
    const int sr = tid >> 4, sc = (tid & 15) * 8, vst0 = v_st(sr, sc), vst1 = v_st(32 + sr, sc), kws = KSWZ(sr, sc * 2);
    const int vb0 = (int)(uintptr_t)V_lds + v_rd_base(lane);
    const bf16* Kh = cur.K; const bf16* Vh = cur.V;
#define RESC(a) do { if (__any((a) < 1.f)) { if (hi == 0) al_l[r32] = (a); asm volatile("s_waitcnt lgkmcnt(0)" ::: "memory");              \
                     for (int d_ = 0; d_ < 4; ++d_) for (int r = 0; r < 16; ++r) o[d_][r] *= al_l[crow(r, hi)]; } } while (0)
#define KBASE(t) ((t) * KVBLK)
#define MASKT(P0_, P1_, t) do { const int kb_ = KBASE(t); if (kb_ + KVBLK - 1 > qlo) mask_tile(P0_, P1_, qm - kb_, 0x40000000u); } while (0)
#define SEAM_K0() do { VMWN(8); SWRITE_HK(0); SBAR(); } while (0)
    f32x16 pA0, pA1, pB0, pB1; float mnA, mnB, alA, alB; bf16x8 pa0, pa1, pa2, pa3;
    SWRITE_HV(0); SBAR();
    if (NT > 1) SLOAD_H(Kh, Vh, KBASE(1));
    SBAR(); qkt<0>(pA0, pA1, K_lds, bias_l + KBASE(0) * 4, r32, hi, S.qr);
    MASKT(pA0, pA1, 0); partialSM(pA0, pA1, m_reg, mnA, alA);
    if (NT > 1) { VMW(); SWRITE_H(1); }
    __syncthreads();
#define HALF_STEP(PX0, PX1, mnX, alX, PY0, PY1, alY, t, KB, VB, SB) do {                                                      \
        SBAR(); qkt<KB>(PX0, PX1, K_lds, bias_l + KBASE(t) * 4, r32, hi, S.qr);                                               \
        finishSM(PY0, PY1, alY, l_reg, pa0, pa1, pa2, pa3); SBAR();                                                           \
        if ((t) + 1 < NT) { SLOAD_H(Kh, Vh, KBASE((t) + 1)); SBAR(); }                                                        \
        pv_tile<VB>(o, vb0, pa0, pa1, pa2, pa3); MASKT(PX0, PX1, (t)); partialSM(PX0, PX1, m_reg, mnX, alX);                  \
        __syncthreads();                                                                                                      \
        if ((t) + 1 < NT) { VMW(); SWRITE_H(SB); }                                                                            \
        RESC(alX); __syncthreads(); } while (0)
    for (int t = 1; t + 1 < NT; t += 2) {
        HALF_STEP(pB0, pB1, mnB, alB, pA0, pA1, alA, t, 1, 0, 0);
        HALF_STEP(pA0, pA1, mnA, alA, pB0, pB1, alB, t + 1, 0, 1, 1);
    }
    const bool even = (NT & 1) == 0;
    if (even) { SBAR(); qkt<1>(pB0, pB1, K_lds, bias_l + KBASE(NT - 1) * 4, r32, hi, S.qr); SBAR(); }
    __builtin_amdgcn_global_load_lds((const __attribute__((address_space(1))) unsigned*)(nxt.Bias + tid * 4), (__attribute__((address_space(3))) unsigned*)(lds + LDS_BIAS + (par ^ 1) * 8192 + wid * 1024), 16, 0, 0);
    SBAR();
    SLOAD_H(nxt.K, nxt.V, 0); SBAR();
#pragma unroll
    for (int d0 = 0; d0 < 8; ++d0) S.qr[d0] = load8<bf16>(nxt.Q + (size_t)(wid * QBLK + r32) * LDR + d0 * 16 + hi * 8);
    SBAR();
    finishSM(pA0, pA1, alA, l_reg, pa0, pa1, pa2, pa3); SBAR();
    pv_tile<0>(o, vb0, pa0, pa1, pa2, pa3);
    if (even) { MASKT(pB0, pB1, NT - 1); partialSM(pB0, pB1, m_reg, mnB, alB); __syncthreads(); RESC(alB);
        finishSM(pB0, pB1, alB, l_reg, pa0, pa1, pa2, pa3); SBAR(); pv_tile<1>(o, vb0, pa0, pa1, pa2, pa3); }
    SBAR(); SEAM_K0();
    if (hi == 0) li_l[r32] = l_reg; asm volatile("s_waitcnt lgkmcnt(0)" ::: "memory");
    float rs[16];
#pragma unroll
    for (int r = 0; r < 16; ++r) { const float rl = __builtin_amdgcn_rcpf(li_l[crow(r, hi)]); float s = 0.f;
#pragma unroll
        for (int d0 = 0; d0 < 4; ++d0) { o[d0][r] *= rl; s = fmaf(o[d0][r], o[d0][r], s); }
        s += __shfl_xor(s, 1); s += __shfl_xor(s, 2); s += __shfl_xor(s, 4); s += __shfl_xor(s, 8); s += __shfl_xor(s, 16);
        rs[r] = __builtin_amdgcn_rsqf(s * (1.0f / 128.0f) + 1e-6f); }
    float gw[4];
#pragma unroll
    for (int d0 = 0; d0 < 4; ++d0) gw[d0] = cur.gattn[d0 * 32 + r32];
#pragma unroll
    for (int rh = 0; rh < 2; ++rh) {
        unsigned short gq[8][4];
#pragma unroll
        for (int r8 = 0; r8 < 8; ++r8) { const int orow = wid * QBLK + crow(rh * 8 + r8, hi);
#pragma unroll
            for (int d0 = 0; d0 < 4; ++d0) gq[r8][d0] = *(const unsigned short*)(cur.GA + (size_t)orow * LDR + d0 * 32 + r32); }
#pragma unroll
        for (int r8 = 0; r8 < 8; ++r8) { const int r = rh * 8 + r8, orow = wid * QBLK + crow(r, hi);
#pragma unroll
            for (int d0 = 0; d0 < 4; ++d0) { const float ga = __uint_as_float((unsigned)gq[r8][d0] << 16);
                const float v = o[d0][r] * rs[r] * gw[d0] * ga; const float vn = __shfl_xor(v, 1);
                if ((r32 & 1) == 0) *(unsigned*)(cur.Y + (size_t)orow * LDY + d0 * 32 + r32) = cvtpk(v, vn); } }
        asm volatile("" ::: "memory"); }
    __syncthreads();
#undef RESC
#undef KBASE
#undef MASKT
#undef SEAM_K0
#undef HALF_STEP
}
#undef ROW
#undef VMW
#undef VMWN
#undef SLOAD_H
#undef SWRITE_HK
#undef SWRITE_HV
#undef SWRITE_H

struct SwaItem { int bh, qb0, qb1; };
__device__ __forceinline__ SwaItem swa_decode(int L, int nbh, int nqb, int nx) {
    SwaItem it; int x;
    { const int xcd = L & 7, k = L >> 3, gi = k / nx, r = k - gi * nx; it.bh = gi * 8 + xcd; x = r; }
    it.qb0 = x; it.qb1 = nqb - 1 - x;
    return it;
}
struct PTensors { const bf16* Q; const bf16* K; const bf16* V; const float* Bias; const bf16* GA; bf16* Y; const float* gattn; };
__device__ __forceinline__ BlockRef swa_ref(const SwaItem& it, int pass, const PTensors& T) {
    const int qb = pass ? it.qb1 : it.qb0, b = it.bh >> 3, h = it.bh & 7; const size_t row0 = (size_t)b * 2048 + (size_t)qb * QB;
    BlockRef r; r.Q = T.Q + row0 * LDR + h * D; r.K = T.K + (size_t)b * 2048 * LDR + h * D; r.V = T.V + (size_t)b * 2048 * LDR + h * D;
    r.Bias = T.Bias + (size_t)it.bh * 2048; r.GA = T.GA + row0 * LDR + h * D; r.Y = T.Y + row0 * LDY + h * D; r.gattn = T.gattn + h * D; r.P0 = qb * QB;
    return r;
}
__device__ __forceinline__ void prompt_item(char* lds, const PTensors& T, int L) {
    constexpr int nqb = 8, nx = 4, nbh = 128;
    const SwaItem it = swa_decode(L, nbh, nqb, nx);
    const BlockRef b1 = swa_ref(it, 1, T);
    BlockRef cur = swa_ref(it, 0, T), nxt = b1;
    Seam S;
    causal_prime(cur, lds, S);
    int par = 0;
#pragma unroll 1
    for (int p = 0; p < 2; ++p) { causal_block(cur, nxt, lds, S, par); cur = b1; nxt = b1; par ^= 1; }
}
}

namespace sa {
using namespace pa;
constexpr int SA_BIAS = 131072, SA_WS = SA_BIAS + 4160 * 4, SA_M = SA_WS + 2048, SA_L = SA_M + 1024, SA_WT = SA_L + 1024, LDS_BYTES = SA_WT + 64;
constexpr float SQRTD = 11.313708498984761f, C2 = 1.4426950408889634f * SCALE;
struct STensors { const bf16* Q; const bf16* Kn; const bf16* Vn; const float* ck; const float* cv; const float* clogf; const float* logf_s; const bf16* GA; bf16* Y; const float* gattn; };

__device__ __forceinline__ void sm_step(f32x16& p, float& m_reg, float& l_reg, float& alpha, bf16x8& pa0, bf16x8& pa1) {
    float pmax = p[0];
#pragma unroll
    for (int r = 1; r < 16; ++r) pmax = fmaxf(pmax, p[r]);
    { auto rr = __builtin_amdgcn_permlane32_swap(__float_as_uint(pmax), __float_as_uint(pmax), false, false);
      pmax = fmaxf(__uint_as_float(rr[0]), __uint_as_float(rr[1])); }
    float mn;
    if (__builtin_expect(__all((pmax - m_reg) * SCALE <= THR), 1)) { mn = m_reg; alpha = 1.f; }
    else { mn = fmaxf(m_reg, pmax); alpha = __builtin_amdgcn_exp2f((m_reg - mn) * C2); m_reg = mn; }
    const float mnL = -mn * C2;
    float ps = 0.f;
#pragma unroll
    for (int r = 0; r < 16; ++r) { p[r] = __builtin_amdgcn_exp2f(fmaf(p[r], C2, mnL)); ps += p[r]; }
    { auto rr = __builtin_amdgcn_permlane32_swap(__float_as_uint(ps), __float_as_uint(ps), false, false);
      ps = __uint_as_float(rr[0]) + __uint_as_float(rr[1]); }
    l_reg = l_reg * alpha + ps;
#define PK4(P, B_, OUT) do { unsigned a0 = cvtpk(P[B_+0], P[B_+1]), a1 = cvtpk(P[B_+2], P[B_+3]);                          \
        unsigned b0 = cvtpk(P[B_+4], P[B_+5]), b1 = cvtpk(P[B_+6], P[B_+7]);                                             \
        auto r0 = __builtin_amdgcn_permlane32_swap(a0, b0, false, false); auto r1 = __builtin_amdgcn_permlane32_swap(a1, b1, false, false); \
        u32x4 w = {r0[0], r1[0], r0[1], r1[1]}; OUT = *reinterpret_cast<bf16x8*>(&w); } while (0)
    PK4(p, 0, pa0); PK4(p, 8, pa1);
#undef PK4
}

__device__ __forceinline__ void sample_unit(char* lds, int b, int h, const STensors& T) {
    const int tid = threadIdx.x, wid = __builtin_amdgcn_readfirstlane(tid >> 6); int lane = tid & 63; asm volatile("" : "+v"(lane));
    const int r32 = lane & 31, hi = lane >> 5;
    char* Kt = lds + wid * 16384; char* Vt = Kt + 8192;
    float* biasL = (float*)(lds + SA_BIAS);
    float* ws = (float*)(lds + SA_WS) + wid * 64; float* li_l = ws; float* al_l = ws + 32;
    float* Mx = (float*)(lds + SA_M); float* Lx = (float*)(lds + SA_L); float* wt = (float*)(lds + SA_WT);
    {
        const float* lf = T.clogf + ((size_t)b * 4096 + 512 * wid + 8 * lane) * 8 + h;
        float v[8], e[8];
#pragma unroll
        for (int k = 0; k < 8; ++k) v[k] = lf[k * 8];
        float run = 0.f;
#pragma unroll
        for (int k = 7; k >= 0; --k) { e[k] = run; run += v[k]; }
        float incl = run;
#pragma unroll
        for (int off = 1; off < 64; off <<= 1) { const float t = __shfl_down(incl, off); if (lane + off < 64) incl += t; }
        const float excl = incl - run;
        if (lane == 0) wt[wid] = incl;
        float nv = 0.f;
        if (wid == 0) { if (lane < 32) nv = T.logf_s[((size_t)b * 32 + lane) * 8 + h];
#pragma unroll
            for (int off = 1; off < 32; off <<= 1) { const float t = __shfl_up(nv, off); if (lane >= off) nv += t; } }
        __syncthreads();
        float X = 0.f;
        for (int w2 = wid + 1; w2 < 8; ++w2) X += wt[w2];
#pragma unroll
        for (int k = 0; k < 8; ++k) biasL[512 * wid + 8 * lane + k] = (e[k] + excl + X) * SQRTD;
        if (wid == 0 && lane < 32) biasL[4096 + lane] = -nv * SQRTD;
    }
    bf16x8 qr[8];
    { const bf16* qp = T.Q + ((size_t)b * 32 + r32) * 1024 + h * 128 + hi * 8;
#pragma unroll
      for (int d0 = 0; d0 < 8; ++d0) qr[d0] = load8<bf16>(qp + d0 * 16); }
    __syncthreads();
    float m_reg = -1e30f, l_reg = 0.f; f32x16 o[4] = {};
    const int vb0 = (int)(uintptr_t)Vt + v_rd_base(lane);
    const char* ckb = (const char*)(T.ck + (((size_t)b * 4096) * 8 + h) * 128);
    const char* cvb = (const char*)(T.cv + (((size_t)b * 4096) * 8 + h) * 128);
    const unsigned lofs = (unsigned)(hi * 4096 + r32 * 16);
    char* const kwb0 = Kt + KSWZ(0 + hi, r32 * 8); char* const kwb1 = Kt + KSWZ(2 + hi, r32 * 8); char* const kwb2 = Kt + KSWZ(4 + hi, r32 * 8); char* const kwb3 = Kt + KSWZ(6 + hi, r32 * 8);
    char* const vwb = Vt + ((r32 * 4) >> 5) * 512 + hi * 64 + ((r32 * 4) & 31) * 2;
    f32x4 stg[16];
#define SA_ISSUE(src, kb) do { const char* s_ = (src) + (size_t)(kb) * 4096; _Pragma("unroll") for (int i = 0; i < 16; ++i) stg[i] = *(const f32x4*)(s_ + (size_t)i * 8192 + lofs); } while (0)
#define SA_WRITE_K() do { _Pragma("unroll") for (int i = 0; i < 16; ++i) { uint2 w_; w_.x = cvtpk(stg[i][0], stg[i][1]); w_.y = cvtpk(stg[i][2], stg[i][3]); \
        char* kb_ = (i & 3) == 0 ? kwb0 : ((i & 3) == 1 ? kwb1 : ((i & 3) == 2 ? kwb2 : kwb3)); *(uint2*)(kb_ + (i >> 2) * 2048) = w_; } } while (0)
#define SA_WRITE_V() do { _Pragma("unroll") for (int i = 0; i < 16; ++i) { uint2 w_; w_.x = cvtpk(stg[i][0], stg[i][1]); w_.y = cvtpk(stg[i][2], stg[i][3]); \
        *(uint2*)(vwb + (i & 1) * 128 + ((i >> 1) & 1) * 2048 + ((i >> 2) & 1) * 256 + ((i >> 3) & 1) * 4096) = w_; } } while (0)
#define SA_VMW() asm volatile("s_waitcnt vmcnt(0)" ::: "memory")
#define SA_LGW() asm volatile("s_waitcnt lgkmcnt(0)" ::: "memory")
#define SA_QKT(p, kb) do { const char* bt_ = (const char*)(biasL + (kb) + 4 * hi); \
        { const f32x4 b0 = *(const f32x4*)(bt_), b1 = *(const f32x4*)(bt_ + 32), b2 = *(const f32x4*)(bt_ + 64), b3 = *(const f32x4*)(bt_ + 96); \
          p = (f32x16){b0[0], b0[1], b0[2], b0[3], b1[0], b1[1], b1[2], b1[3], b2[0], b2[1], b2[2], b2[3], b3[0], b3[1], b3[2], b3[3]}; } \
        _Pragma("unroll") for (int d0 = 0; d0 < 8; ++d0) { const bf16x8 kf = *(const bf16x8*)(Kt + KSWZ(r32, ((d0 & 3) * 16 + hi * 8) * 2) + (d0 >> 2) * 128); \
            p = __builtin_amdgcn_mfma_f32_32x32x16_bf16(kf, qr[d0], p, 0, 0, 0); } } while (0)
#define SA_RESC(a) do { if (__any((a) < 1.f)) { if (hi == 0) al_l[r32] = (a); SA_LGW();              \
        _Pragma("unroll") for (int d_ = 0; d_ < 4; ++d_) _Pragma("unroll") for (int r = 0; r < 16; ++r) o[d_][r] *= al_l[crow(r, hi)]; } } while (0)
#define SA_TRRD(dst, off) asm volatile("ds_read_b64_tr_b16 %0, %1 offset:%2" : "=&v"(dst) : "v"(vb0), "i"(off) : "memory")
#define SA_PV() do { _Pragma("unroll") for (int d0 = 0; d0 < 4; ++d0) { s16x4 l0, h0, l1, h1; \
        if (d0 == 0) { SA_TRRD(l0, 0); SA_TRRD(h0, 2048); SA_TRRD(l1, 4096); SA_TRRD(h1, 6144); } \
        else if (d0 == 1) { SA_TRRD(l0, 512); SA_TRRD(h0, 2560); SA_TRRD(l1, 4608); SA_TRRD(h1, 6656); } \
        else if (d0 == 2) { SA_TRRD(l0, 1024); SA_TRRD(h0, 3072); SA_TRRD(l1, 5120); SA_TRRD(h1, 7168); } \
        else { SA_TRRD(l0, 1536); SA_TRRD(h0, 3584); SA_TRRD(l1, 5632); SA_TRRD(h1, 7680); } \
        SA_LGW(); SBAR(); \
        o[d0] = __builtin_amdgcn_mfma_f32_32x32x16_bf16(pa0, (bf16x8){l0[0], l0[1], l0[2], l0[3], h0[0], h0[1], h0[2], h0[3]}, o[d0], 0, 0, 0); \
        o[d0] = __builtin_amdgcn_mfma_f32_32x32x16_bf16(pa1, (bf16x8){l1[0], l1[1], l1[2], l1[3], h1[0], h1[1], h1[2], h1[3]}, o[d0], 0, 0, 0); } } while (0)
    const int kw0 = 512 * wid;
    SA_ISSUE(ckb, kw0);
#pragma unroll 1
    for (int i = 0; i < 16; ++i) {
        const int kb = kw0 + 32 * i;
        f32x16 p; float alpha; bf16x8 pa0, pa1;
        SA_VMW(); SA_WRITE_K(); SBAR();
        SA_ISSUE(cvb, kb); SBAR();
        SA_LGW(); SA_QKT(p, kb);
        sm_step(p, m_reg, l_reg, alpha, pa0, pa1);
        SA_VMW(); SA_WRITE_V(); SBAR();
        if (i + 1 < 16) SA_ISSUE(ckb, kb + 32);
        SBAR();
        SA_RESC(alpha);
        SA_LGW(); SA_PV();
    }
    if (wid == 0) {
        const bf16* kn = T.Kn + ((size_t)b * 32 + (lane >> 4)) * 1024 + h * 128 + (lane & 15) * 8;
        const bf16* vn = T.Vn + ((size_t)b * 32 + (lane >> 4)) * 1024 + h * 128 + (lane & 15) * 8;
        bf16x8 kk[8], vv[8];
#pragma unroll
        for (int i = 0; i < 8; ++i) { kk[i] = load8<bf16>(kn + (size_t)i * 4096); vv[i] = load8<bf16>(vn + (size_t)i * 4096); }
#pragma unroll
        for (int i = 0; i < 8; ++i) { const int row = 4 * i + (lane >> 4); *(bf16x8*)(Kt + KSWZ(row, (lane & 15) * 16)) = kk[i]; *(bf16x8*)(Vt + v_st(row, (lane & 15) * 8)) = vv[i]; }
        f32x16 p; float alpha; bf16x8 pa0, pa1;
        SA_LGW(); SA_QKT(p, 4096);
        { const float NEG = -__builtin_inff();
#pragma unroll
          for (int r = 0; r < 16; ++r) if (crow(r, hi) > r32) p[r] = NEG; }
        sm_step(p, m_reg, l_reg, alpha, pa0, pa1);
        SA_RESC(alpha);
        SA_LGW(); SA_PV();
    }
    if (hi == 0) Mx[wid * 32 + r32] = m_reg;
    __syncthreads();
    { float ms = Mx[r32];
#pragma unroll
      for (int w2 = 1; w2 < 8; ++w2) ms = fmaxf(ms, Mx[w2 * 32 + r32]);
      const float f = __builtin_amdgcn_exp2f((m_reg - ms) * C2);
      l_reg *= f;
      if (hi == 0) { al_l[r32] = f; Lx[wid * 32 + r32] = l_reg; }
      SA_LGW();
#pragma unroll
      for (int d_ = 0; d_ < 4; ++d_)
#pragma unroll
          for (int r = 0; r < 16; ++r) o[d_][r] *= al_l[crow(r, hi)]; }
#define SA_OWR(slot) do { char* sp_ = lds + (slot) * 16384 + lane * 16; _Pragma("unroll") for (int d_ = 0; d_ < 4; ++d_) _Pragma("unroll") for (int g = 0; g < 4; ++g) \
        *(f32x4*)(sp_ + (d_ * 4 + g) * 1024) = (f32x4){o[d_][4 * g], o[d_][4 * g + 1], o[d_][4 * g + 2], o[d_][4 * g + 3]}; } while (0)
#define SA_OAD(slot) do { const char* sp_ = lds + (slot) * 16384 + lane * 16; _Pragma("unroll") for (int d_ = 0; d_ < 4; ++d_) _Pragma("unroll") for (int g = 0; g < 4; ++g) { \
        const f32x4 t_ = *(const f32x4*)(sp_ + (d_ * 4 + g) * 1024); o[d_][4 * g] += t_[0]; o[d_][4 * g + 1] += t_[1]; o[d_][4 * g + 2] += t_[2]; o[d_][4 * g + 3] += t_[3]; } } while (0)
    if (wid >= 4) SA_OWR(wid - 4);
    __syncthreads();
    if (wid < 4) SA_OAD(wid);
    __syncthreads();
    if (wid == 2 || wid == 3) SA_OWR(wid - 2);
    __syncthreads();
    if (wid < 2) SA_OAD(wid);
    __syncthreads();
    if (wid == 1) SA_OWR(0);
    __syncthreads();
    if (wid == 0) {
        SA_OAD(0);
        int r32 = lane & 31, hi = lane >> 5; asm volatile("" : "+v"(r32), "+v"(hi));
        float lt = Lx[r32];
#pragma unroll
        for (int w2 = 1; w2 < 8; ++w2) lt += Lx[w2 * 32 + r32];
        if (hi == 0) li_l[r32] = lt;
        SA_LGW();
        float rs[16];
#pragma unroll
        for (int r = 0; r < 16; ++r) { const float rl = __builtin_amdgcn_rcpf(li_l[crow(r, hi)]); float s = 0.f;
#pragma unroll
            for (int d0 = 0; d0 < 4; ++d0) { o[d0][r] *= rl; s = fmaf(o[d0][r], o[d0][r], s); }
            s += __shfl_xor(s, 1); s += __shfl_xor(s, 2); s += __shfl_xor(s, 4); s += __shfl_xor(s, 8); s += __shfl_xor(s, 16);
            rs[r] = __builtin_amdgcn_rsqf(s * (1.0f / 128.0f) + 1e-6f); }
        float gw[4];
#pragma unroll
        for (int d0 = 0; d0 < 4; ++d0) gw[d0] = T.gattn[h * 128 + d0 * 32 + r32];
        const bf16* gap = T.GA + (size_t)b * 32 * 1024 + h * 128; bf16* yp = T.Y + (size_t)b * 32 * 2048 + h * 128;
        unsigned short gq[16][4];
#pragma unroll
        for (int r = 0; r < 16; ++r) { const int orow = crow(r, hi);
#pragma unroll
            for (int d0 = 0; d0 < 4; ++d0) gq[r][d0] = *(const unsigned short*)(gap + (size_t)orow * 1024 + d0 * 32 + r32); }
#pragma unroll
        for (int r = 0; r < 16; ++r) { const int orow = crow(r, hi);
#pragma unroll
            for (int d0 = 0; d0 < 4; ++d0) { const float ga = __uint_as_float((unsigned)gq[r][d0] << 16);
                const float v = o[d0][r] * rs[r] * gw[d0] * ga; const float vn = __shfl_xor(v, 1);
                if ((r32 & 1) == 0) *(unsigned*)(yp + (size_t)orow * 2048 + d0 * 32 + r32) = cvtpk(v, vn); } }
    }
    __syncthreads();
#undef SA_ISSUE
#undef SA_WRITE_K
#undef SA_WRITE_V
#undef SA_VMW
#undef SA_LGW
#undef SA_QKT
#undef SA_RESC
#undef SA_TRRD
#undef SA_PV
#undef SA_OWR
#undef SA_OAD
}
}

namespace lru {
using namespace pa;
constexpr int WP = 272;
constexpr int L_WR = 0, L_WI = 128 * WP, L_CW = 2 * 128 * WP, L_CST = L_CW + 5 * 128 * 4, L_XA = L_CST + 4 * 128 * 4, L_XU = L_XA + 2 * 8 * 32 * 4, L_CAR = L_XU + 2 * 8 * 32 * 4, LDS_BYTES = L_CAR + 2 * 128 * 4;
struct LTensors { const bf16* XL; const bf16* GL; bf16* Y; const bf16* WrT; const bf16* WiT; const float* conv_w; const float* conv_b; const float* b_r; const float* b_i; const float* lam; const float* g_lru;
                  const float* state_h; const float* state_conv; float* h_p; float* h_s; };

__device__ __forceinline__ void load_weights(char* lds, const LTensors& T, int n) {
    int tid = threadIdx.x; asm volatile("" : "+v"(tid));
#pragma unroll
    for (int i = 0; i < 4; ++i) { const int ch = tid + 512 * i, row = ch >> 4, c16 = ch & 15;
        *(u32x4*)(lds + L_WR + row * WP + c16 * 16) = *(const u32x4*)((const char*)(T.WrT + (size_t)n * 16384) + row * 256 + c16 * 16);
        *(u32x4*)(lds + L_WI + row * WP + c16 * 16) = *(const u32x4*)((const char*)(T.WiT + (size_t)n * 16384) + row * 256 + c16 * 16); }
    for (int i = tid; i < 5 * 128; i += 512) { const int d = i >> 7, c = i & 127; ((float*)(lds + L_CW))[i] = (d < 4) ? T.conv_w[d * 1024 + n * 128 + c] : T.conv_b[n * 128 + c]; }
    if (tid < 128) { const int c = n * 128 + tid; float* cst = (float*)(lds + L_CST);
        cst[tid] = T.b_r[c]; cst[128 + tid] = T.b_i[c]; const float lam = T.lam[c]; cst[256 + tid] = 8.0f * (fmaxf(-lam, 0.f) + log1pf(expf(-fabsf(lam)))); cst[384 + tid] = T.g_lru[c]; }
    if (tid < 256) ((float*)(lds + L_CAR))[tid] = 0.f;
}
template <bool SAMPLE>
__device__ __forceinline__ void tile_afrags(const char* lds, const bf16* xl, int t0, const float* hist, bf16x8 (&af)[8], int r32, int hi) {
    const float* cw = (const float*)(lds + L_CW);
#pragma unroll
    for (int kh = 0; kh < 2; ++kh) {
        bf16x8 raw[4][4];
#pragma unroll
        for (int k4 = 0; k4 < 4; ++k4)
#pragma unroll
            for (int d = 0; d < 4; ++d) { const int tt = r32 - 3 + d; raw[k4][d] = (bf16x8){0, 0, 0, 0, 0, 0, 0, 0};
                if (t0 + tt >= 0) raw[k4][d] = *(const bf16x8*)(xl + (ptrdiff_t)tt * 1024 + (kh * 4 + k4) * 16 + hi * 8); }
#pragma unroll
        for (int k4 = 0; k4 < 4; ++k4) { const int ks = kh * 4 + k4, c8 = ks * 16 + hi * 8;
            f32x4 x0 = *(const f32x4*)(cw + 4 * 128 + c8), x1 = *(const f32x4*)(cw + 4 * 128 + c8 + 4);
#pragma unroll
            for (int d = 0; d < 4; ++d) { const int tt = r32 - 3 + d; const bf16x8 rw = raw[k4][d];
                f32x4 v0 = (f32x4){__uint_as_float((unsigned)(unsigned short)rw[0] << 16), __uint_as_float((unsigned)(unsigned short)rw[1] << 16), __uint_as_float((unsigned)(unsigned short)rw[2] << 16), __uint_as_float((unsigned)(unsigned short)rw[3] << 16)};
                f32x4 v1 = (f32x4){__uint_as_float((unsigned)(unsigned short)rw[4] << 16), __uint_as_float((unsigned)(unsigned short)rw[5] << 16), __uint_as_float((unsigned)(unsigned short)rw[6] << 16), __uint_as_float((unsigned)(unsigned short)rw[7] << 16)};
                if (SAMPLE) { if (t0 + tt < 0) { const float* hp = hist + (size_t)(tt + 3) * 1024 + c8; v0 = *(const f32x4*)hp; v1 = *(const f32x4*)(hp + 4); } }
                const f32x4 w0 = *(const f32x4*)(cw + d * 128 + c8), w1 = *(const f32x4*)(cw + d * 128 + c8 + 4);
                x0 += w0 * v0; x1 += w1 * v1; }
            af[ks] = pack8(x0, x1); }
        asm volatile("" ::: "memory"); }
}
__device__ __forceinline__ void cb_maps(const char* lds, const bf16x8 (&af)[8], int cb, bool first0, f32x16& PA, f32x16& PU, float& tA, float& tU, int r32, int hi) {
    f32x16 ar = {}, ai = {}, ax = {};
    const char* wp = lds + (cb * 32 + r32) * WP + hi * 16;
#pragma unroll
    for (int ks = 0; ks < 8; ++ks) {
        const bf16x8 br = *(const bf16x8*)(wp + L_WR + ks * 32), bi = *(const bf16x8*)(wp + L_WI + ks * 32);
        ar = __builtin_amdgcn_mfma_f32_32x32x16_bf16(af[ks], br, ar, 0, 0, 0);
        ai = __builtin_amdgcn_mfma_f32_32x32x16_bf16(af[ks], bi, ai, 0, 0, 0);
        if ((ks & 1) == 1) asm volatile("" ::: "memory"); }
    {
        const int j = r32 & 7; const unsigned one = (j & 1) ? 0x3F800000u : 0x00003F80u; const bool hm = (hi == ((r32 >> 3) & 1));
        const bool c0 = hm && ((r32 >> 4) == 0), c1 = hm && ((r32 >> 4) == 1);
        u32x4 f0, f1;
        f0.x = (c0 && (j >> 1) == 0) ? one : 0u; f0.y = (c0 && (j >> 1) == 1) ? one : 0u; f0.z = (c0 && (j >> 1) == 2) ? one : 0u; f0.w = (c0 && (j >> 1) == 3) ? one : 0u;
        f1.x = (c1 && (j >> 1) == 0) ? one : 0u; f1.y = (c1 && (j >> 1) == 1) ? one : 0u; f1.z = (c1 && (j >> 1) == 2) ? one : 0u; f1.w = (c1 && (j >> 1) == 3) ? one : 0u;
        ax = __builtin_amdgcn_mfma_f32_32x32x16_bf16(af[2 * cb], *reinterpret_cast<bf16x8*>(&f0), ax, 0, 0, 0);
        ax = __builtin_amdgcn_mfma_f32_32x32x16_bf16(af[2 * cb + 1], *reinterpret_cast<bf16x8*>(&f1), ax, 0, 0, 0); }
    const float* cst = (const float*)(lds + L_CST) + cb * 32 + r32;
    const float cbr = cst[0], cbi = cst[128], csp = cst[256];
    const bool first = first0 && (hi == 0);
#pragma unroll
    for (int r = 0; r < 16; ++r) {
        const float rg = __builtin_amdgcn_rcpf(1.0f + __builtin_amdgcn_exp2f(-1.4426950408889634f * (ar[r] + cbr)));
        const float ig = __builtin_amdgcn_rcpf(1.0f + __builtin_amdgcn_exp2f(-1.4426950408889634f * (ai[r] + cbi)));
        const float av = __builtin_amdgcn_exp2f(-1.4426950408889634f * csp * rg);
        float mult = __builtin_amdgcn_sqrtf(fmaxf(fmaf(-av, av, 1.0f), 0.f));
        if (r == 0 && first) mult = 1.0f;
        ar[r] = av; ai[r] = mult * ig * ax[r]; }
    float Ag[4], Ug[4];
#pragma unroll
    for (int gl = 0; gl < 4; ++gl) { const int r0 = 4 * gl;
        float pa = ar[r0], pu = ai[r0];
#pragma unroll
        for (int k = 1; k < 4; ++k) { pu = fmaf(ar[r0 + k], pu, ai[r0 + k]); pa = ar[r0 + k] * pa; ar[r0 + k] = pa; ai[r0 + k] = pu; }
        Ag[gl] = pa; Ug[gl] = pu; }
    float GA = 1.0f, GU = 0.f;
#pragma unroll
    for (int gl = 0; gl < 4; ++gl) { const int r0 = 4 * gl;
        const float oA = __shfl_xor(Ag[gl], 32), oU = __shfl_xor(Ug[gl], 32);
        const float sA0 = hi ? oA : Ag[gl], sU0 = hi ? oU : Ug[gl], sA1 = hi ? Ag[gl] : oA, sU1 = hi ? Ug[gl] : oU;
        const float GA1 = sA0 * GA, GU1 = fmaf(sA0, GU, sU0);
        const float mA = hi ? GA1 : GA, mU = hi ? GU1 : GU;
#pragma unroll
        for (int k = 0; k < 4; ++k) { PU[r0 + k] = fmaf(ar[r0 + k], mU, ai[r0 + k]); PA[r0 + k] = ar[r0 + k] * mA; }
        GA = sA1 * GA1; GU = fmaf(sA1, GU1, sU1); }
    tA = GA; tU = GU;
}
__device__ __forceinline__ void tile_out(const char* lds, f32x16 (&H)[4], const bf16* gl, bf16* y, int r32, int hi) {
    const float* cst = (const float*)(lds + L_CST) + 384 + r32;
    const float cg0 = cst[0], cg1 = cst[32], cg2 = cst[64], cg3 = cst[96];
#pragma unroll
    for (int rh = 0; rh < 2; ++rh) {
        unsigned short gq[8][4];
#pragma unroll
        for (int r8 = 0; r8 < 8; ++r8) { const int tt = crow(rh * 8 + r8, hi);
#pragma unroll
            for (int cb = 0; cb < 4; ++cb) gq[r8][cb] = *(const unsigned short*)(gl + (size_t)tt * 1024 + cb * 32 + r32); }
#pragma unroll
        for (int r8 = 0; r8 < 8; ++r8) { const int r = rh * 8 + r8; float s = 0.f;
#pragma unroll
            for (int cb = 0; cb < 4; ++cb) s = fmaf(H[cb][r], H[cb][r], s);
            s += __shfl_xor(s, 1); s += __shfl_xor(s, 2); s += __shfl_xor(s, 4); s += __shfl_xor(s, 8); s += __shfl_xor(s, 16);
            const float rs = __builtin_amdgcn_rsqf(s * (1.0f / 128.0f) + 1e-6f); const int tt = crow(r, hi);
#pragma unroll
            for (int cb = 0; cb < 4; ++cb) { const float g = __uint_as_float((unsigned)gq[r8][cb] << 16);
                const float v = H[cb][r] * rs * (cb == 0 ? cg0 : (cb == 1 ? cg1 : (cb == 2 ? cg2 : cg3))) * g; const float vn = __shfl_xor(v, 1);
                if ((r32 & 1) == 0) *(unsigned*)(y + (size_t)tt * 2048 + cb * 32 + r32) = cvtpk(v, vn); } }
        asm volatile("" ::: "memory"); }
}
__device__ __forceinline__ void prompt_unit(char* lds, const LTensors& T, int b, int n) {
    const int tid = threadIdx.x, wid = __builtin_amdgcn_readfirstlane(tid >> 6); const int lane0 = tid & 63;
    load_weights(lds, T, n);
    __syncthreads();
    float* XA = (float*)(lds + L_XA); float* XU = (float*)(lds + L_XU); float* CAR = (float*)(lds + L_CAR);
#pragma unroll 1
    for (int ch = 0; ch < 8; ++ch) {
        int lane = lane0; asm volatile("" : "+v"(lane)); const int r32 = lane & 31, hi = lane >> 5;
        const int t0 = ch * 256 + wid * 32; const size_t row = (size_t)b * 2048 + t0;
        bf16x8 af[8];
        tile_afrags<false>(lds, T.XL + row * 1024 + n * 128, t0, nullptr, af, r32, hi);
        f32x16 H[4];
#pragma unroll
        for (int cb = 0; cb < 4; ++cb) { const int par = cb & 1, c = cb * 32 + r32;
            f32x16 PA, PU; float tA, tU;
            cb_maps(lds, af, cb, t0 == 0, PA, PU, tA, tU, r32, hi);
            if (hi == 0) { XA[(par * 8 + wid) * 32 + r32] = tA; XU[(par * 8 + wid) * 32 + r32] = tU; }
            __syncthreads();
            float hin = CAR[(ch & 1) * 128 + c];
            for (int w2 = 0; w2 < wid; ++w2) hin = fmaf(XA[(par * 8 + w2) * 32 + r32], hin, XU[(par * 8 + w2) * 32 + r32]);
#pragma unroll
            for (int r = 0; r < 16; ++r) H[cb][r] = fmaf(PA[r], hin, PU[r]);
            if (wid == 7 && hi == 1) { CAR[((ch + 1) & 1) * 128 + c] = H[cb][15]; if (ch == 7) T.h_p[(size_t)b * 1024 + n * 128 + c] = H[cb][15]; } }
        { int r32v = r32, hiv = hi; asm volatile("" : "+v"(r32v), "+v"(hiv)); tile_out(lds, H, T.GL + row * 1024 + n * 128, T.Y + row * 2048 + 1024 + n * 128, r32v, hiv); }
    }
    __syncthreads();
}
__device__ __forceinline__ void sample_unit(char* lds, const LTensors& T, int n) {
    const int tid = threadIdx.x, wid = __builtin_amdgcn_readfirstlane(tid >> 6); const int lane0 = tid & 63;
    load_weights(lds, T, n);
    __syncthreads();
#pragma unroll 1
    for (int bi = 0; bi < 4; ++bi) { const int b = wid + 8 * bi;
        int lane = lane0; asm volatile("" : "+v"(lane)); const int r32 = lane & 31, hi = lane >> 5; const size_t row = 32768 + (size_t)b * 32;
        bf16x8 af[8];
        tile_afrags<true>(lds, T.XL + row * 1024 + n * 128, 0, T.state_conv + (size_t)b * 3 * 1024 + n * 128, af, r32, hi);
        f32x16 H[4];
#pragma unroll
        for (int cb = 0; cb < 4; ++cb) { const int c = n * 128 + cb * 32 + r32;
            f32x16 PA, PU; float tA, tU;
            cb_maps(lds, af, cb, false, PA, PU, tA, tU, r32, hi);
            const float hin = T.state_h[(size_t)b * 1024 + c];
#pragma unroll
            for (int r = 0; r < 16; ++r) H[cb][r] = fmaf(PA[r], hin, PU[r]);
            if (hi == 1) T.h_s[(size_t)b * 1024 + c] = H[cb][15]; }
        { int r32v = r32, hiv = hi; asm volatile("" : "+v"(r32v), "+v"(hiv)); tile_out(lds, H, T.GL + row * 1024 + n * 128, T.Y + row * 2048 + 1024 + n * 128, r32v, hiv); }
    }
    __syncthreads();
}
}

constexpr int NWAVES = 8;
constexpr int N_LAUNCHES = MK_N_LAUNCHES;
constexpr int PER_PHASE = 5;
constexpr int DM = 2048, SEQ = 2048, NB = 16, DB = 32, DS = 32, PAST = 4096, NH = 8, HD = 128, DA = 1024, DL = 1024;
constexpr int MP = NB * SEQ, MS = DB * DS, M = MP + MS;
constexpr int D_IN = 6152, NIN = 6144;
constexpr float LN_EPS = 1e-5f, ALPHA = 1.189207115002721f;
constexpr size_t O_YP = 0, O_YS = O_YP + (size_t)MP * DM, O_KP = O_YS + (size_t)MS * DM, O_VP = O_KP + (size_t)MP * DA, O_FP = O_VP + (size_t)MP * DA,
                 O_HP = O_FP + (size_t)MP * NH, O_CP = O_HP + (size_t)NB * DL, O_KS = O_CP + (size_t)NB * 3 * DL, O_VS = O_KS + (size_t)MS * DA, O_FS = O_VS + (size_t)MS * DA,
                 O_HS = O_FS + (size_t)MS * NH, O_CS = O_HS + (size_t)DB * DL, O_END = O_CS + (size_t)DB * 3 * DL;
static_assert(O_END == 138878976, "d_out size");
constexpr size_t MiB = 1u << 20;
constexpr size_t WS_CTL = 0, CTL_ZERO_BYTES = 1 * MiB;
constexpr size_t WS_WIN = 2 * MiB;
constexpr size_t WS_WOUT = 26 * MiB;
constexpr size_t WS_WR = 34 * MiB, WS_WI = 34 * MiB + 512 * 1024;
constexpr size_t WS_BIAS = 35 * MiB;
constexpr size_t WS_XB = 40 * MiB;
constexpr size_t ACT_BYTES = (size_t)M * 1024 * 2;
constexpr size_t WS_ACT = 172 * MiB;
constexpr size_t WS_YC = WS_ACT + 6 * ACT_BYTES;
constexpr size_t WS_END = WS_YC + (size_t)M * 2048 * 2;
static_assert(ACT_BYTES == 66 * MiB && WS_XB + (size_t)M * 2048 * 2 <= WS_ACT, "ws map");
constexpr int CW_TMO = 0, CW_CODE = 1, CW_BAR = 4096, CW_QUEUE = 8192;
constexpr int PH_BYTES = 153600;
constexpr int LDSCTL_OFF = PH_BYTES, MISC_OFF = LDSCTL_OFF + 320, LDS_BYTES = 155648;
static_assert(MISC_OFF + 128 <= LDS_BYTES && sa::LDS_BYTES <= PH_BYTES && lru::LDS_BYTES <= PH_BYTES && pa::LDS_BYTES <= PH_BYTES && pg8::STAGE_BYTES <= PH_BYTES, "LDS map");

#define GAS __attribute__((address_space(1)))
#define LAS __attribute__((address_space(3)))
typedef unsigned short bf16;
typedef unsigned v4u __attribute__((ext_vector_type(4)));
typedef float f32x4 __attribute__((ext_vector_type(4)));
typedef GAS unsigned gu32;
#define RLX_AGENT __ATOMIC_RELAXED, __HIP_MEMORY_SCOPE_AGENT
#define LDS_WAIT() asm volatile("s_waitcnt lgkmcnt(0)" ::: "memory")
#define VM_WAIT() asm volatile("s_waitcnt vmcnt(0)" ::: "memory")
__device__ __forceinline__ unsigned f2bf(float f) { unsigned u = __builtin_bit_cast(unsigned, f); return (u + 0x7fffu + ((u >> 16) & 1u)) >> 16; }
__device__ __forceinline__ unsigned pk2(float lo, float hi) { return f2bf(lo) | (f2bf(hi) << 16); }

#define XB_TMO      128
#define XB_XCNT(j)  (256  + 64 * (j))
#define XB_XSUB(j)  (1280 + 64 * (j))
#define XB_XGEN(j)  (2304 + 64 * (j))
#define XB_TOP      3328
#define XB_TOPGEN   3392
#define XCD_BAR_WORDS 3456
#define XB_SPIN_CAP (1u << 18)

__device__ __forceinline__ unsigned xb_ld(unsigned* p)              { return __hip_atomic_load(p, __ATOMIC_RELAXED, __HIP_MEMORY_SCOPE_AGENT); }
__device__ __forceinline__ unsigned xb_add(unsigned* p, unsigned v) { return __hip_atomic_fetch_add(p, v, __ATOMIC_RELAXED, __HIP_MEMORY_SCOPE_AGENT); }
__device__ __forceinline__ unsigned xb_xcc_id() { return (unsigned)__builtin_amdgcn_s_getreg((3 << 11) | 20) & 0xFu; }
#define XB_SPIN(cond, bar) do { unsigned _sp = 0; while (cond) { __builtin_amdgcn_s_sleep(1); \
    if ((++_sp & 255u) == 0u) { if (xb_ld(&(bar)[XB_TMO])) break; if (_sp > XB_SPIN_CAP) { atomicAdd(&(bar)[XB_TMO], 1u); break; } } } } while (0)

struct XcdBarrier {
    unsigned* bar; unsigned x;
    volatile LAS unsigned* st;
};

__device__ __forceinline__ XcdBarrier xcd_barrier_post(unsigned* bar, volatile LAS unsigned* st) {
    XcdBarrier b; b.bar = bar; b.x = xb_xcc_id(); b.st = st;
    if (threadIdx.x == 0) (void)xb_add(&bar[XB_XCNT(b.x)], 1u);
    return b;
}
__device__ __forceinline__ void xcd_barrier_complete(unsigned* bar, unsigned x, unsigned& nloc, unsigned& nx) {
    const unsigned G = gridDim.x * gridDim.y * gridDim.z;
    unsigned sum, cnt, mine, sp = 0u;
    for (;;) {
        sum = 0u; cnt = 0u; mine = 0u;
#pragma unroll
        for (unsigned j = 0; j < 16; ++j) { const unsigned c = xb_ld(&bar[XB_XCNT(j)]); sum += c; cnt += (c > 0u) ? 1u : 0u; mine = (j == x) ? c : mine; }
        if (sum == G) break;
        __builtin_amdgcn_s_sleep(1);
        if ((++sp & 255u) == 0u) { if (xb_ld(&bar[XB_TMO])) break; if (sp > XB_SPIN_CAP) { atomicAdd(&bar[XB_TMO], 1u); break; } }
    }
    nloc = mine > 0u ? mine : 1u; nx = cnt > 0u ? cnt : 1u;
}

__device__ __forceinline__ void xcd_barrier(const XcdBarrier& b) {
    asm volatile("s_waitcnt vmcnt(0)" ::: "memory");
    __syncthreads();
    if (threadIdx.x == 0) {
        unsigned* bar = b.bar;
        __builtin_amdgcn_s_waitcnt(0);
        unsigned nloc = b.st[0], nx = b.st[1];
        if (nloc == 0u) { xcd_barrier_complete(bar, b.x, nloc, nx); b.st[0] = nloc; b.st[1] = nx; }
        const unsigned old = xb_add(&bar[XB_XSUB(b.x)], 1u);
        const unsigned gen = old / nloc;
        if (old + 1u == (gen + 1u) * nloc) {
            __builtin_amdgcn_fence(__ATOMIC_RELEASE, "agent");
            asm volatile("s_waitcnt vmcnt(0)" ::: "memory");
            const unsigned og = xb_add(&bar[XB_TOP], 1u);
            const unsigned tg = og / nx;
            if (og + 1u == (tg + 1u) * nx) xb_add(&bar[XB_TOPGEN], 1u);
            else XB_SPIN(xb_ld(&bar[XB_TOPGEN]) == tg, bar);
            __builtin_amdgcn_fence(__ATOMIC_ACQUIRE, "agent");
            xb_add(&bar[XB_XGEN(b.x)], 1u);
            asm volatile("s_waitcnt vmcnt(0)" ::: "memory");
        } else {
            XB_SPIN(xb_ld(&bar[XB_XGEN(b.x)]) == gen, bar);
            __builtin_amdgcn_fence(__ATOMIC_ACQUIRE, "agent");
            asm volatile("s_waitcnt vmcnt(0)" ::: "memory");
        }
    }
    __syncthreads();
}

__device__ __forceinline__ float wave_sum(float v) {
#pragma unroll
    for (int o = 1; o < 64; o <<= 1) v += __shfl_xor(v, o);
    return v;
}
__device__ __forceinline__ void p0_transpose_item(const float* W, int ldw, int scol, bf16* WT, int K, int drow, int k0, LAS float* scr, int lane) {
#pragma unroll 8
    for (int i = 0; i < 32; ++i) { const int kk = 2 * i + (lane >> 5); scr[kk * 33 + (lane & 31)] = W[(size_t)(k0 + kk) * ldw + scol + (lane & 31)]; }
    LDS_WAIT(); asm volatile("" ::: "memory");
    const int c = lane & 7;
#pragma unroll
    for (int j = 0; j < 4; ++j) { const int n = (lane >> 3) + 8 * j; const LAS float* s = scr + (8 * c) * 33 + n;
        v4u o; o.x = pk2(s[0 * 33], s[1 * 33]); o.y = pk2(s[2 * 33], s[3 * 33]); o.z = pk2(s[4 * 33], s[5 * 33]); o.w = pk2(s[6 * 33], s[7 * 33]);
        *(GAS v4u*)(WT + (size_t)(drow + n) * K + k0 + 8 * c) = o; }
    LDS_WAIT(); asm volatile("" ::: "memory");
}

struct Args { const float* in[21]; float* out; unsigned char* ws; int ph_lo, ph_hi; };

__global__ void __launch_bounds__(NWAVES * 64, 2) fwd_kernel(Args args) {
    extern __shared__ __attribute__((aligned(16))) unsigned char lds[];
    LAS unsigned char* ldsl = (LAS unsigned char*)lds;
    volatile LAS unsigned* MISC = (volatile LAS unsigned*)(ldsl + MISC_OFF);
    const int tid = threadIdx.x, lane = tid & 63, wave = __builtin_amdgcn_readfirstlane(tid >> 6);
    const int G = gridDim.x, bx = blockIdx.x;
    unsigned char* ws = args.ws;
    gu32* ctl = (gu32*)(ws + WS_CTL);
    float* out = args.out;
    const float* x_p = args.in[0]; const float* x_s = args.in[1];
    bf16* WinT = (bf16*)(ws + WS_WIN); bf16* WoutT = (bf16*)(ws + WS_WOUT); bf16* WrT = (bf16*)(ws + WS_WR); bf16* WiT = (bf16*)(ws + WS_WI);
    float* BIAS = (float*)(ws + WS_BIAS); bf16* XB = (bf16*)(ws + WS_XB); bf16* ACT = (bf16*)(ws + WS_ACT); bf16* YC = (bf16*)(ws + WS_YC);
    constexpr size_t ACT_EL = ACT_BYTES / 2;
    bf16* QB = ACT; bf16* KBf = ACT + ACT_EL; bf16* VBf = ACT + 2 * ACT_EL; bf16* GA = ACT + 3 * ACT_EL; bf16* XL = ACT + 4 * ACT_EL; bf16* GL = ACT + 5 * ACT_EL;

    for (int u = tid; u < (LDS_BYTES - LDSCTL_OFF) / 4; u += NWAVES * 64) ((LAS unsigned*)(ldsl + LDSCTL_OFF))[u] = 0u;
    __syncthreads();
    XcdBarrier bar; bar.bar = (unsigned*)(ctl + CW_BAR); bar.x = 0; bar.st = nullptr;
    if (N_LAUNCHES != PER_PHASE) bar = xcd_barrier_post((unsigned*)(ctl + CW_BAR), MISC + 8);
#define GRID_BAR(seam) do { if (N_LAUNCHES == PER_PHASE) { if (tid == 0) __hip_atomic_store(ctl + CW_TMO, 0xBADBA0u | (unsigned)(seam), RLX_AGENT); } else { xcd_barrier(bar); } } while (0)
    const int lo = args.ph_lo, hi_ph = args.ph_hi;
#ifndef ONLY_PHASE
#define ONLY_PHASE -1
#endif
#define IN(k) (lo <= (k) && (k) < hi_ph && (ONLY_PHASE < 0 || ONLY_PHASE == (k)))
#define BOTH(k) (IN(k) && IN((k) + 1))
#ifndef PROBE_REPEAT
#define PROBE_REPEAT -1
#endif
#define REP(k) for (int rep_ = 0; rep_ < ((PROBE_REPEAT == (k)) ? 2 : 1); ++rep_)

    if (IN(0)) {
        REP(0) {
        const int gw = bx * NWAVES + wave, NGW = G * NWAVES;
        const float* w_in = args.in[7]; const float* w_out = args.in[18]; const float* w_r = args.in[11]; const float* w_i = args.in[13]; const float* b_f = args.in[8];
        LAS float* scr = (LAS float*)(ldsl + wave * 16384);
        constexpr int I_IN = 32 * 192, I_OUT = 32 * 64, I_R = 64, NITEMS = I_IN + I_OUT + 2 * I_R;
        for (int it = gw; it < NITEMS; it += NGW) {
            int r = it;
            if (r < I_IN) { const int kb = r / 192, nb = r % 192; p0_transpose_item(w_in, D_IN, 32 * nb + (nb >= 96 ? 8 : 0), WinT, 2048, 32 * nb, 64 * kb, scr, lane); continue; } r -= I_IN;
            if (r < I_OUT) { const int kb = r / 64, nb = r % 64; p0_transpose_item(w_out, 2048, 32 * nb, WoutT, 2048, 32 * nb, 64 * kb, scr, lane); continue; } r -= I_OUT;
            if (r < I_R) { const int n = r >> 3, kb = (r >> 2) & 1, nb = r & 3; p0_transpose_item(w_r + (size_t)n * 16384, 128, 32 * nb, WrT + (size_t)n * 16384, 128, 32 * nb, 64 * kb, scr, lane); continue; } r -= I_R;
            { const int n = r >> 3, kb = (r >> 2) & 1, nb = r & 3; p0_transpose_item(w_i + (size_t)n * 16384, 128, 32 * nb, WiT + (size_t)n * 16384, 128, 32 * nb, 64 * kb, scr, lane); }
        }
        __syncthreads();
        LAS float* wf = (LAS float*)ldsl;
#pragma unroll
        for (int i = 0; i < 4; ++i) { const int k = tid + 512 * i; const f32x4 a = *(const f32x4*)(w_in + (size_t)k * D_IN + 3072), b = *(const f32x4*)(w_in + (size_t)k * D_IN + 3076);
            wf[0 * 2048 + k] = a[0]; wf[1 * 2048 + k] = a[1]; wf[2 * 2048 + k] = a[2]; wf[3 * 2048 + k] = a[3]; wf[4 * 2048 + k] = b[0]; wf[5 * 2048 + k] = b[1]; wf[6 * 2048 + k] = b[2]; wf[7 * 2048 + k] = b[3]; }
        __syncthreads();
        const float bfl = (lane < 8) ? b_f[lane] : 0.f;
        for (int m = gw; m < M; m += NGW) {
            const float* xr = (m < MP) ? x_p + (size_t)m * DM : x_s + (size_t)(m - MP) * DM;
            f32x4 v[8];
#pragma unroll
            for (int j = 0; j < 8; ++j) v[j] = *(const f32x4*)(xr + 4 * lane + 256 * j);
            GAS unsigned long long* o8 = (GAS unsigned long long*)(XB + (size_t)m * DM) + lane;
#pragma unroll
            for (int j = 0; j < 8; ++j) o8[64 * j] = (unsigned long long)pk2(v[j][0], v[j][1]) | ((unsigned long long)pk2(v[j][2], v[j][3]) << 32);
            float acc[8];
#pragma unroll
            for (int h = 0; h < 8; ++h) { float a = 0.f;
#pragma unroll
                for (int j = 0; j < 8; ++j) { const f32x4 w = *(const LAS f32x4*)(wf + h * 2048 + 256 * j + 4 * lane); a = fmaf(v[j][0], w[0], a); a = fmaf(v[j][1], w[1], a); a = fmaf(v[j][2], w[2], a); a = fmaf(v[j][3], w[3], a); }
                acc[h] = wave_sum(a); asm volatile("" ::: "memory"); }
            float z = acc[0];
#pragma unroll
            for (int h = 1; h < 8; ++h) z = (lane == h) ? acc[h] : z;
            if (lane < 8) { z += bfl; const float lf = fminf(z, 0.f) - log1pf(expf(-fabsf(z)));
                float* fo = (m < MP) ? out + O_FP + (size_t)m * NH : out + O_FS + (size_t)(m - MP) * NH; fo[lane] = lf; }
        }
        __syncthreads();
        }
        if (BOTH(0)) GRID_BAR(0);
    }

    if (IN(1)) {
        REP(1) {
        pg8::Gemm g{XB, WinT, M, NIN, DM}; pg8::StaticOrder S; S.init(M, NIN, G, bx);
        pg8::EpiIn E{ACT, ACT_EL, out + O_KP, out + O_VP, out + O_KS, out + O_VS, out + O_CP, out + O_CS};
        pg8::gemm_phase<pg8::EpiIn, pg8::StaticOrder, true, true>(ldsl, g, S, E);
        }
        {
            const int idle0 = ((M / 256) * (NIN / 256)) % G, nidle = G - idle0;
            if (bx >= idle0) {
            const int gwr = (bx - idle0) * NWAVES + wave;
            for (int bh = gwr; bh < NB * NH; bh += nidle * NWAVES) { const int b = bh >> 3, h = bh & 7;
                const float* lf = out + O_FP + ((size_t)b * SEQ + 32 * lane) * NH + h;
                float v[32];
#pragma unroll
                for (int k = 0; k < 32; ++k) v[k] = lf[k * NH];
#pragma unroll
                for (int k = 1; k < 32; ++k) v[k] += v[k - 1];
                float incl = v[31];
#pragma unroll
                for (int off = 1; off < 64; off <<= 1) { const float t = __shfl_up(incl, off); if (lane >= off) incl += t; }
                const float excl = incl - v[31];
                float* bo = BIAS + (size_t)bh * SEQ + 32 * lane;
#pragma unroll
                for (int k = 0; k < 32; k += 4) *(f32x4*)(bo + k) = (f32x4){-(v[k] + excl) * sa::SQRTD, -(v[k + 1] + excl) * sa::SQRTD, -(v[k + 2] + excl) * sa::SQRTD, -(v[k + 3] + excl) * sa::SQRTD};
            } }
        }
        if (BOTH(1)) GRID_BAR(1);
    }

    if (IN(2)) {
        lru::LTensors LT{(const pa::bf16*)XL, (const pa::bf16*)GL, (pa::bf16*)YC, (const pa::bf16*)WrT, (const pa::bf16*)WiT, args.in[9], args.in[10], args.in[12], args.in[14], args.in[15], args.in[17],
                         args.in[5], args.in[6], out + O_HP, out + O_HS};
        const pa::PTensors PT{(const pa::bf16*)QB, (const pa::bf16*)KBf, (const pa::bf16*)VBf, BIAS, (const pa::bf16*)GA, (pa::bf16*)YC, args.in[16]};
        const sa::STensors ST{(const pa::bf16*)(QB + (size_t)MP * 1024), (const pa::bf16*)(KBf + (size_t)MP * 1024), (const pa::bf16*)(VBf + (size_t)MP * 1024), args.in[2], args.in[3], args.in[4],
                              out + O_FS, (const pa::bf16*)(GA + (size_t)MP * 1024), (pa::bf16*)(YC + (size_t)MP * 2048), args.in[16]};
        constexpr int N_LRU = 136, N_PA = 512, N_SA = 256;
#define QUEUE_LOOP(qidx, nitems, BODY) do { gu32* qctr_ = ctl + CW_QUEUE + 64 * (qidx); \
            for (int k_ = 0;; ++k_) { if (tid == 0) MISC[16 + (k_ & 1)] = __hip_atomic_fetch_add(qctr_, 1u, RLX_AGENT); __syncthreads(); \
                const int item = (int)MISC[16 + (k_ & 1)]; if (item >= (nitems)) break; BODY; } __syncthreads(); } while (0)
        REP(2) {
        QUEUE_LOOP(3 * rep_ + 0, N_LRU, { if (item < 128) lru::prompt_unit((char*)lds, LT, item >> 3, item & 7); else lru::sample_unit((char*)lds, LT, item - 128); });
        QUEUE_LOOP(3 * rep_ + 1, N_PA, pa::prompt_item((char*)lds, PT, item));
        QUEUE_LOOP(3 * rep_ + 2, N_SA, sa::sample_unit((char*)lds, item >> 3, item & 7, ST));
        }
#undef QUEUE_LOOP
        if (BOTH(2)) GRID_BAR(2);
    }

    if (IN(3)) {
        REP(3) {
        pg8::Gemm g{YC, WoutT, M, DM, DM}; pg8::StaticOrder S; S.init(M, DM, G, bx);
        pg8::EpiOut E{XB};
        pg8::gemm_phase<pg8::EpiOut, pg8::StaticOrder, true, true>(ldsl, g, S, E);
        }
        if (BOTH(3)) GRID_BAR(3);
    }

    if (IN(4)) {
        const int gw = bx * NWAVES + wave, NGW = G * NWAVES;
        const float* ln_g = args.in[19]; const float* ln_b = args.in[20];
        f32x4 gv[8], bv[8];
#pragma unroll
        for (int j = 0; j < 8; ++j) { gv[j] = *(const f32x4*)(ln_g + 4 * lane + 256 * j); bv[j] = *(const f32x4*)(ln_b + 4 * lane + 256 * j); }
        for (int m = gw; m < M; m += NGW) {
            const float* xr = ((m < MP) ? x_p + (size_t)m * DM : x_s + (size_t)(m - MP) * DM) + 4 * lane;
            const bf16* orow = XB + (size_t)m * DM + 4 * lane;
            float* yr = out + O_YP + (size_t)m * DM + 4 * lane;
            f32x4 v[8]; float s = 0.f;
#pragma unroll
            for (int j = 0; j < 8; ++j) { const f32x4 xv = *(const f32x4*)(xr + 256 * j); const uint2 ob = *(const uint2*)(orow + 256 * j);
                const f32x4 ov = {__uint_as_float(ob.x << 16), __uint_as_float(ob.x & 0xffff0000u), __uint_as_float(ob.y << 16), __uint_as_float(ob.y & 0xffff0000u)};
                v[j] = xv * ALPHA + ov; s += (v[j][0] + v[j][1]) + (v[j][2] + v[j][3]); }
            const float mean = wave_sum(s) * (1.f / DM); float s2 = 0.f;
#pragma unroll
            for (int j = 0; j < 8; ++j) { v[j] = v[j] - mean; s2 += (v[j][0] * v[j][0] + v[j][1] * v[j][1]) + (v[j][2] * v[j][2] + v[j][3] * v[j][3]); }
            const float rstd = 1.f / sqrtf(wave_sum(s2) * (1.f / DM) + LN_EPS);
#pragma unroll
            for (int j = 0; j < 8; ++j) *(f32x4*)(yr + 256 * j) = v[j] * rstd * gv[j] + bv[j];
        }
    }
#undef IN
#undef BOTH
#undef GRID_BAR
}

extern "C" void kernel_launch(void* const* d_in, const int* in_sizes, int n_in, void* d_out, int out_size, void* d_ws, size_t ws_size, hipStream_t stream) {
    static int grid = 0;
    if (grid == 0) {
        if (n_in != 21 || (size_t)out_size != O_END || ws_size < WS_END) { fprintf(stderr, "kernel_launch: unexpected shapes: n_in %d out %d ws %zu (need >= %zu); nothing launched\n", n_in, out_size, ws_size, (size_t)WS_END); grid = -1; return; }
        int dev = 0, cus = 0, per_cu = 0;
        if (hipGetDevice(&dev) != hipSuccess || hipDeviceGetAttribute(&cus, hipDeviceAttributeMultiprocessorCount, dev) != hipSuccess) { fprintf(stderr, "kernel_launch: device query failed\n"); grid = -1; return; }
        if (hipFuncSetAttribute((const void*)fwd_kernel, hipFuncAttributeMaxDynamicSharedMemorySize, LDS_BYTES) != hipSuccess) { fprintf(stderr, "kernel_launch: hipFuncSetAttribute failed\n"); grid = -1; return; }
        if (hipOccupancyMaxActiveBlocksPerMultiprocessor(&per_cu, (const void*)fwd_kernel, NWAVES * 64, LDS_BYTES) != hipSuccess || per_cu < 1)
            fprintf(stderr, "kernel_launch: note: occupancy query reports %d workgroups per CU\n", per_cu);
        (void)hipGetLastError();
        grid = cus;
    }
    if (grid < 0) return;
    if (hipMemsetAsync((char*)d_ws + WS_CTL, 0, CTL_ZERO_BYTES, stream) != hipSuccess) { fprintf(stderr, "kernel_launch: memset failed\n"); return; }
    Args a{};
    for (int i = 0; i < 21; ++i) a.in[i] = (const float*)d_in[i];
    a.out = (float*)d_out; a.ws = (unsigned char*)d_ws;
    if (N_LAUNCHES == 1) { a.ph_lo = 0; a.ph_hi = PER_PHASE; hipLaunchKernelGGL(fwd_kernel, dim3(grid), dim3(NWAVES * 64), LDS_BYTES, stream, a); }
    else { for (int li = 0; li < PER_PHASE; ++li) { a.ph_lo = li; a.ph_hi = li + 1; hipLaunchKernelGGL(fwd_kernel, dim3(grid), dim3(NWAVES * 64), LDS_BYTES, stream, a); } }
    const hipError_t le = hipPeekAtLastError();
    if (le != hipSuccess) fprintf(stderr, "kernel_launch: launch failed: %s\n", hipGetErrorName(le));
}
```

```cpp
#include <hip/hip_runtime.h>
#include <hip/hip_bf16.h>
#include <cstdio>
#include <cstdint>

#ifndef MK_N_LAUNCHES
#define MK_N_LAUNCHES 1
#endif

namespace pg8 {
#define PG8_LAS __attribute__((address_space(3)))
typedef unsigned short bf16_t;
typedef short bf16x8 __attribute__((ext_vector_type(8)));
typedef float f32x4 __attribute__((ext_vector_type(4)));
typedef unsigned u32x4 __attribute__((ext_vector_type(4)));
constexpr int BM = 256, BK = 64, HALF = 128, HTB = HALF * BK * 2  , STAGE_BYTES = 8 * HTB, NXCD = 8, WGM = 8;

__host__ __device__ __forceinline__ int lds_byte(int r, int c) { const int st = (r >> 4) * 2 + (c >> 5), rr = r & 15, cc = c & 31, ob = rr * 64 + cc * 2; return st * 1024 + (ob ^ (((ob >> 9) & 1) << 5)); }
__host__ __device__ __forceinline__ void stage_rc(int b, int& R, int& C) { const int st = b / 1024, sb = b % 1024, swz = sb ^ (((sb >> 9) & 1) << 5); R = (st >> 1) * 16 + swz / 64; C = (st & 1) * 32 + (swz % 64) / 2; }
__host__ __device__ __forceinline__ int perm32(int rho) { const int n = rho >> 4, i = rho & 15; return 8 * (i >> 2) + 4 * n + (i & 3); }

struct Unit { int pm, pn; };
struct Gemm { const bf16_t* A; const bf16_t* Bt; int M, N, K; };

struct StaticOrder {
    int nM, nN, nwg, G, c;
    __host__ __device__ void init(int M, int N, int G_, int c_) { nM = M / BM; nN = N / BM; nwg = nM * nN; G = G_; c = c_; }
    __host__ __device__ bool next(int i, Unit& u) const {
        const long L = (long)i * G + c; if (L >= nwg) return false;
        int wgid = (int)L; { const int q = nwg / NXCD, r = nwg % NXCD, xcd = wgid % NXCD, off = wgid / NXCD; wgid = (xcd < r ? xcd * (q + 1) : r * (q + 1) + (xcd - r) * q) + off; }
        const int nig = WGM * nN, gid = wgid / nig, fm = gid * WGM, gsz = (nM - fm) < WGM ? (nM - fm) : WGM;
        u.pm = fm + ((wgid % nig) % gsz); u.pn = (wgid % nig) / gsz; return true;
    }
    __device__ __forceinline__ void a_ready(const Unit&) const {}
    __device__ __forceinline__ void done(const Unit&) const {}
};

__device__ __forceinline__ unsigned cvt_pk_bf16(float lo, float hi) { unsigned r; asm volatile("v_cvt_pk_bf16_f32 %0, %1, %2" : "=v"(r) : "v"(lo), "v"(hi)); return r; }
__device__ __forceinline__ float silu_f(float v) { return v * __builtin_amdgcn_rcpf(1.0f + __builtin_amdgcn_exp2f(-1.4426950408889634f * v)); }

struct EpiIn {
    static constexpr bool PERM = true, AFTER_DRAIN = false;
    bf16_t* act; size_t act_stride;
    float* kout_p; float* vout_p; float* kout_s; float* vout_s; float* conv_p; float* conv_s;
    __device__ __forceinline__ void operator()(const f32x4 (&acc)[2][2][4][2], const Unit& u, int wr, int wc, int fr, int fq) const {
        const int ty = u.pn >> 2, colt = (u.pn & 3) * BM;
        const int row0 = u.pm * BM + wr * 64 + fr, col0 = colt + wc * 32 + 8 * fq;
        const bool samp = u.pm >= 128; const int rofs = samp ? 32768 : 0;
        bf16_t* base = act + (size_t)ty * act_stride;
        float* fo = (ty == 1) ? (samp ? kout_s : kout_p) : ((ty == 2) ? (samp ? vout_s : vout_p) : nullptr);
        const bool do_silu = (ty == 3) || (ty == 5);
#pragma unroll
        for (int ai = 0; ai < 2; ++ai)
#pragma unroll
            for (int m = 0; m < 4; ++m) { const int row = row0 + ai * HALF + m * 16; bf16_t* rowp = base + (size_t)row * 1024 + col0;
#pragma unroll
                for (int bj = 0; bj < 2; ++bj) { f32x4 v0 = acc[ai][bj][m][0], v1 = acc[ai][bj][m][1];
                    if (fo) { float* fp = fo + (size_t)(row - rofs) * 1024 + col0 + bj * HALF; *(f32x4*)fp = v0; *(f32x4*)(fp + 4) = v1; }
                    if (ty == 4) {
                        const int rl = row - rofs; const int t = samp ? (rl & 31) : (rl & 2047); const int tl = samp ? 29 : 2045;
                        if (t >= tl) { float* cp = (samp ? conv_s + (size_t)((rl >> 5) * 3 + (t - tl)) * 1024 : conv_p + (size_t)((rl >> 11) * 3 + (t - tl)) * 1024) + col0 + bj * HALF;
                            *(f32x4*)cp = v0; *(f32x4*)(cp + 4) = v1; }
                    }
                    if (do_silu) { v0[0] = silu_f(v0[0]); v0[1] = silu_f(v0[1]); v0[2] = silu_f(v0[2]); v0[3] = silu_f(v0[3]); v1[0] = silu_f(v1[0]); v1[1] = silu_f(v1[1]); v1[2] = silu_f(v1[2]); v1[3] = silu_f(v1[3]); }
                    u32x4 w; w.x = cvt_pk_bf16(v0[0], v0[1]); w.y = cvt_pk_bf16(v0[2], v0[3]); w.z = cvt_pk_bf16(v1[0], v1[1]); w.w = cvt_pk_bf16(v1[2], v1[3]);
                    *(u32x4*)(rowp + bj * HALF) = w; } }
    }
};
struct EpiOut {
    static constexpr bool PERM = true, AFTER_DRAIN = false;
    bf16_t* O;
    __device__ __forceinline__ void operator()(const f32x4 (&acc)[2][2][4][2], const Unit& u, int wr, int wc, int fr, int fq) const {
        const int row0 = u.pm * BM + wr * 64 + fr, col0 = u.pn * BM + wc * 32 + 8 * fq;
#pragma unroll
        for (int ai = 0; ai < 2; ++ai)
#pragma unroll
            for (int m = 0; m < 4; ++m) { bf16_t* rowp = O + (size_t)(row0 + ai * HALF + m * 16) * 2048 + col0;
#pragma unroll
                for (int bj = 0; bj < 2; ++bj) { const f32x4 v0 = acc[ai][bj][m][0], v1 = acc[ai][bj][m][1];
                    u32x4 w; w.x = cvt_pk_bf16(v0[0], v0[1]); w.y = cvt_pk_bf16(v0[2], v0[3]); w.z = cvt_pk_bf16(v1[0], v1[1]); w.w = cvt_pk_bf16(v1[2], v1[3]);
                    *(u32x4*)(rowp + bj * HALF) = w; } }
    }
};

__device__ __forceinline__ void map_tiles(int L, int nM, int nN, Unit& u) {
    const int nwg = nM * nN; int wgid = L; { const int q = nwg / NXCD, r = nwg % NXCD, xcd = wgid % NXCD, off = wgid / NXCD; wgid = (xcd < r ? xcd * (q + 1) : r * (q + 1) + (xcd - r) * q) + off; }
    const int nig = WGM * nN, gid = wgid / nig, fm = gid * WGM, gsz = (nM - fm) < WGM ? (nM - fm) : WGM;
    u.pm = fm + ((wgid % nig) % gsz); u.pn = (wgid % nig) / gsz;
}
struct InMain {
    int G, c;
    static constexpr int N1 = 104 * 24, N2 = 24 * 20, N3 = 4 * 24, NTOT = N1 + N2 + N3;
    __device__ __forceinline__ bool next(int i, Unit& u) const {
        const int L = i * G + c; if (L >= NTOT) return false;
        if (L < N1) { map_tiles(L, 104, 24, u); }
        else if (L < N1 + N2) { map_tiles(L - N1, 24, 20, u); u.pm += 104; u.pn += 4; }
        else { map_tiles(L - N1 - N2, 4, 24, u); u.pm += 128; }
        return true;
    }
    __device__ __forceinline__ void a_ready(const Unit&) const {}
    __device__ __forceinline__ void done(const Unit&) const {}
};
struct OneUnit {
    int pm, pn;
    __device__ __forceinline__ bool next(int i, Unit& u) const { if (i > 0) return false; u.pm = pm; u.pn = pn; return true; }
    __device__ __forceinline__ void a_ready(const Unit&) const {}
    __device__ __forceinline__ void done(const Unit&) const {}
};
template <class Epi, class Sched, bool ALIGN_EPI = false, bool SP2 = false>
__device__ __forceinline__ void gemm_phase(PG8_LAS unsigned char* lds, const Gemm g, const Sched& S, const Epi& E) {
    const int tid = threadIdx.x, wid = __builtin_amdgcn_readfirstlane(tid >> 6), lane = tid & 63, wr = wid >> 2, wc = wid & 3, fr = lane & 15, fq = lane >> 4;
    const int K = g.K, nt = K / BK;
    unsigned voffA[2], voffB[2];
#pragma unroll
    for (int i = 0; i < 2; ++i) { int R, C; stage_rc(tid * 16 + i * 8192, R, C); const int Rb = Epi::PERM ? ((R & ~31) + perm32(R & 31)) : R;
        voffA[i] = (unsigned)(R * K + C) * 2u; voffB[i] = (unsigned)(Rb * K + C) * 2u; }
    const size_t kstep = (size_t)(BK * 2);
    const size_t hstep = (size_t)HALF * K * 2;
    const size_t tstep = 2 * hstep;
    const unsigned ldsw = (unsigned)wid * 1024u;
    const int aoff = lds_byte(wr * 64 + fr, fq * 8), boff = lds_byte(wc * 32 + fr, fq * 8);
#define PG8_SA(b, h) (((b) * 2 + (h)) * HTB)
#define PG8_SB(b, h) ((4 + (b) * 2 + (h)) * HTB)
#define PG8_STAGE(bufoff, gbase, voff) do { _Pragma("unroll") for (int _i = 0; _i < 2; ++_i) \
        __builtin_amdgcn_global_load_lds((const unsigned*)((const char*)(gbase) + (voff)[_i]), (PG8_LAS unsigned*)(lds + (bufoff) + ldsw + _i * 8192), 16, 0, 0); } while (0)
#define PG8_LDA(dst, b, h) do { _Pragma("unroll") for (int m = 0; m < 4; ++m) _Pragma("unroll") for (int k = 0; k < 2; ++k) dst[m][k] = *(const PG8_LAS bf16x8*)(lds + PG8_SA(b, h) + aoff + m * 2048 + k * 1024); } while (0)
#define PG8_LDB(dst, b, h) do { _Pragma("unroll") for (int n = 0; n < 2; ++n) _Pragma("unroll") for (int k = 0; k < 2; ++k) dst[n][k] = *(const PG8_LAS bf16x8*)(lds + PG8_SB(b, h) + boff + n * 2048 + k * 1024); } while (0)
#define PG8_MMA(ai, bj, At, Bt) do { __builtin_amdgcn_s_setprio(1); _Pragma("unroll") for (int m = 0; m < 4; ++m) _Pragma("unroll") for (int n = 0; n < 2; ++n) _Pragma("unroll") for (int k = 0; k < 2; ++k) \
        acc[ai][bj][m][n] = __builtin_amdgcn_mfma_f32_16x16x32_bf16(Bt[n][k], At[m][k], acc[ai][bj][m][n], 0, 0, 0); __builtin_amdgcn_s_setprio(0); } while (0)
#define PG8_WAIT_V(n) asm volatile("s_waitcnt vmcnt(" #n ")" ::: "memory")
#define PG8_WAIT_L(n) asm volatile("s_waitcnt lgkmcnt(" #n ")" ::: "memory")
#define PG8_BAR __builtin_amdgcn_s_barrier()
#define PG8_SCHED __builtin_amdgcn_sched_barrier(0)
    Unit cur, nxt; int ui = 0;
    if (!S.next(0, cur)) return;
    f32x4 acc[2][2][4][2];
#pragma unroll
    for (int a = 0; a < 2; ++a)
#pragma unroll
        for (int b = 0; b < 2; ++b)
#pragma unroll
            for (int m = 0; m < 4; ++m)
#pragma unroll
                for (int n = 0; n < 2; ++n) acc[a][b][m][n] = (f32x4){0.f, 0.f, 0.f, 0.f};
    bf16x8 At[4][2], B0[2][2], B1[2][2];
    const char* cA = (const char*)g.A + (size_t)cur.pm * tstep; const char* cB = (const char*)g.Bt + (size_t)cur.pn * tstep;
    S.a_ready(cur);
    if constexpr (SP2) {
        PG8_STAGE(PG8_SB(0, 0), cB, voffB); PG8_STAGE(PG8_SB(0, 1), cB + hstep, voffB); PG8_STAGE(PG8_SA(0, 0), cA, voffA); PG8_STAGE(PG8_SA(0, 1), cA + hstep, voffA);
        if (wr == 1) PG8_BAR;
        PG8_WAIT_V(2); PG8_BAR;
        PG8_STAGE(PG8_SB(1, 0), cB + kstep, voffB); PG8_STAGE(PG8_SA(1, 0), cA + kstep, voffA); PG8_STAGE(PG8_SB(1, 1), cB + hstep + kstep, voffB);
        PG8_WAIT_V(6); PG8_BAR;
    } else {
        PG8_STAGE(PG8_SB(0, 0), cB, voffB); PG8_STAGE(PG8_SA(0, 0), cA, voffA); PG8_STAGE(PG8_SB(0, 1), cB + hstep, voffB); PG8_STAGE(PG8_SA(0, 1), cA + hstep, voffA);
        if (wr == 1) PG8_BAR;
        PG8_WAIT_V(4); PG8_BAR;
        PG8_STAGE(PG8_SB(1, 0), cB + kstep, voffB); PG8_STAGE(PG8_SA(1, 0), cA + kstep, voffA); PG8_STAGE(PG8_SB(1, 1), cB + hstep + kstep, voffB);
        PG8_WAIT_V(6); PG8_BAR;
    }
    for (;;) {
        const bool has_next = S.next(ui + 1, nxt);
        const char* nA = has_next ? (const char*)g.A + (size_t)nxt.pm * tstep : cA; const char* nB = has_next ? (const char*)g.Bt + (size_t)nxt.pn * tstep : cB;
        for (int t = 0; t < nt; t += 2) {
            const bool last = (t == nt - 2);
            const char* a1 = cA + (size_t)(t + 1) * kstep;
            const char* a2 = last ? nA : cA + (size_t)(t + 2) * kstep; const char* b2 = last ? nB : cB + (size_t)(t + 2) * kstep;
            const char* a3 = a2 + kstep; const char* b3 = b2 + kstep;
            if (last && has_next) S.a_ready(nxt);
            if constexpr (SP2) {
            PG8_LDB(B0, 0, 0); PG8_LDB(B1, 0, 1); PG8_SCHED; PG8_LDA(At, 0, 0); PG8_STAGE(PG8_SA(1, 1), a1 + hstep, voffA);
            PG8_WAIT_V(8); PG8_WAIT_L(0); PG8_BAR; PG8_MMA(0, 0, At, B0); PG8_MMA(0, 1, At, B1); PG8_BAR; PG8_SCHED;
            PG8_LDA(At, 0, 1); PG8_STAGE(PG8_SB(0, 0), b2, voffB); PG8_STAGE(PG8_SB(0, 1), b2 + hstep, voffB); PG8_STAGE(PG8_SA(0, 0), a2, voffA);
            PG8_WAIT_V(8); PG8_WAIT_L(0); PG8_BAR; PG8_MMA(1, 0, At, B0); PG8_MMA(1, 1, At, B1); PG8_BAR; PG8_SCHED;
            PG8_LDB(B0, 1, 0); PG8_LDB(B1, 1, 1); PG8_SCHED; PG8_LDA(At, 1, 0); PG8_STAGE(PG8_SA(0, 1), a2 + hstep, voffA);
            PG8_WAIT_V(8); PG8_WAIT_L(0); PG8_BAR; PG8_MMA(0, 0, At, B0); PG8_MMA(0, 1, At, B1); PG8_BAR; PG8_SCHED;
            PG8_LDA(At, 1, 1); PG8_STAGE(PG8_SB(1, 0), b3, voffB); PG8_STAGE(PG8_SB(1, 1), b3 + hstep, voffB); PG8_STAGE(PG8_SA(1, 0), a3, voffA);
            PG8_WAIT_V(8); PG8_WAIT_L(0); PG8_BAR; PG8_MMA(1, 0, At, B0); PG8_MMA(1, 1, At, B1); PG8_BAR; PG8_SCHED;
            } else {
            PG8_LDB(B0, 0, 0); PG8_SCHED; PG8_LDA(At, 0, 0); PG8_STAGE(PG8_SA(1, 1), a1 + hstep, voffA);
            PG8_WAIT_L(8); PG8_BAR; PG8_WAIT_L(0); PG8_MMA(0, 0, At, B0); PG8_BAR; PG8_SCHED;
            PG8_LDB(B1, 0, 1); PG8_STAGE(PG8_SB(0, 0), b2, voffB);
            PG8_BAR; PG8_WAIT_L(0); PG8_MMA(0, 1, At, B1); PG8_BAR;
            PG8_LDA(At, 0, 1); PG8_STAGE(PG8_SA(0, 0), a2, voffA);
            PG8_BAR; PG8_WAIT_L(0); PG8_MMA(1, 0, At, B0); PG8_BAR; PG8_SCHED;
            PG8_STAGE(PG8_SB(0, 1), b2 + hstep, voffB);
            PG8_WAIT_V(6); PG8_BAR; PG8_MMA(1, 1, At, B1); PG8_BAR;
            PG8_LDB(B0, 1, 0); PG8_SCHED; PG8_LDA(At, 1, 0); PG8_STAGE(PG8_SA(0, 1), a2 + hstep, voffA);
            PG8_WAIT_L(8); PG8_BAR; PG8_WAIT_L(0); PG8_MMA(0, 0, At, B0); PG8_BAR; PG8_SCHED;
            PG8_LDB(B1, 1, 1); PG8_STAGE(PG8_SB(1, 0), b3, voffB);
            PG8_BAR; PG8_WAIT_L(0); PG8_MMA(0, 1, At, B1); PG8_BAR;
            PG8_LDA(At, 1, 1); PG8_STAGE(PG8_SA(1, 0), a3, voffA);
            PG8_BAR; PG8_WAIT_L(0); PG8_MMA(1, 0, At, B0); PG8_BAR; PG8_SCHED;
            PG8_STAGE(PG8_SB(1, 1), b3 + hstep, voffB);
            PG8_WAIT_V(6); PG8_BAR; PG8_MMA(1, 1, At, B1); PG8_BAR;
            }
        }
        if constexpr (ALIGN_EPI) { if (wr == 0) PG8_BAR; }
        if constexpr (!Epi::AFTER_DRAIN) { E(acc, cur, wr, wc, fr, fq); S.done(cur); }
        if (!has_next) break;
#pragma unroll
        for (int a = 0; a < 2; ++a)
#pragma unroll
            for (int b = 0; b < 2; ++b)
#pragma unroll
                for (int m = 0; m < 4; ++m)
#pragma unroll
                    for (int n = 0; n < 2; ++n) acc[a][b][m][n] = (f32x4){0.f, 0.f, 0.f, 0.f};
        cur = nxt; cA = nA; cB = nB; ++ui;
        if constexpr (ALIGN_EPI) { if (wr == 1) PG8_BAR; }
    }
    PG8_WAIT_V(0);
    if constexpr (!ALIGN_EPI) { if (wr == 0) PG8_BAR; }
    PG8_BAR;
    if constexpr (Epi::AFTER_DRAIN) { E.fused(acc, cur, wr, wc, fr, fq, lds, wid, lane); S.done(cur); }
#undef PG8_SA
#undef PG8_SB
#undef PG8_STAGE
#undef PG8_LDA
#undef PG8_LDB
#undef PG8_MMA
#undef PG8_WAIT_V
#undef PG8_WAIT_L
#undef PG8_BAR
#undef PG8_SCHED
}
}

namespace pa {
using bf16 = __hip_bfloat16;
typedef short bf16x8 __attribute__((ext_vector_type(8)));
typedef short s16x4 __attribute__((ext_vector_type(4)));
typedef float f32x16 __attribute__((ext_vector_type(16)));
typedef float f32x4 __attribute__((ext_vector_type(4)));
typedef unsigned u32x4 __attribute__((ext_vector_type(4)));
template <class A, class Bt> struct same_t { static constexpr bool v = false; };
template <class A> struct same_t<A, A> { static constexpr bool v = true; };
constexpr int D = 128, LDR = 1024, LDY = 2048;
constexpr float SCALE = 0.08838834764831845f;
constexpr float THR = 8.f;
constexpr int NW = 8, QBLK = 32, KVBLK = 64, QB = NW * QBLK;
constexpr int SHM_V = KVBLK * D * 2, SHM_K = KVBLK * D * 2;
constexpr int LDS_WS = 2 * SHM_V + 2 * SHM_K, LDS_BIAS = LDS_WS + NW * 64 * 4, LDS_BYTES = LDS_BIAS + 2 * 2048 * 4;
enum { ORDER_NATURAL = 0, ORDER_REVERSED = 1, ORDER_PAIRED = 2, ORDER_XCD = 4 };
#define KSWZ(row, colB) ((row) * 256 + ((colB) ^ (((row) & 7) << 4)))
#define SBAR() __builtin_amdgcn_sched_barrier(0)
__device__ __forceinline__ int v_st(int k, int c) { const int kk = (k & ~0xC) | ((k & 4) << 1) | ((k & 8) >> 1); return ((kk >> 3) * 4 + (c >> 5)) * 512 + ((kk & 7) * 32 + (c & 31)) * 2; }
__device__ __forceinline__ int v_rd_base(int lane) { return ((lane & 3) << 3) | (((lane >> 2) & 3) << 6) | (((lane >> 4) & 1) << 5) | (((lane >> 5) & 1) << 8); }
constexpr int v_rd_off(int d0, int ks, int half) { return d0 * 512 + ks * 4096 + half * 2048; }
__device__ __forceinline__ int crow(int r, int hi) { return (r & 3) + 8 * (r >> 2) + 4 * hi; }
__device__ __forceinline__ unsigned cvtpk(float lo, float hi) {
    unsigned r; asm volatile("v_cvt_pk_bf16_f32 %0, %1, %2" : "=v"(r) : "v"(lo), "v"(hi)); return r;
}
__device__ __forceinline__ bf16x8 pack8(f32x4 a, f32x4 b) {
    u32x4 w = {cvtpk(a[0], a[1]), cvtpk(a[2], a[3]), cvtpk(b[0], b[1]), cvtpk(b[2], b[3])};
    return *reinterpret_cast<bf16x8*>(&w);
}
template <class T> __device__ __forceinline__ bf16x8 load8(const T* p) {
    if constexpr (same_t<T, float>::v) { return pack8(*(const f32x4*)p, *(const f32x4*)(p + 4)); }
    else { return *reinterpret_cast<const bf16x8*>(p); }
}
__device__ __forceinline__ void mask_tile(f32x16& p0, f32x16& p1, int dq, unsigned W) {
    const float NEG = -__builtin_inff();
#pragma unroll
    for (int r = 0; r < 16; ++r) {
        const int c = (r & 3) + 8 * (r >> 2);
        if ((unsigned)(dq - c) >= W) p0[r] = NEG;
        if ((unsigned)(dq - c - 32) >= W) p1[r] = NEG;
    }
}
__device__ __forceinline__ void partialSM(f32x16& p0, f32x16& p1, float& m_reg, float& mn, float& alpha) {
    float pmax = p0[0]; for (int r = 1; r < 16; ++r) pmax = fmaxf(pmax, p0[r]); for (int r = 0; r < 16; ++r) pmax = fmaxf(pmax, p1[r]);
    { auto rr = __builtin_amdgcn_permlane32_swap(__float_as_uint(pmax), __float_as_uint(pmax), false, false);
      pmax = fmaxf(__uint_as_float(rr[0]), __uint_as_float(rr[1])); }
    constexpr float C2 = 1.4426950408889634f * SCALE;
    if (__builtin_expect(__all((pmax - m_reg) * SCALE <= THR), 1)) { mn = m_reg; alpha = 1.f; }
    else { mn = fmaxf(m_reg, pmax); alpha = __builtin_amdgcn_exp2f((m_reg - mn) * C2); m_reg = mn; }
    const float mnL = -mn * C2;
    for (int r = 0; r < 16; ++r) p0[r] = fmaf(p0[r], C2, mnL); for (int r = 0; r < 16; ++r) p1[r] = fmaf(p1[r], C2, mnL);
    for (int r = 0; r < 16; ++r) p0[r] = __builtin_amdgcn_exp2f(p0[r]);
}
__device__ __forceinline__ void finishSM(f32x16& p0, f32x16& p1, float alpha, float& l_reg, bf16x8& pa0, bf16x8& pa1, bf16x8& pa2, bf16x8& pa3) {
    for (int r = 0; r < 16; ++r) p1[r] = __builtin_amdgcn_exp2f(p1[r]);
    float ps = 0; for (int r = 0; r < 16; ++r) ps += p0[r]; for (int r = 0; r < 16; ++r) ps += p1[r];
    { auto rr = __builtin_amdgcn_permlane32_swap(__float_as_uint(ps), __float_as_uint(ps), false, false);
      ps = __uint_as_float(rr[0]) + __uint_as_float(rr[1]); }
    l_reg = l_reg * alpha + ps;
#define PK4(P, B_, OUT) do { unsigned a0 = cvtpk(P[B_+0], P[B_+1]), a1 = cvtpk(P[B_+2], P[B_+3]);                          \
        unsigned b0 = cvtpk(P[B_+4], P[B_+5]), b1 = cvtpk(P[B_+6], P[B_+7]);                                             \
        auto r0 = __builtin_amdgcn_permlane32_swap(a0, b0, false, false); auto r1 = __builtin_amdgcn_permlane32_swap(a1, b1, false, false); \
        u32x4 w = {r0[0], r1[0], r0[1], r1[1]}; OUT = *reinterpret_cast<bf16x8*>(&w); } while (0)
    PK4(p0, 0, pa0); PK4(p0, 8, pa1); PK4(p1, 0, pa2); PK4(p1, 8, pa3);
#undef PK4
}
template <int KB>
__device__ __forceinline__ void qkt(f32x16& p0, f32x16& p1, const char* K_lds, const char* bias_t, int r32, int hi, const bf16x8* qr) {
    { const f32x4 b0 = *(const f32x4*)(bias_t), b1 = *(const f32x4*)(bias_t + 32), b2 = *(const f32x4*)(bias_t + 64), b3 = *(const f32x4*)(bias_t + 96);
      const f32x4 c0 = *(const f32x4*)(bias_t + 128), c1 = *(const f32x4*)(bias_t + 160), c2 = *(const f32x4*)(bias_t + 192), c3 = *(const f32x4*)(bias_t + 224);
      p0 = (f32x16){b0[0], b0[1], b0[2], b0[3], b1[0], b1[1], b1[2], b1[3], b2[0], b2[1], b2[2], b2[3], b3[0], b3[1], b3[2], b3[3]};
      p1 = (f32x16){c0[0], c0[1], c0[2], c0[3], c1[0], c1[1], c1[2], c1[3], c2[0], c2[1], c2[2], c2[3], c3[0], c3[1], c3[2], c3[3]}; }
    const char* kb[4];
#pragma unroll
    for (int dd = 0; dd < 4; ++dd) kb[dd] = K_lds + KB * SHM_K + KSWZ(r32, (dd * 16 + hi * 8) * 2);
#pragma unroll
    for (int d0 = 0; d0 < 8; ++d0) { const char* a = kb[d0 & 3] + (d0 >> 2) * 128;
        bf16x8 b0 = *reinterpret_cast<const bf16x8*>(a);
        bf16x8 b1 = *reinterpret_cast<const bf16x8*>(a + 32 * 256);
        p0 = __builtin_amdgcn_mfma_f32_32x32x16_bf16(b0, qr[d0], p0, 0, 0, 0);
        p1 = __builtin_amdgcn_mfma_f32_32x32x16_bf16(b1, qr[d0], p1, 0, 0, 0); }
}
template <int VB>
__device__ __forceinline__ void pv_tile(f32x16* o, int vb0, bf16x8 pa0, bf16x8 pa1, bf16x8 pa2, bf16x8 pa3) {
#define TRRD(dst, off) asm volatile("ds_read_b64_tr_b16 %0, %1 offset:%2" : "=&v"(dst) : "v"(vb0), "i"(off) : "memory")
#define PV_D0(d0) do { s16x4 l0, l1, l2, l3, h0, h1, h2, h3; constexpr int b_ = VB * SHM_V + v_rd_off(d0, 0, 0);     \
        TRRD(l0, b_); TRRD(h0, b_ + 2048); TRRD(l1, b_ + 4096); TRRD(h1, b_ + 6144); TRRD(l2, b_ + 8192); TRRD(h2, b_ + 10240); TRRD(l3, b_ + 12288); TRRD(h3, b_ + 14336); \
        asm volatile("s_waitcnt lgkmcnt(0)" ::: "memory"); SBAR();                 \
        o[d0] = __builtin_amdgcn_mfma_f32_32x32x16_bf16(pa0, (bf16x8){l0[0], l0[1], l0[2], l0[3], h0[0], h0[1], h0[2], h0[3]}, o[d0], 0, 0, 0);   \
        o[d0] = __builtin_amdgcn_mfma_f32_32x32x16_bf16(pa1, (bf16x8){l1[0], l1[1], l1[2], l1[3], h1[0], h1[1], h1[2], h1[3]}, o[d0], 0, 0, 0);   \
        o[d0] = __builtin_amdgcn_mfma_f32_32x32x16_bf16(pa2, (bf16x8){l2[0], l2[1], l2[2], l2[3], h2[0], h2[1], h2[2], h2[3]}, o[d0], 0, 0, 0);   \
        o[d0] = __builtin_amdgcn_mfma_f32_32x32x16_bf16(pa3, (bf16x8){l3[0], l3[1], l3[2], l3[3], h3[0], h3[1], h3[2], h3[3]}, o[d0], 0, 0, 0); } while (0)
    PV_D0(0); PV_D0(1); PV_D0(2); PV_D0(3);
#undef PV_D0
#undef TRRD
}

struct BlockRef { const bf16* Q; const bf16* K; const bf16* V; const float* Bias; const bf16* GA; bf16* Y; const float* gattn; int P0; };
struct Seam { bf16x8 qr[8]; bf16x8 st_v0, st_v1, st_k0, st_k1; };
#define ROW(p, k0, rr) ((p) + (size_t)((k0) + (rr)) * LDR + sc)
#define VMW() asm volatile("s_waitcnt vmcnt(0)" ::: "memory")
#define VMWN(n) asm volatile("s_waitcnt vmcnt(%0)" :: "i"(n) : "memory")
#define SLOAD_H(Kp, Vp, k0) do { S.st_v0 = load8<bf16>(ROW(Vp, k0, sr)); S.st_v1 = load8<bf16>(ROW(Vp, k0, 32 + sr));              \
                         S.st_k0 = load8<bf16>(ROW(Kp, k0, sr)); S.st_k1 = load8<bf16>(ROW(Kp, k0, 32 + sr)); } while (0)
#define SWRITE_HK(bf) do { *(bf16x8*)(K_lds + (bf) * SHM_K + kws) = S.st_k0; *(bf16x8*)(K_lds + (bf) * SHM_K + kws + 32 * 256) = S.st_k1; } while (0)
#define SWRITE_HV(bf) do { *(bf16x8*)(V_lds + (bf) * SHM_V + vst0) = S.st_v0; *(bf16x8*)(V_lds + (bf) * SHM_V + vst1) = S.st_v1; } while (0)
#define SWRITE_H(bf) do { SWRITE_HV(bf); SWRITE_HK(bf); } while (0)
__device__ __forceinline__ void causal_prime(const BlockRef& cur, char* lds, Seam& S) {
    const int tid = threadIdx.x, wid = __builtin_amdgcn_readfirstlane(tid >> 6), lane = tid & 63, r32 = lane & 31, hi = lane >> 5;
    const int sr = tid >> 4, sc = (tid & 15) * 8, kws = KSWZ(sr, sc * 2); char* K_lds = lds + 2 * SHM_V;
#pragma unroll
    for (int d0 = 0; d0 < 8; ++d0) S.qr[d0] = load8<bf16>(cur.Q + (size_t)(wid * QBLK + r32) * LDR + d0 * 16 + hi * 8);
    SLOAD_H(cur.K, cur.V, 0);
    if (tid * 4 < cur.P0 + QB) *(f32x4*)(lds + LDS_BIAS + tid * 16) = *(const f32x4*)(cur.Bias + tid * 4);
    VMW(); SWRITE_HK(0);
    __syncthreads();
}
__device__ __forceinline__ void causal_block(const BlockRef& cur, const BlockRef& nxt, char* lds, Seam& S, int par  ) {
    int tid = threadIdx.x; asm volatile("" : "+v"(tid));
    const int wid = __builtin_amdgcn_readfirstlane(tid >> 6), lane = tid & 63, r32 = lane & 31, hi = lane >> 5;
    const int NT = (cur.P0 + QB) / KVBLK;
    const int qlo = cur.P0 + wid * QBLK, qm = qlo + r32 - 4 * hi;
    char* V_lds = lds; char* K_lds = lds + 2 * SHM_V;
    const char* bias_l = lds + LDS_BIAS + par * 8192 + hi * 16;
    float* ws = (float*)(lds + LDS_WS) + wid * 64; float* li_l = ws, * al_l = ws + 32;
    float m_reg = -1e30f, l_reg = 0; f32x16 o[4] = {};
    const int sr = tid >> 4, sc = (tid & 15) * 8, vst0 = v_st(sr, sc), vst1 = v_st(32 + sr, sc), kws = KSWZ(sr, sc * 2);
    const int vb0 = (int)(uintptr_t)V_lds + v_rd_base(lane);
    const bf16* Kh = cur.K; const bf16* Vh = cur.V;
#define RESC(a) do { if (__any((a) < 1.f)) { if (hi == 0) al_l[r32] = (a); asm volatile("s_waitcnt lgkmcnt(0)" ::: "memory");              \
                     for (int d_ = 0; d_ < 4; ++d_) for (int r = 0; r < 16; ++r) o[d_][r] *= al_l[crow(r, hi)]; } } while (0)
#define KBASE(t) ((t) * KVBLK)
#define MASKT(P0_, P1_, t) do { const int kb_ = KBASE(t); if (kb_ + KVBLK - 1 > qlo) mask_tile(P0_, P1_, qm - kb_, 0x40000000u); } while (0)
#define SEAM_K0() do { VMWN(8); SWRITE_HK(0); SBAR(); } while (0)
    f32x16 pA0, pA1, pB0, pB1; float mnA, mnB, alA, alB; bf16x8 pa0, pa1, pa2, pa3;
    SWRITE_HV(0); SBAR();
    if (NT > 1) SLOAD_H(Kh, Vh, KBASE(1));
    SBAR(); qkt<0>(pA0, pA1, K_lds, bias_l + KBASE(0) * 4, r32, hi, S.qr);
    MASKT(pA0, pA1, 0); partialSM(pA0, pA1, m_reg, mnA, alA);
    if (NT > 1) { VMW(); SWRITE_H(1); }
    __syncthreads();
#define HALF_STEP(PX0, PX1, mnX, alX, PY0, PY1, alY, t, KB, VB, SB) do {                                                      \
        SBAR(); qkt<KB>(PX0, PX1, K_lds, bias_l + KBASE(t) * 4, r32, hi, S.qr);                                               \
        finishSM(PY0, PY1, alY, l_reg, pa0, pa1, pa2, pa3); SBAR();                                                           \
        if ((t) + 1 < NT) { SLOAD_H(Kh, Vh, KBASE((t) + 1)); SBAR(); }                                                        \
        pv_tile<VB>(o, vb0, pa0, pa1, pa2, pa3); MASKT(PX0, PX1, (t)); partialSM(PX0, PX1, m_reg, mnX, alX);                  \
        __syncthreads();                                                                                                      \
        if ((t) + 1 < NT) { VMW(); SWRITE_H(SB); }                                                                            \
        RESC(alX); __syncthreads(); } while (0)
    for (int t = 1; t + 1 < NT; t += 2) {
        HALF_STEP(pB0, pB1, mnB, alB, pA0, pA1, alA, t, 1, 0, 0);
        HALF_STEP(pA0, pA1, mnA, alA, pB0, pB1, alB, t + 1, 0, 1, 1);
    }
    const bool even = (NT & 1) == 0;
    if (even) { SBAR(); qkt<1>(pB0, pB1, K_lds, bias_l + KBASE(NT - 1) * 4, r32, hi, S.qr); SBAR(); }
    __builtin_amdgcn_global_load_lds((const __attribute__((address_space(1))) unsigned*)(nxt.Bias + tid * 4), (__attribute__((address_space(3))) unsigned*)(lds + LDS_BIAS + (par ^ 1) * 8192 + wid * 1024), 16, 0, 0);
    SBAR();
    SLOAD_H(nxt.K, nxt.V, 0); SBAR();
#pragma unroll
    for (int d0 = 0; d0 < 8; ++d0) S.qr[d0] = load8<bf16>(nxt.Q + (size_t)(wid * QBLK + r32) * LDR + d0 * 16 + hi * 8);
    SBAR();
    finishSM(pA0, pA1, alA, l_reg, pa0, pa1, pa2, pa3); SBAR();
    pv_tile<0>(o, vb0, pa0, pa1, pa2, pa3);
    if (even) { MASKT(pB0, pB1, NT - 1); partialSM(pB0, pB1, m_reg, mnB, alB); __syncthreads(); RESC(alB);
        finishSM(pB0, pB1, alB, l_reg, pa0, pa1, pa2, pa3); SBAR(); pv_tile<1>(o, vb0, pa0, pa1, pa2, pa3); }
    SBAR(); SEAM_K0();
    if (hi == 0) li_l[r32] = l_reg; asm volatile("s_waitcnt lgkmcnt(0)" ::: "memory");
    float rs[16];
#pragma unroll
    for (int r = 0; r < 16; ++r) { const float rl = __builtin_amdgcn_rcpf(li_l[crow(r, hi)]); float s = 0.f;
#pragma unroll
        for (int d0 = 0; d0 < 4; ++d0) { o[d0][r] *= rl; s = fmaf(o[d0][r], o[d0][r], s); }
        s += __shfl_xor(s, 1); s += __shfl_xor(s, 2); s += __shfl_xor(s, 4); s += __shfl_xor(s, 8); s += __shfl_xor(s, 16);
        rs[r] = __builtin_amdgcn_rsqf(s * (1.0f / 128.0f) + 1e-6f); }
    float gw[4];
#pragma unroll
    for (int d0 = 0; d0 < 4; ++d0) gw[d0] = cur.gattn[d0 * 32 + r32];
#pragma unroll
    for (int rh = 0; rh < 2; ++rh) {
        unsigned short gq[8][4];
#pragma unroll
        for (int r8 = 0; r8 < 8; ++r8) { const int orow = wid * QBLK + crow(rh * 8 + r8, hi);
#pragma unroll
            for (int d0 = 0; d0 < 4; ++d0) gq[r8][d0] = *(const unsigned short*)(cur.GA + (size_t)orow * LDR + d0 * 32 + r32); }
#pragma unroll
        for (int r8 = 0; r8 < 8; ++r8) { const int r = rh * 8 + r8, orow = wid * QBLK + crow(r, hi);
#pragma unroll
            for (int d0 = 0; d0 < 4; ++d0) { const float ga = __uint_as_float((unsigned)gq[r8][d0] << 16);
                const float v = o[d0][r] * rs[r] * gw[d0] * ga; const float vn = __shfl_xor(v, 1);
                if ((r32 & 1) == 0) *(unsigned*)(cur.Y + (size_t)orow * LDY + d0 * 32 + r32) = cvtpk(v, vn); } }
        asm volatile("" ::: "memory"); }
    __syncthreads();
#undef RESC
#undef KBASE
#undef MASKT
#undef SEAM_K0
#undef HALF_STEP
}
#undef ROW
#undef VMW
#undef VMWN
#undef SLOAD_H
#undef SWRITE_HK
#undef SWRITE_HV
#undef SWRITE_H

struct SwaItem { int bh, qb0, qb1; };
__device__ __forceinline__ SwaItem swa_decode(int L, int nbh, int nqb, int nx) {
    SwaItem it; int x;
    { const int xcd = L & 7, k = L >> 3, gi = k / nx, r = k - gi * nx; it.bh = gi * 8 + xcd; x = r; }
    it.qb0 = x; it.qb1 = nqb - 1 - x;
    return it;
}
struct PTensors { const bf16* Q; const bf16* K; const bf16* V; const float* Bias; const bf16* GA; bf16* Y; const float* gattn; };
__device__ __forceinline__ BlockRef swa_ref(const SwaItem& it, int pass, const PTensors& T) {
    const int qb = pass ? it.qb1 : it.qb0, b = it.bh >> 3, h = it.bh & 7; const size_t row0 = (size_t)b * 2048 + (size_t)qb * QB;
    BlockRef r; r.Q = T.Q + row0 * LDR + h * D; r.K = T.K + (size_t)b * 2048 * LDR + h * D; r.V = T.V + (size_t)b * 2048 * LDR + h * D;
    r.Bias = T.Bias + (size_t)it.bh * 2048; r.GA = T.GA + row0 * LDR + h * D; r.Y = T.Y + row0 * LDY + h * D; r.gattn = T.gattn + h * D; r.P0 = qb * QB;
    return r;
}
__device__ __forceinline__ void prompt_item(char* lds, const PTensors& T, int L) {
    constexpr int nqb = 8, nx = 4, nbh = 128;
    const SwaItem it = swa_decode(L, nbh, nqb, nx);
    const BlockRef b1 = swa_ref(it, 1, T);
    BlockRef cur = swa_ref(it, 0, T), nxt = b1;
    Seam S;
    causal_prime(cur, lds, S);
    int par = 0;
#pragma unroll 1
    for (int p = 0; p < 2; ++p) { causal_block(cur, nxt, lds, S, par); cur = b1; nxt = b1; par ^= 1; }
}
}

namespace sa {
using namespace pa;
constexpr int SA_BIAS = 131072, SA_WS = SA_BIAS + 4160 * 4, SA_M = SA_WS + 2048, SA_L = SA_M + 1024, SA_WT = SA_L + 1024, LDS_BYTES = SA_WT + 64;
constexpr float SQRTD = 11.313708498984761f, C2 = 1.4426950408889634f * SCALE;
struct STensors { const bf16* Q; const bf16* Kn; const bf16* Vn; const float* ck; const float* cv; const float* clogf; const float* logf_s; const bf16* GA; bf16* Y; const float* gattn; };

__device__ __forceinline__ void sm_step(f32x16& p, float& m_reg, float& l_reg, float& alpha, bf16x8& pa0, bf16x8& pa1) {
    float pmax = p[0];
#pragma unroll
    for (int r = 1; r < 16; ++r) pmax = fmaxf(pmax, p[r]);
    { auto rr = __builtin_amdgcn_permlane32_swap(__float_as_uint(pmax), __float_as_uint(pmax), false, false);
      pmax = fmaxf(__uint_as_float(rr[0]), __uint_as_float(rr[1])); }
    float mn;
    if (__builtin_expect(__all((pmax - m_reg) * SCALE <= THR), 1)) { mn = m_reg; alpha = 1.f; }
    else { mn = fmaxf(m_reg, pmax); alpha = __builtin_amdgcn_exp2f((m_reg - mn) * C2); m_reg = mn; }
    const float mnL = -mn * C2;
    float ps = 0.f;
#pragma unroll
    for (int r = 0; r < 16; ++r) { p[r] = __builtin_amdgcn_exp2f(fmaf(p[r], C2, mnL)); ps += p[r]; }
    { auto rr = __builtin_amdgcn_permlane32_swap(__float_as_uint(ps), __float_as_uint(ps), false, false);
      ps = __uint_as_float(rr[0]) + __uint_as_float(rr[1]); }
    l_reg = l_reg * alpha + ps;
#define PK4(P, B_, OUT) do { unsigned a0 = cvtpk(P[B_+0], P[B_+1]), a1 = cvtpk(P[B_+2], P[B_+3]);                          \
        unsigned b0 = cvtpk(P[B_+4], P[B_+5]), b1 = cvtpk(P[B_+6], P[B_+7]);                                             \
        auto r0 = __builtin_amdgcn_permlane32_swap(a0, b0, false, false); auto r1 = __builtin_amdgcn_permlane32_swap(a1, b1, false, false); \
        u32x4 w = {r0[0], r1[0], r0[1], r1[1]}; OUT = *reinterpret_cast<bf16x8*>(&w); } while (0)
    PK4(p, 0, pa0); PK4(p, 8, pa1);
#undef PK4
}

__device__ __forceinline__ void sample_unit(char* lds, int b, int h, const STensors& T) {
    const int tid = threadIdx.x, wid = __builtin_amdgcn_readfirstlane(tid >> 6); int lane = tid & 63; asm volatile("" : "+v"(lane));
    const int r32 = lane & 31, hi = lane >> 5;
    char* Kt = lds + wid * 16384; char* Vt = Kt + 8192;
    float* biasL = (float*)(lds + SA_BIAS);
    float* ws = (float*)(lds + SA_WS) + wid * 64; float* li_l = ws; float* al_l = ws + 32;
    float* Mx = (float*)(lds + SA_M); float* Lx = (float*)(lds + SA_L); float* wt = (float*)(lds + SA_WT);
    {
        const float* lf = T.clogf + ((size_t)b * 4096 + 512 * wid + 8 * lane) * 8 + h;
        float v[8], e[8];
#pragma unroll
        for (int k = 0; k < 8; ++k) v[k] = lf[k * 8];
        float run = 0.f;
#pragma unroll
        for (int k = 7; k >= 0; --k) { e[k] = run; run += v[k]; }
        float incl = run;
#pragma unroll
        for (int off = 1; off < 64; off <<= 1) { const float t = __shfl_down(incl, off); if (lane + off < 64) incl += t; }
        const float excl = incl - run;
        if (lane == 0) wt[wid] = incl;
        float nv = 0.f;
        if (wid == 0) { if (lane < 32) nv = T.logf_s[((size_t)b * 32 + lane) * 8 + h];
#pragma unroll
            for (int off = 1; off < 32; off <<= 1) { const float t = __shfl_up(nv, off); if (lane >= off) nv += t; } }
        __syncthreads();
        float X = 0.f;
        for (int w2 = wid + 1; w2 < 8; ++w2) X += wt[w2];
#pragma unroll
        for (int k = 0; k < 8; ++k) biasL[512 * wid + 8 * lane + k] = (e[k] + excl + X) * SQRTD;
        if (wid == 0 && lane < 32) biasL[4096 + lane] = -nv * SQRTD;
    }
    bf16x8 qr[8];
    { const bf16* qp = T.Q + ((size_t)b * 32 + r32) * 1024 + h * 128 + hi * 8;
#pragma unroll
      for (int d0 = 0; d0 < 8; ++d0) qr[d0] = load8<bf16>(qp + d0 * 16); }
    __syncthreads();
    float m_reg = -1e30f, l_reg = 0.f; f32x16 o[4] = {};
    const int vb0 = (int)(uintptr_t)Vt + v_rd_base(lane);
    const char* ckb = (const char*)(T.ck + (((size_t)b * 4096) * 8 + h) * 128);
    const char* cvb = (const char*)(T.cv + (((size_t)b * 4096) * 8 + h) * 128);
    const unsigned lofs = (unsigned)(hi * 4096 + r32 * 16);
    char* const kwb0 = Kt + KSWZ(0 + hi, r32 * 8); char* const kwb1 = Kt + KSWZ(2 + hi, r32 * 8); char* const kwb2 = Kt + KSWZ(4 + hi, r32 * 8); char* const kwb3 = Kt + KSWZ(6 + hi, r32 * 8);
    char* const vwb = Vt + ((r32 * 4) >> 5) * 512 + hi * 64 + ((r32 * 4) & 31) * 2;
    f32x4 stg[16];
#define SA_ISSUE(src, kb) do { const char* s_ = (src) + (size_t)(kb) * 4096; _Pragma("unroll") for (int i = 0; i < 16; ++i) stg[i] = *(const f32x4*)(s_ + (size_t)i * 8192 + lofs); } while (0)
#define SA_WRITE_K() do { _Pragma("unroll") for (int i = 0; i < 16; ++i) { uint2 w_; w_.x = cvtpk(stg[i][0], stg[i][1]); w_.y = cvtpk(stg[i][2], stg[i][3]); \
        char* kb_ = (i & 3) == 0 ? kwb0 : ((i & 3) == 1 ? kwb1 : ((i & 3) == 2 ? kwb2 : kwb3)); *(uint2*)(kb_ + (i >> 2) * 2048) = w_; } } while (0)
#define SA_WRITE_V() do { _Pragma("unroll") for (int i = 0; i < 16; ++i) { uint2 w_; w_.x = cvtpk(stg[i][0], stg[i][1]); w_.y = cvtpk(stg[i][2], stg[i][3]); \
        *(uint2*)(vwb + (i & 1) * 128 + ((i >> 1) & 1) * 2048 + ((i >> 2) & 1) * 256 + ((i >> 3) & 1) * 4096) = w_; } } while (0)
#define SA_VMW() asm volatile("s_waitcnt vmcnt(0)" ::: "memory")
#define SA_LGW() asm volatile("s_waitcnt lgkmcnt(0)" ::: "memory")
#define SA_QKT(p, kb) do { const char* bt_ = (const char*)(biasL + (kb) + 4 * hi); \
        { const f32x4 b0 = *(const f32x4*)(bt_), b1 = *(const f32x4*)(bt_ + 32), b2 = *(const f32x4*)(bt_ + 64), b3 = *(const f32x4*)(bt_ + 96); \
          p = (f32x16){b0[0], b0[1], b0[2], b0[3], b1[0], b1[1], b1[2], b1[3], b2[0], b2[1], b2[2], b2[3], b3[0], b3[1], b3[2], b3[3]}; } \
        _Pragma("unroll") for (int d0 = 0; d0 < 8; ++d0) { const bf16x8 kf = *(const bf16x8*)(Kt + KSWZ(r32, ((d0 & 3) * 16 + hi * 8) * 2) + (d0 >> 2) * 128); \
            p = __builtin_amdgcn_mfma_f32_32x32x16_bf16(kf, qr[d0], p, 0, 0, 0); } } while (0)
#define SA_RESC(a) do { if (__any((a) < 1.f)) { if (hi == 0) al_l[r32] = (a); SA_LGW();              \
        _Pragma("unroll") for (int d_ = 0; d_ < 4; ++d_) _Pragma("unroll") for (int r = 0; r < 16; ++r) o[d_][r] *= al_l[crow(r, hi)]; } } while (0)
#define SA_TRRD(dst, off) asm volatile("ds_read_b64_tr_b16 %0, %1 offset:%2" : "=&v"(dst) : "v"(vb0), "i"(off) : "memory")
#define SA_PV() do { _Pragma("unroll") for (int d0 = 0; d0 < 4; ++d0) { s16x4 l0, h0, l1, h1; \
        if (d0 == 0) { SA_TRRD(l0, 0); SA_TRRD(h0, 2048); SA_TRRD(l1, 4096); SA_TRRD(h1, 6144); } \
        else if (d0 == 1) { SA_TRRD(l0, 512); SA_TRRD(h0, 2560); SA_TRRD(l1, 4608); SA_TRRD(h1, 6656); } \
        else if (d0 == 2) { SA_TRRD(l0, 1024); SA_TRRD(h0, 3072); SA_TRRD(l1, 5120); SA_TRRD(h1, 7168); } \
        else { SA_TRRD(l0, 1536); SA_TRRD(h0, 3584); SA_TRRD(l1, 5632); SA_TRRD(h1, 7680); } \
        SA_LGW(); SBAR(); \
        o[d0] = __builtin_amdgcn_mfma_f32_32x32x16_bf16(pa0, (bf16x8){l0[0], l0[1], l0[2], l0[3], h0[0], h0[1], h0[2], h0[3]}, o[d0], 0, 0, 0); \
        o[d0] = __builtin_amdgcn_mfma_f32_32x32x16_bf16(pa1, (bf16x8){l1[0], l1[1], l1[2], l1[3], h1[0], h1[1], h1[2], h1[3]}, o[d0], 0, 0, 0); } } while (0)
    const int kw0 = 512 * wid;
    SA_ISSUE(ckb, kw0);
#pragma unroll 1
    for (int i = 0; i < 16; ++i) {
        const int kb = kw0 + 32 * i;
        f32x16 p; float alpha; bf16x8 pa0, pa1;
        SA_VMW(); SA_WRITE_K(); SBAR();
        SA_ISSUE(cvb, kb); SBAR();
        SA_LGW(); SA_QKT(p, kb);
        sm_step(p, m_reg, l_reg, alpha, pa0, pa1);
        SA_VMW(); SA_WRITE_V(); SBAR();
        if (i + 1 < 16) SA_ISSUE(ckb, kb + 32);
        SBAR();
        SA_RESC(alpha);
        SA_LGW(); SA_PV();
    }
    if (wid == 0) {
        const bf16* kn = T.Kn + ((size_t)b * 32 + (lane >> 4)) * 1024 + h * 128 + (lane & 15) * 8;
        const bf16* vn = T.Vn + ((size_t)b * 32 + (lane >> 4)) * 1024 + h * 128 + (lane & 15) * 8;
        bf16x8 kk[8], vv[8];
#pragma unroll
        for (int i = 0; i < 8; ++i) { kk[i] = load8<bf16>(kn + (size_t)i * 4096); vv[i] = load8<bf16>(vn + (size_t)i * 4096); }
#pragma unroll
        for (int i = 0; i < 8; ++i) { const int row = 4 * i + (lane >> 4); *(bf16x8*)(Kt + KSWZ(row, (lane & 15) * 16)) = kk[i]; *(bf16x8*)(Vt + v_st(row, (lane & 15) * 8)) = vv[i]; }
        f32x16 p; float alpha; bf16x8 pa0, pa1;
        SA_LGW(); SA_QKT(p, 4096);
        { const float NEG = -__builtin_inff();
#pragma unroll
          for (int r = 0; r < 16; ++r) if (crow(r, hi) > r32) p[r] = NEG; }
        sm_step(p, m_reg, l_reg, alpha, pa0, pa1);
        SA_RESC(alpha);
        SA_LGW(); SA_PV();
    }
    if (hi == 0) Mx[wid * 32 + r32] = m_reg;
    __syncthreads();
    { float ms = Mx[r32];
#pragma unroll
      for (int w2 = 1; w2 < 8; ++w2) ms = fmaxf(ms, Mx[w2 * 32 + r32]);
      const float f = __builtin_amdgcn_exp2f((m_reg - ms) * C2);
      l_reg *= f;
      if (hi == 0) { al_l[r32] = f; Lx[wid * 32 + r32] = l_reg; }
      SA_LGW();
#pragma unroll
      for (int d_ = 0; d_ < 4; ++d_)
#pragma unroll
          for (int r = 0; r < 16; ++r) o[d_][r] *= al_l[crow(r, hi)]; }
#define SA_OWR(slot) do { char* sp_ = lds + (slot) * 16384 + lane * 16; _Pragma("unroll") for (int d_ = 0; d_ < 4; ++d_) _Pragma("unroll") for (int g = 0; g < 4; ++g) \
        *(f32x4*)(sp_ + (d_ * 4 + g) * 1024) = (f32x4){o[d_][4 * g], o[d_][4 * g + 1], o[d_][4 * g + 2], o[d_][4 * g + 3]}; } while (0)
#define SA_OAD(slot) do { const char* sp_ = lds + (slot) * 16384 + lane * 16; _Pragma("unroll") for (int d_ = 0; d_ < 4; ++d_) _Pragma("unroll") for (int g = 0; g < 4; ++g) { \
        const f32x4 t_ = *(const f32x4*)(sp_ + (d_ * 4 + g) * 1024); o[d_][4 * g] += t_[0]; o[d_][4 * g + 1] += t_[1]; o[d_][4 * g + 2] += t_[2]; o[d_][4 * g + 3] += t_[3]; } } while (0)
    if (wid >= 4) SA_OWR(wid - 4);
    __syncthreads();
    if (wid < 4) SA_OAD(wid);
    __syncthreads();
    if (wid == 2 || wid == 3) SA_OWR(wid - 2);
    __syncthreads();
    if (wid < 2) SA_OAD(wid);
    __syncthreads();
    if (wid == 1) SA_OWR(0);
    __syncthreads();
    if (wid == 0) {
        SA_OAD(0);
        int r32 = lane & 31, hi = lane >> 5; asm volatile("" : "+v"(r32), "+v"(hi));
        float lt = Lx[r32];
#pragma unroll
        for (int w2 = 1; w2 < 8; ++w2) lt += Lx[w2 * 32 + r32];
        if (hi == 0) li_l[r32] = lt;
        SA_LGW();
        float rs[16];
#pragma unroll
        for (int r = 0; r < 16; ++r) { const float rl = __builtin_amdgcn_rcpf(li_l[crow(r, hi)]); float s = 0.f;
#pragma unroll
            for (int d0 = 0; d0 < 4; ++d0) { o[d0][r] *= rl; s = fmaf(o[d0][r], o[d0][r], s); }
            s += __shfl_xor(s, 1); s += __shfl_xor(s, 2); s += __shfl_xor(s, 4); s += __shfl_xor(s, 8); s += __shfl_xor(s, 16);
            rs[r] = __builtin_amdgcn_rsqf(s * (1.0f / 128.0f) + 1e-6f); }
        float gw[4];
#pragma unroll
        for (int d0 = 0; d0 < 4; ++d0) gw[d0] = T.gattn[h * 128 + d0 * 32 + r32];
        const bf16* gap = T.GA + (size_t)b * 32 * 1024 + h * 128; bf16* yp = T.Y + (size_t)b * 32 * 2048 + h * 128;
        unsigned short gq[16][4];
#pragma unroll
        for (int r = 0; r < 16; ++r) { const int orow = crow(r, hi);
#pragma unroll
            for (int d0 = 0; d0 < 4; ++d0) gq[r][d0] = *(const unsigned short*)(gap + (size_t)orow * 1024 + d0 * 32 + r32); }
#pragma unroll
        for (int r = 0; r < 16; ++r) { const int orow = crow(r, hi);
#pragma unroll
            for (int d0 = 0; d0 < 4; ++d0) { const float ga = __uint_as_float((unsigned)gq[r][d0] << 16);
                const float v = o[d0][r] * rs[r] * gw[d0] * ga; const float vn = __shfl_xor(v, 1);
                if ((r32 & 1) == 0) *(unsigned*)(yp + (size_t)orow * 2048 + d0 * 32 + r32) = cvtpk(v, vn); } }
    }
    __syncthreads();
#undef SA_ISSUE
#undef SA_WRITE_K
#undef SA_WRITE_V
#undef SA_VMW
#undef SA_LGW
#undef SA_QKT
#undef SA_RESC
#undef SA_TRRD
#undef SA_PV
#undef SA_OWR
#undef SA_OAD
}
}

namespace lru {
using namespace pa;
constexpr int WP = 272;
constexpr int L_WR = 0, L_WI = 128 * WP, L_CW = 2 * 128 * WP, L_CST = L_CW + 5 * 128 * 4, L_XA = L_CST + 4 * 128 * 4, L_XU = L_XA + 2 * 8 * 32 * 4, L_CAR = L_XU + 2 * 8 * 32 * 4, LDS_BYTES = L_CAR + 2 * 128 * 4;
struct LTensors { const bf16* XL; const bf16* GL; bf16* Y; const bf16* WrT; const bf16* WiT; const float* conv_w; const float* conv_b; const float* b_r; const float* b_i; const float* lam; const float* g_lru;
                  const float* state_h; const float* state_conv; float* h_p; float* h_s; };

__device__ __forceinline__ void load_weights(char* lds, const LTensors& T, int n) {
    int tid = threadIdx.x; asm volatile("" : "+v"(tid));
#pragma unroll
    for (int i = 0; i < 4; ++i) { const int ch = tid + 512 * i, row = ch >> 4, c16 = ch & 15;
        *(u32x4*)(lds + L_WR + row * WP + c16 * 16) = *(const u32x4*)((const char*)(T.WrT + (size_t)n * 16384) + row * 256 + c16 * 16);
        *(u32x4*)(lds + L_WI + row * WP + c16 * 16) = *(const u32x4*)((const char*)(T.WiT + (size_t)n * 16384) + row * 256 + c16 * 16); }
    for (int i = tid; i < 5 * 128; i += 512) { const int d = i >> 7, c = i & 127; ((float*)(lds + L_CW))[i] = (d < 4) ? T.conv_w[d * 1024 + n * 128 + c] : T.conv_b[n * 128 + c]; }
    if (tid < 128) { const int c = n * 128 + tid; float* cst = (float*)(lds + L_CST);
        cst[tid] = T.b_r[c]; cst[128 + tid] = T.b_i[c]; const float lam = T.lam[c]; cst[256 + tid] = 8.0f * (fmaxf(-lam, 0.f) + log1pf(expf(-fabsf(lam)))); cst[384 + tid] = T.g_lru[c]; }
    if (tid < 256) ((float*)(lds + L_CAR))[tid] = 0.f;
}
template <bool SAMPLE>
__device__ __forceinline__ void tile_afrags(const char* lds, const bf16* xl, int t0, const float* hist, bf16x8 (&af)[8], int r32, int hi) {
    const float* cw = (const float*)(lds + L_CW);
#pragma unroll
    for (int kh = 0; kh < 2; ++kh) {
        bf16x8 raw[4][4];
#pragma unroll
        for (int k4 = 0; k4 < 4; ++k4)
#pragma unroll
            for (int d = 0; d < 4; ++d) { const int tt = r32 - 3 + d; raw[k4][d] = (bf16x8){0, 0, 0, 0, 0, 0, 0, 0};
                if (t0 + tt >= 0) raw[k4][d] = *(const bf16x8*)(xl + (ptrdiff_t)tt * 1024 + (kh * 4 + k4) * 16 + hi * 8); }
#pragma unroll
        for (int k4 = 0; k4 < 4; ++k4) { const int ks = kh * 4 + k4, c8 = ks * 16 + hi * 8;
            f32x4 x0 = *(const f32x4*)(cw + 4 * 128 + c8), x1 = *(const f32x4*)(cw + 4 * 128 + c8 + 4);
#pragma unroll
            for (int d = 0; d < 4; ++d) { const int tt = r32 - 3 + d; const bf16x8 rw = raw[k4][d];
                f32x4 v0 = (f32x4){__uint_as_float((unsigned)(unsigned short)rw[0] << 16), __uint_as_float((unsigned)(unsigned short)rw[1] << 16), __uint_as_float((unsigned)(unsigned short)rw[2] << 16), __uint_as_float((unsigned)(unsigned short)rw[3] << 16)};
                f32x4 v1 = (f32x4){__uint_as_float((unsigned)(unsigned short)rw[4] << 16), __uint_as_float((unsigned)(unsigned short)rw[5] << 16), __uint_as_float((unsigned)(unsigned short)rw[6] << 16), __uint_as_float((unsigned)(unsigned short)rw[7] << 16)};
                if (SAMPLE) { if (t0 + tt < 0) { const float* hp = hist + (size_t)(tt + 3) * 1024 + c8; v0 = *(const f32x4*)hp; v1 = *(const f32x4*)(hp + 4); } }
                const f32x4 w0 = *(const f32x4*)(cw + d * 128 + c8), w1 = *(const f32x4*)(cw + d * 128 + c8 + 4);
                x0 += w0 * v0; x1 += w1 * v1; }
            af[ks] = pack8(x0, x1); }
        asm volatile("" ::: "memory"); }
}
__device__ __forceinline__ void cb_maps(const char* lds, const bf16x8 (&af)[8], int cb, bool first0, f32x16& PA, f32x16& PU, float& tA, float& tU, int r32, int hi) {
    f32x16 ar = {}, ai = {}, ax = {};
    const char* wp = lds + (cb * 32 + r32) * WP + hi * 16;
#pragma unroll
    for (int ks = 0; ks < 8; ++ks) {
        const bf16x8 br = *(const bf16x8*)(wp + L_WR + ks * 32), bi = *(const bf16x8*)(wp + L_WI + ks * 32);
        ar = __builtin_amdgcn_mfma_f32_32x32x16_bf16(af[ks], br, ar, 0, 0, 0);
        ai = __builtin_amdgcn_mfma_f32_32x32x16_bf16(af[ks], bi, ai, 0, 0, 0);
        if ((ks & 1) == 1) asm volatile("" ::: "memory"); }
    {
        const int j = r32 & 7; const unsigned one = (j & 1) ? 0x3F800000u : 0x00003F80u; const bool hm = (hi == ((r32 >> 3) & 1));
        const bool c0 = hm && ((r32 >> 4) == 0), c1 = hm && ((r32 >> 4) == 1);
        u32x4 f0, f1;
        f0.x = (c0 && (j >> 1) == 0) ? one : 0u; f0.y = (c0 && (j >> 1) == 1) ? one : 0u; f0.z = (c0 && (j >> 1) == 2) ? one : 0u; f0.w = (c0 && (j >> 1) == 3) ? one : 0u;
        f1.x = (c1 && (j >> 1) == 0) ? one : 0u; f1.y = (c1 && (j >> 1) == 1) ? one : 0u; f1.z = (c1 && (j >> 1) == 2) ? one : 0u; f1.w = (c1 && (j >> 1) == 3) ? one : 0u;
        ax = __builtin_amdgcn_mfma_f32_32x32x16_bf16(af[2 * cb], *reinterpret_cast<bf16x8*>(&f0), ax, 0, 0, 0);
        ax = __builtin_amdgcn_mfma_f32_32x32x16_bf16(af[2 * cb + 1], *reinterpret_cast<bf16x8*>(&f1), ax, 0, 0, 0); }
    const float* cst = (const float*)(lds + L_CST) + cb * 32 + r32;
    const float cbr = cst[0], cbi = cst[128], csp = cst[256];
    const bool first = first0 && (hi == 0);
#pragma unroll
    for (int r = 0; r < 16; ++r) {
        const float rg = __builtin_amdgcn_rcpf(1.0f + __builtin_amdgcn_exp2f(-1.4426950408889634f * (ar[r] + cbr)));
        const float ig = __builtin_amdgcn_rcpf(1.0f + __builtin_amdgcn_exp2f(-1.4426950408889634f * (ai[r] + cbi)));
        const float av = __builtin_amdgcn_exp2f(-1.4426950408889634f * csp * rg);
        float mult = __builtin_amdgcn_sqrtf(fmaxf(fmaf(-av, av, 1.0f), 0.f));
        if (r == 0 && first) mult = 1.0f;
        ar[r] = av; ai[r] = mult * ig * ax[r]; }
    float Ag[4], Ug[4];
#pragma unroll
    for (int gl = 0; gl < 4; ++gl) { const int r0 = 4 * gl;
        float pa = ar[r0], pu = ai[r0];
#pragma unroll
        for (int k = 1; k < 4; ++k) { pu = fmaf(ar[r0 + k], pu, ai[r0 + k]); pa = ar[r0 + k] * pa; ar[r0 + k] = pa; ai[r0 + k] = pu; }
        Ag[gl] = pa; Ug[gl] = pu; }
    float GA = 1.0f, GU = 0.f;
#pragma unroll
    for (int gl = 0; gl < 4; ++gl) { const int r0 = 4 * gl;
        const float oA = __shfl_xor(Ag[gl], 32), oU = __shfl_xor(Ug[gl], 32);
        const float sA0 = hi ? oA : Ag[gl], sU0 = hi ? oU : Ug[gl], sA1 = hi ? Ag[gl] : oA, sU1 = hi ? Ug[gl] : oU;
        const float GA1 = sA0 * GA, GU1 = fmaf(sA0, GU, sU0);
        const float mA = hi ? GA1 : GA, mU = hi ? GU1 : GU;
#pragma unroll
        for (int k = 0; k < 4; ++k) { PU[r0 + k] = fmaf(ar[r0 + k], mU, ai[r0 + k]); PA[r0 + k] = ar[r0 + k] * mA; }
        GA = sA1 * GA1; GU = fmaf(sA1, GU1, sU1); }
    tA = GA; tU = GU;
}
__device__ __forceinline__ void tile_out(const char* lds, f32x16 (&H)[4], const bf16* gl, bf16* y, int r32, int hi) {
    const float* cst = (const float*)(lds + L_CST) + 384 + r32;
    const float cg0 = cst[0], cg1 = cst[32], cg2 = cst[64], cg3 = cst[96];
#pragma unroll
    for (int rh = 0; rh < 2; ++rh) {
        unsigned short gq[8][4];
#pragma unroll
        for (int r8 = 0; r8 < 8; ++r8) { const int tt = crow(rh * 8 + r8, hi);
#pragma unroll
            for (int cb = 0; cb < 4; ++cb) gq[r8][cb] = *(const unsigned short*)(gl + (size_t)tt * 1024 + cb * 32 + r32); }
#pragma unroll
        for (int r8 = 0; r8 < 8; ++r8) { const int r = rh * 8 + r8; float s = 0.f;
#pragma unroll
            for (int cb = 0; cb < 4; ++cb) s = fmaf(H[cb][r], H[cb][r], s);
            s += __shfl_xor(s, 1); s += __shfl_xor(s, 2); s += __shfl_xor(s, 4); s += __shfl_xor(s, 8); s += __shfl_xor(s, 16);
            const float rs = __builtin_amdgcn_rsqf(s * (1.0f / 128.0f) + 1e-6f); const int tt = crow(r, hi);
#pragma unroll
            for (int cb = 0; cb < 4; ++cb) { const float g = __uint_as_float((unsigned)gq[r8][cb] << 16);
                const float v = H[cb][r] * rs * (cb == 0 ? cg0 : (cb == 1 ? cg1 : (cb == 2 ? cg2 : cg3))) * g; const float vn = __shfl_xor(v, 1);
                if ((r32 & 1) == 0) *(unsigned*)(y + (size_t)tt * 2048 + cb * 32 + r32) = cvtpk(v, vn); } }
        asm volatile("" ::: "memory"); }
}
__device__ __forceinline__ void prompt_unit(char* lds, const LTensors& T, int b, int n) {
    const int tid = threadIdx.x, wid = __builtin_amdgcn_readfirstlane(tid >> 6); const int lane0 = tid & 63;
    load_weights(lds, T, n);
    __syncthreads();
    float* XA = (float*)(lds + L_XA); float* XU = (float*)(lds + L_XU); float* CAR = (float*)(lds + L_CAR);
#pragma unroll 1
    for (int ch = 0; ch < 8; ++ch) {
        int lane = lane0; asm volatile("" : "+v"(lane)); const int r32 = lane & 31, hi = lane >> 5;
        const int t0 = ch * 256 + wid * 32; const size_t row = (size_t)b * 2048 + t0;
        bf16x8 af[8];
        tile_afrags<false>(lds, T.XL + row * 1024 + n * 128, t0, nullptr, af, r32, hi);
        f32x16 H[4];
#pragma unroll
        for (int cb = 0; cb < 4; ++cb) { const int par = cb & 1, c = cb * 32 + r32;
            f32x16 PA, PU; float tA, tU;
            cb_maps(lds, af, cb, t0 == 0, PA, PU, tA, tU, r32, hi);
            if (hi == 0) { XA[(par * 8 + wid) * 32 + r32] = tA; XU[(par * 8 + wid) * 32 + r32] = tU; }
            __syncthreads();
            float hin = CAR[(ch & 1) * 128 + c];
            for (int w2 = 0; w2 < wid; ++w2) hin = fmaf(XA[(par * 8 + w2) * 32 + r32], hin, XU[(par * 8 + w2) * 32 + r32]);
#pragma unroll
            for (int r = 0; r < 16; ++r) H[cb][r] = fmaf(PA[r], hin, PU[r]);
            if (wid == 7 && hi == 1) { CAR[((ch + 1) & 1) * 128 + c] = H[cb][15]; if (ch == 7) T.h_p[(size_t)b * 1024 + n * 128 + c] = H[cb][15]; } }
        { int r32v = r32, hiv = hi; asm volatile("" : "+v"(r32v), "+v"(hiv)); tile_out(lds, H, T.GL + row * 1024 + n * 128, T.Y + row * 2048 + 1024 + n * 128, r32v, hiv); }
    }
    __syncthreads();
}
__device__ __forceinline__ void sample_unit(char* lds, const LTensors& T, int n) {
    const int tid = threadIdx.x, wid = __builtin_amdgcn_readfirstlane(tid >> 6); const int lane0 = tid & 63;
    load_weights(lds, T, n);
    __syncthreads();
#pragma unroll 1
    for (int bi = 0; bi < 4; ++bi) { const int b = wid + 8 * bi;
        int lane = lane0; asm volatile("" : "+v"(lane)); const int r32 = lane & 31, hi = lane >> 5; const size_t row = 32768 + (size_t)b * 32;
        bf16x8 af[8];
        tile_afrags<true>(lds, T.XL + row * 1024 + n * 128, 0, T.state_conv + (size_t)b * 3 * 1024 + n * 128, af, r32, hi);
        f32x16 H[4];
#pragma unroll
        for (int cb = 0; cb < 4; ++cb) { const int c = n * 128 + cb * 32 + r32;
            f32x16 PA, PU; float tA, tU;
            cb_maps(lds, af, cb, false, PA, PU, tA, tU, r32, hi);
            const float hin = T.state_h[(size_t)b * 1024 + c];
#pragma unroll
            for (int r = 0; r < 16; ++r) H[cb][r] = fmaf(PA[r], hin, PU[r]);
            if (hi == 1) T.h_s[(size_t)b * 1024 + c] = H[cb][15]; }
        { int r32v = r32, hiv = hi; asm volatile("" : "+v"(r32v), "+v"(hiv)); tile_out(lds, H, T.GL + row * 1024 + n * 128, T.Y + row * 2048 + 1024 + n * 128, r32v, hiv); }
    }
    __syncthreads();
}
}

constexpr int NWAVES = 8;
constexpr int N_LAUNCHES = MK_N_LAUNCHES;
constexpr int PER_PHASE = 5;
constexpr int DM = 2048, SEQ = 2048, NB = 16, DB = 32, DS = 32, PAST = 4096, NH = 8, HD = 128, DA = 1024, DL = 1024;
constexpr int MP = NB * SEQ, MS = DB * DS, M = MP + MS;
constexpr int D_IN = 6152, NIN = 6144;
constexpr float LN_EPS = 1e-5f, ALPHA = 1.189207115002721f;
constexpr size_t O_YP = 0, O_YS = O_YP + (size_t)MP * DM, O_KP = O_YS + (size_t)MS * DM, O_VP = O_KP + (size_t)MP * DA, O_FP = O_VP + (size_t)MP * DA,
                 O_HP = O_FP + (size_t)MP * NH, O_CP = O_HP + (size_t)NB * DL, O_KS = O_CP + (size_t)NB * 3 * DL, O_VS = O_KS + (size_t)MS * DA, O_FS = O_VS + (size_t)MS * DA,
                 O_HS = O_FS + (size_t)MS * NH, O_CS = O_HS + (size_t)DB * DL, O_END = O_CS + (size_t)DB * 3 * DL;
static_assert(O_END == 138878976, "d_out size");
constexpr size_t MiB = 1u << 20;
constexpr size_t WS_CTL = 0, CTL_ZERO_BYTES = 1 * MiB;
constexpr size_t WS_WIN = 2 * MiB;
constexpr size_t WS_WOUT = 26 * MiB;
constexpr size_t WS_WR = 34 * MiB, WS_WI = 34 * MiB + 512 * 1024;
constexpr size_t WS_BIAS = 35 * MiB;
constexpr size_t WS_XB = 40 * MiB;
constexpr size_t ACT_BYTES = (size_t)M * 1024 * 2;
constexpr size_t WS_ACT = 172 * MiB;
constexpr size_t WS_YC = WS_ACT + 6 * ACT_BYTES;
constexpr size_t WS_END = WS_YC + (size_t)M * 2048 * 2;
static_assert(ACT_BYTES == 66 * MiB && WS_XB + (size_t)M * 2048 * 2 <= WS_ACT, "ws map");
constexpr int CW_TMO = 0, CW_CODE = 1, CW_BAR = 4096, CW_QUEUE = 8192;
constexpr int PH_BYTES = 153600;
constexpr int LDSCTL_OFF = PH_BYTES, MISC_OFF = LDSCTL_OFF + 320, LDS_BYTES = 155648;
static_assert(MISC_OFF + 128 <= LDS_BYTES && sa::LDS_BYTES <= PH_BYTES && lru::LDS_BYTES <= PH_BYTES && pa::LDS_BYTES <= PH_BYTES && pg8::STAGE_BYTES <= PH_BYTES, "LDS map");

#define GAS __attribute__((address_space(1)))
#define LAS __attribute__((address_space(3)))
typedef unsigned short bf16;
typedef unsigned v4u __attribute__((ext_vector_type(4)));
typedef float f32x4 __attribute__((ext_vector_type(4)));
typedef GAS unsigned gu32;
#define RLX_AGENT __ATOMIC_RELAXED, __HIP_MEMORY_SCOPE_AGENT
#define LDS_WAIT() asm volatile("s_waitcnt lgkmcnt(0)" ::: "memory")
#define VM_WAIT() asm volatile("s_waitcnt vmcnt(0)" ::: "memory")
__device__ __forceinline__ unsigned f2bf(float f) { unsigned u = __builtin_bit_cast(unsigned, f); return (u + 0x7fffu + ((u >> 16) & 1u)) >> 16; }
__device__ __forceinline__ unsigned pk2(float lo, float hi) { return f2bf(lo) | (f2bf(hi) << 16); }

#define XB_TMO      128
#define XB_XCNT(j)  (256  + 64 * (j))
#define XB_XSUB(j)  (1280 + 64 * (j))
#define XB_XGEN(j)  (2304 + 64 * (j))
#define XB_TOP      3328
#define XB_TOPGEN   3392
#define XCD_BAR_WORDS 3456
#define XB_SPIN_CAP (1u << 18)

__device__ __forceinline__ unsigned xb_ld(unsigned* p)              { return __hip_atomic_load(p, __ATOMIC_RELAXED, __HIP_MEMORY_SCOPE_AGENT); }
__device__ __forceinline__ unsigned xb_add(unsigned* p, unsigned v) { return __hip_atomic_fetch_add(p, v, __ATOMIC_RELAXED, __HIP_MEMORY_SCOPE_AGENT); }
__device__ __forceinline__ unsigned xb_xcc_id() { return (unsigned)__builtin_amdgcn_s_getreg((3 << 11) | 20) & 0xFu; }
#define XB_SPIN(cond, bar) do { unsigned _sp = 0; while (cond) { __builtin_amdgcn_s_sleep(1); \
    if ((++_sp & 255u) == 0u) { if (xb_ld(&(bar)[XB_TMO])) break; if (_sp > XB_SPIN_CAP) { atomicAdd(&(bar)[XB_TMO], 1u); break; } } } } while (0)

struct XcdBarrier {
    unsigned* bar; unsigned x;
    volatile LAS unsigned* st;
};

__device__ __forceinline__ XcdBarrier xcd_barrier_post(unsigned* bar, volatile LAS unsigned* st) {
    XcdBarrier b; b.bar = bar; b.x = xb_xcc_id(); b.st = st;
    if (threadIdx.x == 0) (void)xb_add(&bar[XB_XCNT(b.x)], 1u);
    return b;
}
__device__ __forceinline__ void xcd_barrier_complete(unsigned* bar, unsigned x, unsigned& nloc, unsigned& nx) {
    const unsigned G = gridDim.x * gridDim.y * gridDim.z;
    unsigned sum, cnt, mine, sp = 0u;
    for (;;) {
        sum = 0u; cnt = 0u; mine = 0u;
#pragma unroll
        for (unsigned j = 0; j < 16; ++j) { const unsigned c = xb_ld(&bar[XB_XCNT(j)]); sum += c; cnt += (c > 0u) ? 1u : 0u; mine = (j == x) ? c : mine; }
        if (sum == G) break;
        __builtin_amdgcn_s_sleep(1);
        if ((++sp & 255u) == 0u) { if (xb_ld(&bar[XB_TMO])) break; if (sp > XB_SPIN_CAP) { atomicAdd(&bar[XB_TMO], 1u); break; } }
    }
    nloc = mine > 0u ? mine : 1u; nx = cnt > 0u ? cnt : 1u;
}

__device__ __forceinline__ void xcd_barrier(const XcdBarrier& b) {
    asm volatile("s_waitcnt vmcnt(0)" ::: "memory");
    __syncthreads();
    if (threadIdx.x == 0) {
        unsigned* bar = b.bar;
        __builtin_amdgcn_s_waitcnt(0);
        unsigned nloc = b.st[0], nx = b.st[1];
        if (nloc == 0u) { xcd_barrier_complete(bar, b.x, nloc, nx); b.st[0] = nloc; b.st[1] = nx; }
        const unsigned old = xb_add(&bar[XB_XSUB(b.x)], 1u);
        const unsigned gen = old / nloc;
        if (old + 1u == (gen + 1u) * nloc) {
            __builtin_amdgcn_fence(__ATOMIC_RELEASE, "agent");
            asm volatile("s_waitcnt vmcnt(0)" ::: "memory");
            const unsigned og = xb_add(&bar[XB_TOP], 1u);
            const unsigned tg = og / nx;
            if (og + 1u == (tg + 1u) * nx) xb_add(&bar[XB_TOPGEN], 1u);
            else XB_SPIN(xb_ld(&bar[XB_TOPGEN]) == tg, bar);
            __builtin_amdgcn_fence(__ATOMIC_ACQUIRE, "agent");
            xb_add(&bar[XB_XGEN(b.x)], 1u);
            asm volatile("s_waitcnt vmcnt(0)" ::: "memory");
        } else {
            XB_SPIN(xb_ld(&bar[XB_XGEN(b.x)]) == gen, bar);
            __builtin_amdgcn_fence(__ATOMIC_ACQUIRE, "agent");
            asm volatile("s_waitcnt vmcnt(0)" ::: "memory");
        }
    }
    __syncthreads();
}

__device__ __forceinline__ float wave_sum(float v) {
#pragma unroll
    for (int o = 1; o < 64; o <<= 1) v += __shfl_xor(v, o);
    return v;
}
__device__ __forceinline__ void p0_transpose_item(const float* W, int ldw, int scol, bf16* WT, int K, int drow, int k0, LAS float* scr, int lane) {
#pragma unroll 8
    for (int i = 0; i < 32; ++i) { const int kk = 2 * i + (lane >> 5); scr[kk * 33 + (lane & 31)] = W[(size_t)(k0 + kk) * ldw + scol + (lane & 31)]; }
    LDS_WAIT(); asm volatile("" ::: "memory");
    const int c = lane & 7;
#pragma unroll
    for (int j = 0; j < 4; ++j) { const int n = (lane >> 3) + 8 * j; const LAS float* s = scr + (8 * c) * 33 + n;
        v4u o; o.x = pk2(s[0 * 33], s[1 * 33]); o.y = pk2(s[2 * 33], s[3 * 33]); o.z = pk2(s[4 * 33], s[5 * 33]); o.w = pk2(s[6 * 33], s[7 * 33]);
        *(GAS v4u*)(WT + (size_t)(drow + n) * K + k0 + 8 * c) = o; }
    LDS_WAIT(); asm volatile("" ::: "memory");
}

struct Args { const float* in[21]; float* out; unsigned char* ws; int ph_lo, ph_hi; };

__global__ void __launch_bounds__(NWAVES * 64, 2) fwd_kernel(Args args) {
    extern __shared__ __attribute__((aligned(16))) unsigned char lds[];
    LAS unsigned char* ldsl = (LAS unsigned char*)lds;
    volatile LAS unsigned* MISC = (volatile LAS unsigned*)(ldsl + MISC_OFF);
    const int tid = threadIdx.x, lane = tid & 63, wave = __builtin_amdgcn_readfirstlane(tid >> 6);
    const int G = gridDim.x, bx = blockIdx.x;
    unsigned char* ws = args.ws;
    gu32* ctl = (gu32*)(ws + WS_CTL);
    float* out = args.out;
    const float* x_p = args.in[0]; const float* x_s = args.in[1];
    bf16* WinT = (bf16*)(ws + WS_WIN); bf16* WoutT = (bf16*)(ws + WS_WOUT); bf16* WrT = (bf16*)(ws + WS_WR); bf16* WiT = (bf16*)(ws + WS_WI);
    float* BIAS = (float*)(ws + WS_BIAS); bf16* XB = (bf16*)(ws + WS_XB); bf16* ACT = (bf16*)(ws + WS_ACT); bf16* YC = (bf16*)(ws + WS_YC);
    constexpr size_t ACT_EL = ACT_BYTES / 2;
    bf16* QB = ACT; bf16* KBf = ACT + ACT_EL; bf16* VBf = ACT + 2 * ACT_EL; bf16* GA = ACT + 3 * ACT_EL; bf16* XL = ACT + 4 * ACT_EL; bf16* GL = ACT + 5 * ACT_EL;

    for (int u = tid; u < (LDS_BYTES - LDSCTL_OFF) / 4; u += NWAVES * 64) ((LAS unsigned*)(ldsl + LDSCTL_OFF))[u] = 0u;
    __syncthreads();
    XcdBarrier bar; bar.bar = (unsigned*)(ctl + CW_BAR); bar.x = 0; bar.st = nullptr;
    if (N_LAUNCHES != PER_PHASE) bar = xcd_barrier_post((unsigned*)(ctl + CW_BAR), MISC + 8);
#define GRID_BAR(seam) do { if (N_LAUNCHES == PER_PHASE) { if (tid == 0) __hip_atomic_store(ctl + CW_TMO, 0xBADBA0u | (unsigned)(seam), RLX_AGENT); } else { xcd_barrier(bar); } } while (0)
    const int lo = args.ph_lo, hi_ph = args.ph_hi;
#ifndef ONLY_PHASE
#define ONLY_PHASE -1
#endif
#define IN(k) (lo <= (k) && (k) < hi_ph && (ONLY_PHASE < 0 || ONLY_PHASE == (k)))
#define BOTH(k) (IN(k) && IN((k) + 1))
#ifndef PROBE_REPEAT
#define PROBE_REPEAT -1
#endif
#define REP(k) for (int rep_ = 0; rep_ < ((PROBE_REPEAT == (k)) ? 2 : 1); ++rep_)

    if (IN(0)) {
        REP(0) {
        const int gw = bx * NWAVES + wave, NGW = G * NWAVES;
        const float* w_in = args.in[7]; const float* w_out = args.in[18]; const float* w_r = args.in[11]; const float* w_i = args.in[13]; const float* b_f = args.in[8];
        LAS float* scr = (LAS float*)(ldsl + wave * 16384);
        constexpr int I_IN = 32 * 192, I_OUT = 32 * 64, I_R = 64, NITEMS = I_IN + I_OUT + 2 * I_R;
        for (int it = gw; it < NITEMS; it += NGW) {
            int r = it;
            if (r < I_IN) { const int kb = r / 192, nb = r % 192; p0_transpose_item(w_in, D_IN, 32 * nb + (nb >= 96 ? 8 : 0), WinT, 2048, 32 * nb, 64 * kb, scr, lane); continue; } r -= I_IN;
            if (r < I_OUT) { const int kb = r / 64, nb = r % 64; p0_transpose_item(w_out, 2048, 32 * nb, WoutT, 2048, 32 * nb, 64 * kb, scr, lane); continue; } r -= I_OUT;
            if (r < I_R) { const int n = r >> 3, kb = (r >> 2) & 1, nb = r & 3; p0_transpose_item(w_r + (size_t)n * 16384, 128, 32 * nb, WrT + (size_t)n * 16384, 128, 32 * nb, 64 * kb, scr, lane); continue; } r -= I_R;
            { const int n = r >> 3, kb = (r >> 2) & 1, nb = r & 3; p0_transpose_item(w_i + (size_t)n * 16384, 128, 32 * nb, WiT + (size_t)n * 16384, 128, 32 * nb, 64 * kb, scr, lane); }
        }
        __syncthreads();
        LAS float* wf = (LAS float*)ldsl;
#pragma unroll
        for (int i = 0; i < 4; ++i) { const int k = tid + 512 * i; const f32x4 a = *(const f32x4*)(w_in + (size_t)k * D_IN + 3072), b = *(const f32x4*)(w_in + (size_t)k * D_IN + 3076);
            wf[0 * 2048 + k] = a[0]; wf[1 * 2048 + k] = a[1]; wf[2 * 2048 + k] = a[2]; wf[3 * 2048 + k] = a[3]; wf[4 * 2048 + k] = b[0]; wf[5 * 2048 + k] = b[1]; wf[6 * 2048 + k] = b[2]; wf[7 * 2048 + k] = b[3]; }
        __syncthreads();
        const float bfl = (lane < 8) ? b_f[lane] : 0.f;
        for (int m = gw; m < M; m += NGW) {
            const float* xr = (m < MP) ? x_p + (size_t)m * DM : x_s + (size_t)(m - MP) * DM;
            f32x4 v[8];
#pragma unroll
            for (int j = 0; j < 8; ++j) v[j] = *(const f32x4*)(xr + 4 * lane + 256 * j);
            GAS unsigned long long* o8 = (GAS unsigned long long*)(XB + (size_t)m * DM) + lane;
#pragma unroll
            for (int j = 0; j < 8; ++j) o8[64 * j] = (unsigned long long)pk2(v[j][0], v[j][1]) | ((unsigned long long)pk2(v[j][2], v[j][3]) << 32);
            float acc[8];
#pragma unroll
            for (int h = 0; h < 8; ++h) { float a = 0.f;
#pragma unroll
                for (int j = 0; j < 8; ++j) { const f32x4 w = *(const LAS f32x4*)(wf + h * 2048 + 256 * j + 4 * lane); a = fmaf(v[j][0], w[0], a); a = fmaf(v[j][1], w[1], a); a = fmaf(v[j][2], w[2], a); a = fmaf(v[j][3], w[3], a); }
                acc[h] = wave_sum(a); asm volatile("" ::: "memory"); }
            float z = acc[0];
#pragma unroll
            for (int h = 1; h < 8; ++h) z = (lane == h) ? acc[h] : z;
            if (lane < 8) { z += bfl; const float lf = fminf(z, 0.f) - log1pf(expf(-fabsf(z)));
                float* fo = (m < MP) ? out + O_FP + (size_t)m * NH : out + O_FS + (size_t)(m - MP) * NH; fo[lane] = lf; }
        }
        __syncthreads();
        }
        GRID_BAR(0);
    }

    if (IN(1)) {
        if (bx >= G - 16) {
            const int bh = (bx - (G - 16)) * NWAVES + wave, b = bh >> 3, h = bh & 7;
            const float* lf = out + O_FP + ((size_t)b * SEQ + 32 * lane) * NH + h;
            float v[32];
#pragma unroll
            for (int k = 0; k < 32; ++k) v[k] = lf[k * NH];
#pragma unroll
            for (int k = 1; k < 32; ++k) v[k] += v[k - 1];
            float incl = v[31];
#pragma unroll
            for (int off = 1; off < 64; off <<= 1) { const float t = __shfl_up(incl, off); if (lane >= off) incl += t; }
            const float excl = incl - v[31];
            float* bo = BIAS + (size_t)bh * SEQ + 32 * lane;
#pragma unroll
            for (int k = 0; k < 32; k += 4) *(f32x4*)(bo + k) = (f32x4){-(v[k] + excl) * sa::SQRTD, -(v[k + 1] + excl) * sa::SQRTD, -(v[k + 2] + excl) * sa::SQRTD, -(v[k + 3] + excl) * sa::SQRTD};
        }
        REP(1) {
        pg8::Gemm g{XB, WinT, M, NIN, DM}; pg8::InMain S{G, bx};
        pg8::EpiIn E{ACT, ACT_EL, out + O_KP, out + O_VP, out + O_KS, out + O_VS, out + O_CP, out + O_CS};
        pg8::gemm_phase<pg8::EpiIn, pg8::InMain, true, true>(ldsl, g, S, E);
        }
        GRID_BAR(1);
    }

    if (IN(2)) {
        lru::LTensors LT{(const pa::bf16*)XL, (const pa::bf16*)GL, (pa::bf16*)YC, (const pa::bf16*)WrT, (const pa::bf16*)WiT, args.in[9], args.in[10], args.in[12], args.in[14], args.in[15], args.in[17],
                         args.in[5], args.in[6], out + O_HP, out + O_HS};
        const pa::PTensors PT{(const pa::bf16*)QB, (const pa::bf16*)KBf, (const pa::bf16*)VBf, BIAS, (const pa::bf16*)GA, (pa::bf16*)YC, args.in[16]};
        const sa::STensors ST{(const pa::bf16*)(QB + (size_t)MP * 1024), (const pa::bf16*)(KBf + (size_t)MP * 1024), (const pa::bf16*)(VBf + (size_t)MP * 1024), args.in[2], args.in[3], args.in[4],
                              out + O_FS, (const pa::bf16*)(GA + (size_t)MP * 1024), (pa::bf16*)(YC + (size_t)MP * 2048), args.in[16]};
        constexpr int N_LRU = 136, N_PA = 512, N_SA = 256, N_TAIL = 96, PA_GATED = 416;
        gu32* qdone = ctl + CW_QUEUE + 64 * 15;
#define QUEUE_LOOP(qidx, nitems, BODY) do { gu32* qctr_ = ctl + CW_QUEUE + 64 * (qidx); \
            for (int k_ = 0;; ++k_) { if (tid == 0) MISC[16 + (k_ & 1)] = __hip_atomic_fetch_add(qctr_, 1u, RLX_AGENT); __syncthreads(); \
                const int item = (int)MISC[16 + (k_ & 1)]; if (item >= (nitems)) break; BODY; } __syncthreads(); } while (0)
        if (bx < N_TAIL) {
            pg8::Gemm g{XB, WinT, M, NIN, DM}; pg8::OneUnit S{104 + (bx >> 2), bx & 3};
            pg8::EpiIn E{ACT, ACT_EL, out + O_KP, out + O_VP, out + O_KS, out + O_VS, out + O_CP, out + O_CS};
            pg8::gemm_phase<pg8::EpiIn, pg8::OneUnit, true, true>(ldsl, g, S, E);
            VM_WAIT(); __syncthreads();
            if (tid == 0) { __builtin_amdgcn_fence(__ATOMIC_RELEASE, "agent"); VM_WAIT(); (void)__hip_atomic_fetch_add(qdone, 1u, RLX_AGENT); }
            QUEUE_LOOP(2, N_SA, sa::sample_unit((char*)lds, item >> 3, item & 7, ST));
        }
        QUEUE_LOOP(0, N_LRU, { if (item < 128) lru::prompt_unit((char*)lds, LT, item >> 3, item & 7); else lru::sample_unit((char*)lds, LT, item - 128); });
        QUEUE_LOOP(1, N_PA, {
            if (item >= PA_GATED) {
                if (tid == 0) { unsigned sp = 0; while (__hip_atomic_load(qdone, RLX_AGENT) < (unsigned)N_TAIL) { __builtin_amdgcn_s_sleep(2); if (++sp > (1u << 22)) { __hip_atomic_store(ctl + CW_TMO, 0x51u, RLX_AGENT); break; } }
                    __builtin_amdgcn_fence(__ATOMIC_ACQUIRE, "agent"); VM_WAIT(); }
                __syncthreads(); }
            pa::prompt_item((char*)lds, PT, item); });
        QUEUE_LOOP(2, N_SA, sa::sample_unit((char*)lds, item >> 3, item & 7, ST));
        GRID_BAR(2);
    }

    if (IN(3)) {
        REP(3) {
        pg8::Gemm g{YC, WoutT, MP, DM, DM}; pg8::StaticOrder S; S.init(MP, DM, G, bx);
        pg8::EpiOut E{XB};
        pg8::gemm_phase<pg8::EpiOut, pg8::StaticOrder, true, true>(ldsl, g, S, E);
        }
        GRID_BAR(3);
    }

    if (IN(4)) {
        const float* ln_g = args.in[19]; const float* ln_b = args.in[20];
        if (bx < 32) {
            pg8::Gemm g{YC, WoutT, M, DM, DM}; pg8::OneUnit S{128 + (bx >> 3), bx & 7};
            pg8::EpiOut E{XB};
            pg8::gemm_phase<pg8::EpiOut, pg8::OneUnit, true, true>(ldsl, g, S, E);
        }
        f32x4 gv[8], bv[8];
#pragma unroll
        for (int j = 0; j < 8; ++j) { gv[j] = *(const f32x4*)(ln_g + 4 * lane + 256 * j); bv[j] = *(const f32x4*)(ln_b + 4 * lane + 256 * j); }
#define LN_ROW(m) do { const float* xr = (((m) < MP) ? x_p + (size_t)(m) * DM : x_s + (size_t)((m) - MP) * DM) + 4 * lane; \
            const bf16* orow = XB + (size_t)(m) * DM + 4 * lane; float* yr = out + O_YP + (size_t)(m) * DM + 4 * lane; \
            f32x4 v[8]; float s = 0.f; \
            _Pragma("unroll") for (int j = 0; j < 8; ++j) { const f32x4 xv = *(const f32x4*)(xr + 256 * j); const uint2 ob = *(const uint2*)(orow + 256 * j); \
                const f32x4 ov = {__uint_as_float(ob.x << 16), __uint_as_float(ob.x & 0xffff0000u), __uint_as_float(ob.y << 16), __uint_as_float(ob.y & 0xffff0000u)}; \
                v[j] = xv * ALPHA + ov; s += (v[j][0] + v[j][1]) + (v[j][2] + v[j][3]); } \
            const float mean = wave_sum(s) * (1.f / DM); float s2 = 0.f; \
            _Pragma("unroll") for (int j = 0; j < 8; ++j) { v[j] = v[j] - mean; s2 += (v[j][0] * v[j][0] + v[j][1] * v[j][1]) + (v[j][2] * v[j][2] + v[j][3] * v[j][3]); } \
            const float rstd = 1.f / sqrtf(wave_sum(s2) * (1.f / DM) + LN_EPS); \
            _Pragma("unroll") for (int j = 0; j < 8; ++j) *(f32x4*)(yr + 256 * j) = v[j] * rstd * gv[j] + bv[j]; } while (0)
        QUEUE_LOOP(3, MP / 64, { for (int r8 = 0; r8 < 8; ++r8) { const int m = item * 64 + r8 * 8 + wave; LN_ROW(m); } });
        GRID_BAR(4);
        { const int gw = bx * NWAVES + wave; if (gw < MS) { const int m = MP + gw; LN_ROW(m); } }
#undef LN_ROW
#undef QUEUE_LOOP
    }
#undef IN
#undef BOTH
#undef GRID_BAR
}

extern "C" void kernel_launch(void* const* d_in, const int* in_sizes, int n_in, void* d_out, int out_size, void* d_ws, size_t ws_size, hipStream_t stream) {
    static int grid = 0;
    if (grid == 0) {
        if (n_in != 21 || (size_t)out_size != O_END || ws_size < WS_END) { fprintf(stderr, "kernel_launch: unexpected shapes: n_in %d out %d ws %zu (need >= %zu); nothing launched\n", n_in, out_size, ws_size, (size_t)WS_END); grid = -1; return; }
        int dev = 0, cus = 0, per_cu = 0;
        if (hipGetDevice(&dev) != hipSuccess || hipDeviceGetAttribute(&cus, hipDeviceAttributeMultiprocessorCount, dev) != hipSuccess) { fprintf(stderr, "kernel_launch: device query failed\n"); grid = -1; return; }
        if (hipFuncSetAttribute((const void*)fwd_kernel, hipFuncAttributeMaxDynamicSharedMemorySize, LDS_BYTES) != hipSuccess) { fprintf(stderr, "kernel_launch: hipFuncSetAttribute failed\n"); grid = -1; return; }
        if (hipOccupancyMaxActiveBlocksPerMultiprocessor(&per_cu, (const void*)fwd_kernel, NWAVES * 64, LDS_BYTES) != hipSuccess || per_cu < 1)
            fprintf(stderr, "kernel_launch: note: occupancy query reports %d workgroups per CU\n", per_cu);
        (void)hipGetLastError();
        grid = cus;
        if (grid != 256) { fprintf(stderr, "kernel_launch: built for a 256-CU device (unit orders assume 256 workgroups), found %d; nothing launched\n", cus); grid = -1; return; }
    }
    if (grid < 0) return;
    if (hipMemsetAsync((char*)d_ws + WS_CTL, 0, CTL_ZERO_BYTES, stream) != hipSuccess) { fprintf(stderr, "kernel_launch: memset failed\n"); return; }
    Args a{};
    for (int i = 0; i < 21; ++i) a.in[i] = (const float*)d_in[i];
    a.out = (float*)d_out; a.ws = (unsigned char*)d_ws;
    if (N_LAUNCHES == 1) { a.ph_lo = 0; a.ph_hi = PER_PHASE; hipLaunchKernelGGL(fwd_kernel, dim3(grid), dim3(NWAVES * 64), LDS_BYTES, stream, a); }

    const hipError_t le = hipPeekAtLastError();
    if (le != hipSuccess) fprintf(stderr, "kernel_launch: launch failed: %s\n", hipGetErrorName(le));
}
```

```cpp
#include <hip/hip_runtime.h>
#include <hip/hip_bf16.h>
#include <cstdio>
#include <cstdint>

#ifndef MK_N_LAUNCHES
#define MK_N_LAUNCHES 1
#endif

namespace pg8 {
#define PG8_LAS __attribute__((address_space(3)))
typedef unsigned short bf16_t;
typedef short bf16x8 __attribute__((ext_vector_type(8)));
typedef float f32x4 __attribute__((ext_vector_type(4)));
typedef unsigned u32x4 __attribute__((ext_vector_type(4)));
constexpr int BM = 256, BK = 64, HALF = 128, HTB = HALF * BK * 2  , STAGE_BYTES = 8 * HTB, NXCD = 8, WGM = 8;

__host__ __device__ __forceinline__ int lds_byte(int r, int c) { const int st = (r >> 4) * 2 + (c >> 5), rr = r & 15, cc = c & 31, ob = rr * 64 + cc * 2; return st * 1024 + (ob ^ (((ob >> 9) & 1) << 5)); }
__host__ __device__ __forceinline__ void stage_rc(int b, int& R, int& C) { const int st = b / 1024, sb = b % 1024, swz = sb ^ (((sb >> 9) & 1) << 5); R = (st >> 1) * 16 + swz / 64; C = (st & 1) * 32 + (swz % 64) / 2; }
__host__ __device__ __forceinline__ int perm32(int rho) { const int n = rho >> 4, i = rho & 15; return 8 * (i >> 2) + 4 * n + (i & 3); }

struct Unit { int pm, pn; };
struct Gemm { const bf16_t* A; const bf16_t* Bt; int M, N, K; };

struct StaticOrder {
    int nM, nN, nwg, G, c;
    __host__ __device__ void init(int M, int N, int G_, int c_) { nM = M / BM; nN = N / BM; nwg = nM * nN; G = G_; c = c_; }
    __host__ __device__ bool next(int i, Unit& u) const {
        const long L = (long)i * G + c; if (L >= nwg) return false;
        int wgid = (int)L; { const int q = nwg / NXCD, r = nwg % NXCD, xcd = wgid % NXCD, off = wgid / NXCD; wgid = (xcd < r ? xcd * (q + 1) : r * (q + 1) + (xcd - r) * q) + off; }
        const int nig = WGM * nN, gid = wgid / nig, fm = gid * WGM, gsz = (nM - fm) < WGM ? (nM - fm) : WGM;
        u.pm = fm + ((wgid % nig) % gsz); u.pn = (wgid % nig) / gsz; return true;
    }
    __device__ __forceinline__ void a_ready(const Unit&) const {}
    __device__ __forceinline__ void done(const Unit&) const {}
};

__device__ __forceinline__ unsigned cvt_pk_bf16(float lo, float hi) { unsigned r; asm volatile("v_cvt_pk_bf16_f32 %0, %1, %2" : "=v"(r) : "v"(lo), "v"(hi)); return r; }
__device__ __forceinline__ float silu_f(float v) { return v * __builtin_amdgcn_rcpf(1.0f + __builtin_amdgcn_exp2f(-1.4426950408889634f * v)); }

struct EpiIn {
    static constexpr bool PERM = true, AFTER_DRAIN = false;
    bf16_t* act; size_t act_stride;
    float* kout_p; float* vout_p; float* kout_s; float* vout_s; float* conv_p; float* conv_s;
    __device__ __forceinline__ void operator()(const f32x4 (&acc)[2][2][4][2], const Unit& u, int wr, int wc, int fr, int fq) const {
        const int ty = u.pn >> 2, colt = (u.pn & 3) * BM;
        const int row0 = u.pm * BM + wr * 64 + fr, col0 = colt + wc * 32 + 8 * fq;
        const bool samp = u.pm >= 128; const int rofs = samp ? 32768 : 0;
        bf16_t* base = act + (size_t)ty * act_stride;
        float* fo = (ty == 1) ? (samp ? kout_s : kout_p) : ((ty == 2) ? (samp ? vout_s : vout_p) : nullptr);
        const bool do_silu = (ty == 3) || (ty == 5);
#pragma unroll
        for (int ai = 0; ai < 2; ++ai)
#pragma unroll
            for (int m = 0; m < 4; ++m) { const int row = row0 + ai * HALF + m * 16; bf16_t* rowp = base + (size_t)row * 1024 + col0;
#pragma unroll
                for (int bj = 0; bj < 2; ++bj) { f32x4 v0 = acc[ai][bj][m][0], v1 = acc[ai][bj][m][1];
                    if (fo) { float* fp = fo + (size_t)(row - rofs) * 1024 + col0 + bj * HALF; *(f32x4*)fp = v0; *(f32x4*)(fp + 4) = v1;
#if defined(PROBE_KVSTORE2)
                        { float* fp2 = fp; asm volatile("" : "+v"(fp2) :: "memory"); *(f32x4*)fp2 = v0; *(f32x4*)(fp2 + 4) = v1; }
#endif
                    }
                    if (ty == 4) {
                        const int rl = row - rofs; const int t = samp ? (rl & 31) : (rl & 2047); const int tl = samp ? 29 : 2045;
                        if (t >= tl) { float* cp = (samp ? conv_s + (size_t)((rl >> 5) * 3 + (t - tl)) * 1024 : conv_p + (size_t)((rl >> 11) * 3 + (t - tl)) * 1024) + col0 + bj * HALF;
                            *(f32x4*)cp = v0; *(f32x4*)(cp + 4) = v1; }
                    }
                    if (do_silu) { v0[0] = silu_f(v0[0]); v0[1] = silu_f(v0[1]); v0[2] = silu_f(v0[2]); v0[3] = silu_f(v0[3]); v1[0] = silu_f(v1[0]); v1[1] = silu_f(v1[1]); v1[2] = silu_f(v1[2]); v1[3] = silu_f(v1[3]); }
                    u32x4 w; w.x = cvt_pk_bf16(v0[0], v0[1]); w.y = cvt_pk_bf16(v0[2], v0[3]); w.z = cvt_pk_bf16(v1[0], v1[1]); w.w = cvt_pk_bf16(v1[2], v1[3]);
                    *(u32x4*)(rowp + bj * HALF) = w; } }
    }
};
struct EpiOut {
    static constexpr bool PERM = true, AFTER_DRAIN = false;
    bf16_t* O;
    __device__ __forceinline__ void operator()(const f32x4 (&acc)[2][2][4][2], const Unit& u, int wr, int wc, int fr, int fq) const {
        const int row0 = u.pm * BM + wr * 64 + fr, col0 = u.pn * BM + wc * 32 + 8 * fq;
#pragma unroll
        for (int ai = 0; ai < 2; ++ai)
#pragma unroll
            for (int m = 0; m < 4; ++m) { bf16_t* rowp = O + (size_t)(row0 + ai * HALF + m * 16) * 2048 + col0;
#pragma unroll
                for (int bj = 0; bj < 2; ++bj) { const f32x4 v0 = acc[ai][bj][m][0], v1 = acc[ai][bj][m][1];
                    u32x4 w; w.x = cvt_pk_bf16(v0[0], v0[1]); w.y = cvt_pk_bf16(v0[2], v0[3]); w.z = cvt_pk_bf16(v1[0], v1[1]); w.w = cvt_pk_bf16(v1[2], v1[3]);
                    *(u32x4*)(rowp + bj * HALF) = w; } }
    }
};

__device__ __forceinline__ void map_tiles(int L, int nM, int nN, Unit& u) {
    const int nwg = nM * nN; int wgid = L; { const int q = nwg / NXCD, r = nwg % NXCD, xcd = wgid % NXCD, off = wgid / NXCD; wgid = (xcd < r ? xcd * (q + 1) : r * (q + 1) + (xcd - r) * q) + off; }
    const int nig = WGM * nN, gid = wgid / nig, fm = gid * WGM, gsz = (nM - fm) < WGM ? (nM - fm) : WGM;
    u.pm = fm + ((wgid % nig) % gsz); u.pn = (wgid % nig) / gsz;
}
struct InMain {
    int G, c;
    static constexpr int N1 = 104 * 24, N2 = 24 * 20, N3 = 4 * 24, NTOT = N1 + N2 + N3;
    __device__ __forceinline__ bool next(int i, Unit& u) const {
        const int L = i * G + c; if (L >= NTOT) return false;
        if (L < N1) { map_tiles(L, 104, 24, u); }
        else if (L < N1 + N2) { map_tiles(L - N1, 24, 20, u); u.pm += 104; u.pn += 4; }
        else { map_tiles(L - N1 - N2, 4, 24, u); u.pm += 128; }
        return true;
    }
    __device__ __forceinline__ void a_ready(const Unit&) const {}
    __device__ __forceinline__ void done(const Unit&) const {}
};
struct OneUnit {
    int pm, pn;
    __device__ __forceinline__ bool next(int i, Unit& u) const { if (i > 0) return false; u.pm = pm; u.pn = pn; return true; }
    __device__ __forceinline__ void a_ready(const Unit&) const {}
    __device__ __forceinline__ void done(const Unit&) const {}
};
template <class Epi, class Sched, bool ALIGN_EPI = false, bool SP2 = false>
__device__ __forceinline__ void gemm_phase(PG8_LAS unsigned char* lds, const Gemm g, const Sched& S, const Epi& E) {
    const int tid = threadIdx.x, wid = __builtin_amdgcn_readfirstlane(tid >> 6), lane = tid & 63, wr = wid >> 2, wc = wid & 3, fr = lane & 15, fq = lane >> 4;
    const int K = g.K, nt = K / BK;
    unsigned voffA[2], voffB[2];
#pragma unroll
    for (int i = 0; i < 2; ++i) { int R, C; stage_rc(tid * 16 + i * 8192, R, C); const int Rb = Epi::PERM ? ((R & ~31) + perm32(R & 31)) : R;
        voffA[i] = (unsigned)(R * K + C) * 2u; voffB[i] = (unsigned)(Rb * K + C) * 2u; }
    const size_t kstep = (size_t)(BK * 2);
    const size_t hstep = (size_t)HALF * K * 2;
    const size_t tstep = 2 * hstep;
    const unsigned ldsw = (unsigned)wid * 1024u;
    const int aoff = lds_byte(wr * 64 + fr, fq * 8), boff = lds_byte(wc * 32 + fr, fq * 8);
#define PG8_SA(b, h) (((b) * 2 + (h)) * HTB)
#define PG8_SB(b, h) ((4 + (b) * 2 + (h)) * HTB)
#define PG8_STAGE(bufoff, gbase, voff) do { _Pragma("unroll") for (int _i = 0; _i < 2; ++_i) \
        __builtin_amdgcn_global_load_lds((const unsigned*)((const char*)(gbase) + (voff)[_i]), (PG8_LAS unsigned*)(lds + (bufoff) + ldsw + _i * 8192), 16, 0, 0); } while (0)
#define PG8_LDA(dst, b, h) do { _Pragma("unroll") for (int m = 0; m < 4; ++m) _Pragma("unroll") for (int k = 0; k < 2; ++k) dst[m][k] = *(const PG8_LAS bf16x8*)(lds + PG8_SA(b, h) + aoff + m * 2048 + k * 1024); } while (0)
#define PG8_LDB(dst, b, h) do { _Pragma("unroll") for (int n = 0; n < 2; ++n) _Pragma("unroll") for (int k = 0; k < 2; ++k) dst[n][k] = *(const PG8_LAS bf16x8*)(lds + PG8_SB(b, h) + boff + n * 2048 + k * 1024); } while (0)
#define PG8_MMA(ai, bj, At, Bt) do { __builtin_amdgcn_s_setprio(1); _Pragma("unroll") for (int m = 0; m < 4; ++m) _Pragma("unroll") for (int n = 0; n < 2; ++n) _Pragma("unroll") for (int k = 0; k < 2; ++k) \
        acc[ai][bj][m][n] = __builtin_amdgcn_mfma_f32_16x16x32_bf16(Bt[n][k], At[m][k], acc[ai][bj][m][n], 0, 0, 0); __builtin_amdgcn_s_setprio(0); } while (0)
#define PG8_WAIT_V(n) asm volatile("s_waitcnt vmcnt(" #n ")" ::: "memory")
#define PG8_WAIT_L(n) asm volatile("s_waitcnt lgkmcnt(" #n ")" ::: "memory")
#define PG8_BAR __builtin_amdgcn_s_barrier()
#define PG8_SCHED __builtin_amdgcn_sched_barrier(0)
    Unit cur, nxt; int ui = 0;
    if (!S.next(0, cur)) return;
    f32x4 acc[2][2][4][2];
#pragma unroll
    for (int a = 0; a < 2; ++a)
#pragma unroll
        for (int b = 0; b < 2; ++b)
#pragma unroll
            for (int m = 0; m < 4; ++m)
#pragma unroll
                for (int n = 0; n < 2; ++n) acc[a][b][m][n] = (f32x4){0.f, 0.f, 0.f, 0.f};
    bf16x8 At[4][2], B0[2][2], B1[2][2];
    const char* cA = (const char*)g.A + (size_t)cur.pm * tstep; const char* cB = (const char*)g.Bt + (size_t)cur.pn * tstep;
    S.a_ready(cur);
    if constexpr (SP2) {
        PG8_STAGE(PG8_SB(0, 0), cB, voffB); PG8_STAGE(PG8_SB(0, 1), cB + hstep, voffB); PG8_STAGE(PG8_SA(0, 0), cA, voffA); PG8_STAGE(PG8_SA(0, 1), cA + hstep, voffA);
        if (wr == 1) PG8_BAR;
        PG8_WAIT_V(2); PG8_BAR;
        PG8_STAGE(PG8_SB(1, 0), cB + kstep, voffB); PG8_STAGE(PG8_SA(1, 0), cA + kstep, voffA); PG8_STAGE(PG8_SB(1, 1), cB + hstep + kstep, voffB);
        PG8_WAIT_V(6); PG8_BAR;
    } else {
        PG8_STAGE(PG8_SB(0, 0), cB, voffB); PG8_STAGE(PG8_SA(0, 0), cA, voffA); PG8_STAGE(PG8_SB(0, 1), cB + hstep, voffB); PG8_STAGE(PG8_SA(0, 1), cA + hstep, voffA);
        if (wr == 1) PG8_BAR;
        PG8_WAIT_V(4); PG8_BAR;
        PG8_STAGE(PG8_SB(1, 0), cB + kstep, voffB); PG8_STAGE(PG8_SA(1, 0), cA + kstep, voffA); PG8_STAGE(PG8_SB(1, 1), cB + hstep + kstep, voffB);
        PG8_WAIT_V(6); PG8_BAR;
    }
    for (;;) {
        const bool has_next = S.next(ui + 1, nxt);
        const char* nA = has_next ? (const char*)g.A + (size_t)nxt.pm * tstep : cA; const char* nB = has_next ? (const char*)g.Bt + (size_t)nxt.pn * tstep : cB;
        for (int t = 0; t < nt; t += 2) {
            const bool last = (t == nt - 2);
            const char* a1 = cA + (size_t)(t + 1) * kstep;
            const char* a2 = last ? nA : cA + (size_t)(t + 2) * kstep; const char* b2 = last ? nB : cB + (size_t)(t + 2) * kstep;
            const char* a3 = a2 + kstep; const char* b3 = b2 + kstep;
            if (last && has_next) S.a_ready(nxt);
            if constexpr (SP2) {
            PG8_LDB(B0, 0, 0); PG8_LDB(B1, 0, 1); PG8_SCHED; PG8_LDA(At, 0, 0); PG8_STAGE(PG8_SA(1, 1), a1 + hstep, voffA);
            PG8_WAIT_V(8); PG8_WAIT_L(0); PG8_BAR; PG8_MMA(0, 0, At, B0); PG8_MMA(0, 1, At, B1); PG8_BAR; PG8_SCHED;
            PG8_LDA(At, 0, 1); PG8_STAGE(PG8_SB(0, 0), b2, voffB); PG8_STAGE(PG8_SB(0, 1), b2 + hstep, voffB); PG8_STAGE(PG8_SA(0, 0), a2, voffA);
            PG8_WAIT_V(8); PG8_WAIT_L(0); PG8_BAR; PG8_MMA(1, 0, At, B0); PG8_MMA(1, 1, At, B1); PG8_BAR; PG8_SCHED;
            PG8_LDB(B0, 1, 0); PG8_LDB(B1, 1, 1); PG8_SCHED; PG8_LDA(At, 1, 0); PG8_STAGE(PG8_SA(0, 1), a2 + hstep, voffA);
            PG8_WAIT_V(8); PG8_WAIT_L(0); PG8_BAR; PG8_MMA(0, 0, At, B0); PG8_MMA(0, 1, At, B1); PG8_BAR; PG8_SCHED;
            PG8_LDA(At, 1, 1); PG8_STAGE(PG8_SB(1, 0), b3, voffB); PG8_STAGE(PG8_SB(1, 1), b3 + hstep, voffB); PG8_STAGE(PG8_SA(1, 0), a3, voffA);
            PG8_WAIT_V(8); PG8_WAIT_L(0); PG8_BAR; PG8_MMA(1, 0, At, B0); PG8_MMA(1, 1, At, B1); PG8_BAR; PG8_SCHED;
            } else {
            PG8_LDB(B0, 0, 0); PG8_SCHED; PG8_LDA(At, 0, 0); PG8_STAGE(PG8_SA(1, 1), a1 + hstep, voffA);
            PG8_WAIT_L(8); PG8_BAR; PG8_WAIT_L(0); PG8_MMA(0, 0, At, B0); PG8_BAR; PG8_SCHED;
            PG8_LDB(B1, 0, 1); PG8_STAGE(PG8_SB(0, 0), b2, voffB);
            PG8_BAR; PG8_WAIT_L(0); PG8_MMA(0, 1, At, B1); PG8_BAR;
            PG8_LDA(At, 0, 1); PG8_STAGE(PG8_SA(0, 0), a2, voffA);
            PG8_BAR; PG8_WAIT_L(0); PG8_MMA(1, 0, At, B0); PG8_BAR; PG8_SCHED;
            PG8_STAGE(PG8_SB(0, 1), b2 + hstep, voffB);
            PG8_WAIT_V(6); PG8_BAR; PG8_MMA(1, 1, At, B1); PG8_BAR;
            PG8_LDB(B0, 1, 0); PG8_SCHED; PG8_LDA(At, 1, 0); PG8_STAGE(PG8_SA(0, 1), a2 + hstep, voffA);
            PG8_WAIT_L(8); PG8_BAR; PG8_WAIT_L(0); PG8_MMA(0, 0, At, B0); PG8_BAR; PG8_SCHED;
            PG8_LDB(B1, 1, 1); PG8_STAGE(PG8_SB(1, 0), b3, voffB);
            PG8_BAR; PG8_WAIT_L(0); PG8_MMA(0, 1, At, B1); PG8_BAR;
            PG8_LDA(At, 1, 1); PG8_STAGE(PG8_SA(1, 0), a3, voffA);
            PG8_BAR; PG8_WAIT_L(0); PG8_MMA(1, 0, At, B0); PG8_BAR; PG8_SCHED;
            PG8_STAGE(PG8_SB(1, 1), b3 + hstep, voffB);
            PG8_WAIT_V(6); PG8_BAR; PG8_MMA(1, 1, At, B1); PG8_BAR;
            }
        }
        if constexpr (ALIGN_EPI) { if (wr == 0) PG8_BAR; }
        if constexpr (!Epi::AFTER_DRAIN) { E(acc, cur, wr, wc, fr, fq); S.done(cur); }
        if (!has_next) break;
#pragma unroll
        for (int a = 0; a < 2; ++a)
#pragma unroll
            for (int b = 0; b < 2; ++b)
#pragma unroll
                for (int m = 0; m < 4; ++m)
#pragma unroll
                    for (int n = 0; n < 2; ++n) acc[a][b][m][n] = (f32x4){0.f, 0.f, 0.f, 0.f};
        cur = nxt; cA = nA; cB = nB; ++ui;
        if constexpr (ALIGN_EPI) { if (wr == 1) PG8_BAR; }
    }
    PG8_WAIT_V(0);
    if constexpr (!ALIGN_EPI) { if (wr == 0) PG8_BAR; }
    PG8_BAR;
    if constexpr (Epi::AFTER_DRAIN) { E.fused(acc, cur, wr, wc, fr, fq, lds, wid, lane); S.done(cur); }
#undef PG8_SA
#undef PG8_SB
#undef PG8_STAGE
#undef PG8_LDA
#undef PG8_LDB
#undef PG8_MMA
#undef PG8_WAIT_V
#undef PG8_WAIT_L
#undef PG8_BAR
#undef PG8_SCHED
}
}

namespace pa {
using bf16 = __hip_bfloat16;
typedef short bf16x8 __attribute__((ext_vector_type(8)));
typedef short s16x4 __attribute__((ext_vector_type(4)));
typedef float f32x16 __attribute__((ext_vector_type(16)));
typedef float f32x4 __attribute__((ext_vector_type(4)));
typedef unsigned u32x4 __attribute__((ext_vector_type(4)));
template <class A, class Bt> struct same_t { static constexpr bool v = false; };
template <class A> struct same_t<A, A> { static constexpr bool v = true; };
constexpr int D = 128, LDR = 1024, LDY = 2048;
constexpr float SCALE = 0.08838834764831845f;
constexpr float THR = 8.f;
constexpr int NW = 8, QBLK = 32, KVBLK = 64, QB = NW * QBLK;
constexpr int SHM_V = KVBLK * D * 2, SHM_K = KVBLK * D * 2;
constexpr int LDS_WS = 2 * SHM_V + 2 * SHM_K, LDS_BIAS = LDS_WS + NW * 64 * 4, LDS_BYTES = LDS_BIAS + 2 * 2048 * 4;
enum { ORDER_NATURAL = 0, ORDER_REVERSED = 1, ORDER_PAIRED = 2, ORDER_XCD = 4 };
#define KSWZ(row, colB) ((row) * 256 + ((colB) ^ (((row) & 7) << 4)))
#define SBAR() __builtin_amdgcn_sched_barrier(0)
__device__ __forceinline__ int v_st(int k, int c) { const int kk = (k & ~0xC) | ((k & 4) << 1) | ((k & 8) >> 1); return ((kk >> 3) * 4 + (c >> 5)) * 512 + ((kk & 7) * 32 + (c & 31)) * 2; }
__device__ __forceinline__ int v_rd_base(int lane) { return ((lane & 3) << 3) | (((lane >> 2) & 3) << 6) | (((lane >> 4) & 1) << 5) | (((lane >> 5) & 1) << 8); }
constexpr int v_rd_off(int d0, int ks, int half) { return d0 * 512 + ks * 4096 + half * 2048; }
__device__ __forceinline__ int crow(int r, int hi) { return (r & 3) + 8 * (r >> 2) + 4 * hi; }
__device__ __forceinline__ unsigned cvtpk(float lo, float hi) {
    unsigned r; asm volatile("v_cvt_pk_bf16_f32 %0, %1, %2" : "=v"(r) : "v"(lo), "v"(hi)); return r;
}
__device__ __forceinline__ bf16x8 pack8(f32x4 a, f32x4 b) {
    u32x4 w = {cvtpk(a[0], a[1]), cvtpk(a[2], a[3]), cvtpk(b[0], b[1]), cvtpk(b[2], b[3])};
    return *reinterpret_cast<bf16x8*>(&w);
}
template <class T> __device__ __forceinline__ bf16x8 load8(const T* p) {
    if constexpr (same_t<T, float>::v) { return pack8(*(const f32x4*)p, *(const f32x4*)(p + 4)); }
    else { return *reinterpret_cast<const bf16x8*>(p); }
}
__device__ __forceinline__ void mask_tile(f32x16& p0, f32x16& p1, int dq, unsigned W) {
    const float NEG = -__builtin_inff();
#pragma unroll
    for (int r = 0; r < 16; ++r) {
        const int c = (r & 3) + 8 * (r >> 2);
        if ((unsigned)(dq - c) >= W) p0[r] = NEG;
        if ((unsigned)(dq - c - 32) >= W) p1[r] = NEG;
    }
}
__device__ __forceinline__ void partialSM(f32x16& p0, f32x16& p1, float& m_reg, float& mn, float& alpha) {
    float pmax = p0[0]; for (int r = 1; r < 16; ++r) pmax = fmaxf(pmax, p0[r]); for (int r = 0; r < 16; ++r) pmax = fmaxf(pmax, p1[r]);
    { auto rr = __builtin_amdgcn_permlane32_swap(__float_as_uint(pmax), __float_as_uint(pmax), false, false);
      pmax = fmaxf(__uint_as_float(rr[0]), __uint_as_float(rr[1])); }
    constexpr float C2 = 1.4426950408889634f * SCALE;
    if (__builtin_expect(__all((pmax - m_reg) * SCALE <= THR), 1)) { mn = m_reg; alpha = 1.f; }
    else { mn = fmaxf(m_reg, pmax); alpha = __builtin_amdgcn_exp2f((m_reg - mn) * C2); m_reg = mn; }
    const float mnL = -mn * C2;
    for (int r = 0; r < 16; ++r) p0[r] = fmaf(p0[r], C2, mnL); for (int r = 0; r < 16; ++r) p1[r] = fmaf(p1[r], C2, mnL);
    for (int r = 0; r < 16; ++r) p0[r] = __builtin_amdgcn_exp2f(p0[r]);
}
__device__ __forceinline__ void finishSM(f32x16& p0, f32x16& p1, float alpha, float& l_reg, bf16x8& pa0, bf16x8& pa1, bf16x8& pa2, bf16x8& pa3) {
    for (int r = 0; r < 16; ++r) p1[r] = __builtin_amdgcn_exp2f(p1[r]);
    float ps = 0; for (int r = 0; r < 16; ++r) ps += p0[r]; for (int r = 0; r < 16; ++r) ps += p1[r];
    { auto rr = __builtin_amdgcn_permlane32_swap(__float_as_uint(ps), __float_as_uint(ps), false, false);
      ps = __uint_as_float(rr[0]) + __uint_as_float(rr[1]); }
    l_reg = l_reg * alpha + ps;
#define PK4(P, B_, OUT) do { unsigned a0 = cvtpk(P[B_+0], P[B_+1]), a1 = cvtpk(P[B_+2], P[B_+3]);                          \
        unsigned b0 = cvtpk(P[B_+4], P[B_+5]), b1 = cvtpk(P[B_+6], P[B_+7]);                                             \
        auto r0 = __builtin_amdgcn_permlane32_swap(a0, b0, false, false); auto r1 = __builtin_amdgcn_permlane32_swap(a1, b1, false, false); \
        u32x4 w = {r0[0], r1[0], r0[1], r1[1]}; OUT = *reinterpret_cast<bf16x8*>(&w); } while (0)
    PK4(p0, 0, pa0); PK4(p0, 8, pa1); PK4(p1, 0, pa2); PK4(p1, 8, pa3);
#undef PK4
}
template <int KB>
__device__ __forceinline__ void qkt(f32x16& p0, f32x16& p1, const char* K_lds, const char* bias_t, int r32, int hi, const bf16x8* qr) {
    { const f32x4 b0 = *(const f32x4*)(bias_t), b1 = *(const f32x4*)(bias_t + 32), b2 = *(const f32x4*)(bias_t + 64), b3 = *(const f32x4*)(bias_t + 96);
      const f32x4 c0 = *(const f32x4*)(bias_t + 128), c1 = *(const f32x4*)(bias_t + 160), c2 = *(const f32x4*)(bias_t + 192), c3 = *(const f32x4*)(bias_t + 224);
      p0 = (f32x16){b0[0], b0[1], b0[2], b0[3], b1[0], b1[1], b1[2], b1[3], b2[0], b2[1], b2[2], b2[3], b3[0], b3[1], b3[2], b3[3]};
      p1 = (f32x16){c0[0], c0[1], c0[2], c0[3], c1[0], c1[1], c1[2], c1[3], c2[0], c2[1], c2[2], c2[3], c3[0], c3[1], c3[2], c3[3]}; }
    const char* kb[4];
#pragma unroll
    for (int dd = 0; dd < 4; ++dd) kb[dd] = K_lds + KB * SHM_K + KSWZ(r32, (dd * 16 + hi * 8) * 2);
#pragma unroll
    for (int d0 = 0; d0 < 8; ++d0) { const char* a = kb[d0 & 3] + (d0 >> 2) * 128;
        bf16x8 b0 = *reinterpret_cast<const bf16x8*>(a);
        bf16x8 b1 = *reinterpret_cast<const bf16x8*>(a + 32 * 256);
        p0 = __builtin_amdgcn_mfma_f32_32x32x16_bf16(b0, qr[d0], p0, 0, 0, 0);
        p1 = __builtin_amdgcn_mfma_f32_32x32x16_bf16(b1, qr[d0], p1, 0, 0, 0); }
}
template <int VB>
__device__ __forceinline__ void pv_tile(f32x16* o, int vb0, bf16x8 pa0, bf16x8 pa1, bf16x8 pa2, bf16x8 pa3) {
#define TRRD(dst, off) asm volatile("ds_read_b64_tr_b16 %0, %1 offset:%2" : "=&v"(dst) : "v"(vb0), "i"(off) : "memory")
#define PV_D0(d0) do { s16x4 l0, l1, l2, l3, h0, h1, h2, h3; constexpr int b_ = VB * SHM_V + v_rd_off(d0, 0, 0);     \
        TRRD(l0, b_); TRRD(h0, b_ + 2048); TRRD(l1, b_ + 4096); TRRD(h1, b_ + 6144); TRRD(l2, b_ + 8192); TRRD(h2, b_ + 10240); TRRD(l3, b_ + 12288); TRRD(h3, b_ + 14336); \
        asm volatile("s_waitcnt lgkmcnt(0)" ::: "memory"); SBAR();                 \
        o[d0] = __builtin_amdgcn_mfma_f32_32x32x16_bf16(pa0, (bf16x8){l0[0], l0[1], l0[2], l0[3], h0[0], h0[1], h0[2], h0[3]}, o[d0], 0, 0, 0);   \
        o[d0] = __builtin_amdgcn_mfma_f32_32x32x16_bf16(pa1, (bf16x8){l1[0], l1[1], l1[2], l1[3], h1[0], h1[1], h1[2], h1[3]}, o[d0], 0, 0, 0);   \
        o[d0] = __builtin_amdgcn_mfma_f32_32x32x16_bf16(pa2, (bf16x8){l2[0], l2[1], l2[2], l2[3], h2[0], h2[1], h2[2], h2[3]}, o[d0], 0, 0, 0);   \
        o[d0] = __builtin_amdgcn_mfma_f32_32x32x16_bf16(pa3, (bf16x8){l3[0], l3[1], l3[2], l3[3], h3[0], h3[1], h3[2], h3[3]}, o[d0], 0, 0, 0); } while (0)
    PV_D0(0); PV_D0(1); PV_D0(2); PV_D0(3);
#undef PV_D0
#undef TRRD
}

struct BlockRef { const bf16* Q; const bf16* K; const bf16* V; const float* Bias; const bf16* GA; bf16* Y; const float* gattn; int P0; };
struct Seam { bf16x8 qr[8]; bf16x8 st_v0, st_v1, st_k0, st_k1; };
#define ROW(p, k0, rr) ((p) + (size_t)((k0) + (rr)) * LDR + sc)
#define VMW() asm volatile("s_waitcnt vmcnt(0)" ::: "memory")
#define VMWN(n) asm volatile("s_waitcnt vmcnt(%0)" :: "i"(n) : "memory")
#define SLOAD_H(Kp, Vp, k0) do { S.st_v0 = load8<bf16>(ROW(Vp, k0, sr)); S.st_v1 = load8<bf16>(ROW(Vp, k0, 32 + sr));              \
                         S.st_k0 = load8<bf16>(ROW(Kp, k0, sr)); S.st_k1 = load8<bf16>(ROW(Kp, k0, 32 + sr)); } while (0)
#define SWRITE_HK(bf) do { *(bf16x8*)(K_lds + (bf) * SHM_K + kws) = S.st_k0; *(bf16x8*)(K_lds + (bf) * SHM_K + kws + 32 * 256) = S.st_k1; } while (0)
#define SWRITE_HV(bf) do { *(bf16x8*)(V_lds + (bf) * SHM_V + vst0) = S.st_v0; *(bf16x8*)(V_lds + (bf) * SHM_V + vst1) = S.st_v1; } while (0)
#define SWRITE_H(bf) do { SWRITE_HV(bf); SWRITE_HK(bf); } while (0)
__device__ __forceinline__ void causal_prime(const BlockRef& cur, char* lds, Seam& S) {
    const int tid = threadIdx.x, wid = __builtin_amdgcn_readfirstlane(tid >> 6), lane = tid & 63, r32 = lane & 31, hi = lane >> 5;
    const int sr = tid >> 4, sc = (tid & 15) * 8, kws = KSWZ(sr, sc * 2); char* K_lds = lds + 2 * SHM_V;
#pragma unroll
    for (int d0 = 0; d0 < 8; ++d0) S.qr[d0] = load8<bf16>(cur.Q + (size_t)(wid * QBLK + r32) * LDR + d0 * 16 + hi * 8);
    SLOAD_H(cur.K, cur.V, 0);
    if (tid * 4 < cur.P0 + QB) *(f32x4*)(lds + LDS_BIAS + tid * 16) = *(const f32x4*)(cur.Bias + tid * 4);
    VMW(); SWRITE_HK(0);
    __syncthreads();
}
__device__ __forceinline__ void causal_block(const BlockRef& cur, const BlockRef& nxt, char* lds, Seam& S, int par  ) {
    int tid = threadIdx.x; asm volatile("" : "+v"(tid));
    const int wid = __builtin_amdgcn_readfirstlane(tid >> 6), lane = tid & 63, r32 = lane & 31, hi = lane >> 5;
    const int NT = (cur.P0 + QB) / KVBLK;
    const int qlo = cur.P0 + wid * QBLK, qm = qlo + r32 - 4 * hi;
    char* V_lds = lds; char* K_lds = lds + 2 * SHM_V;
    const char* bias_l = lds + LDS_BIAS + par * 8192 + hi * 16;
    float* ws = (float*)(lds + LDS_WS) + wid * 64; float* li_l = ws, * al_l = ws + 32;
    float m_reg = -1e30f, l_reg = 0; f32x16 o[4] = {};
    const int sr = tid >> 4, sc = (tid & 15) * 8, vst0 = v_st(sr, sc), vst1 = v_st(32 + sr, sc), kws = KSWZ(sr, sc * 2);
    const int vb0 = (int)(uintptr_t)V_lds + v_rd_base(lane);
    const bf16* Kh = cur.K; const bf16* Vh = cur.V;
#define RESC(a) do { if (__any((a) < 1.f)) { if (hi == 0) al_l[r32] = (a); asm volatile("s_waitcnt lgkmcnt(0)" ::: "memory");              \
                     for (int d_ = 0; d_ < 4; ++d_) for (int r = 0; r < 16; ++r) o[d_][r] *= al_l[crow(r, hi)]; } } while (0)
#define KBASE(t) ((t) * KVBLK)
#define MASKT(P0_, P1_, t) do { const int kb_ = KBASE(t); if (kb_ + KVBLK - 1 > qlo) mask_tile(P0_, P1_, qm - kb_, 0x40000000u); } while (0)
#define SEAM_K0() do { VMWN(8); SWRITE_HK(0); SBAR(); } while (0)
    f32x16 pA0, pA1, pB0, pB1; float mnA, mnB, alA, alB; bf16x8 pa0, pa1, pa2, pa3;
    SWRITE_HV(0); SBAR();
    if (NT > 1) SLOAD_H(Kh, Vh, KBASE(1));
    SBAR(); qkt<0>(pA0, pA1, K_lds, bias_l + KBASE(0) * 4, r32, hi, S.qr);
    MASKT(pA0, pA1, 0); partialSM(pA0, pA1, m_reg, mnA, alA);
    if (NT > 1) { VMW(); SWRITE_H(1); }
    __syncthreads();
#define HALF_STEP(PX0, PX1, mnX, alX, PY0, PY1, alY, t, KB, VB, SB) do {                                                      \
        SBAR(); qkt<KB>(PX0, PX1, K_lds, bias_l + KBASE(t) * 4, r32, hi, S.qr);                                               \
        finishSM(PY0, PY1, alY, l_reg, pa0, pa1, pa2, pa3); SBAR();                                                           \
        if ((t) + 1 < NT) { SLOAD_H(Kh, Vh, KBASE((t) + 1)); SBAR(); }                                                        \
        pv_tile<VB>(o, vb0, pa0, pa1, pa2, pa3); MASKT(PX0, PX1, (t)); partialSM(PX0, PX1, m_reg, mnX, alX);                  \
        __syncthreads();                                                                                                      \
        if ((t) + 1 < NT) { VMW(); SWRITE_H(SB); }                                                                            \
        RESC(alX); __syncthreads(); } while (0)
    for (int t = 1; t + 1 < NT; t += 2) {
        HALF_STEP(pB0, pB1, mnB, alB, pA0, pA1, alA, t, 1, 0, 0);
        HALF_STEP(pA0, pA1, mnA, alA, pB0, pB1, alB, t + 1, 0, 1, 1);
    }
    const bool even = (NT & 1) == 0;
    if (even) { SBAR(); qkt<1>(pB0, pB1, K_lds, bias_l + KBASE(NT - 1) * 4, r32, hi, S.qr); SBAR(); }
    __builtin_amdgcn_global_load_lds((const __attribute__((address_space(1))) unsigned*)(nxt.Bias + tid * 4), (__attribute__((address_space(3))) unsigned*)(lds + LDS_BIAS + (par ^ 1) * 8192 + wid * 1024), 16, 0, 0);
    SBAR();
    SLOAD_H(nxt.K, nxt.V, 0); SBAR();
#pragma unroll
    for (int d0 = 0; d0 < 8; ++d0) S.qr[d0] = load8<bf16>(nxt.Q + (size_t)(wid * QBLK + r32) * LDR + d0 * 16 + hi * 8);
    SBAR();
    finishSM(pA0, pA1, alA, l_reg, pa0, pa1, pa2, pa3); SBAR();
    pv_tile<0>(o, vb0, pa0, pa1, pa2, pa3);
    if (even) { MASKT(pB0, pB1, NT - 1); partialSM(pB0, pB1, m_reg, mnB, alB); __syncthreads(); RESC(alB);
        finishSM(pB0, pB1, alB, l_reg, pa0, pa1, pa2, pa3); SBAR(); pv_tile<1>(o, vb0, pa0, pa1, pa2, pa3); }
    SBAR(); SEAM_K0();
    if (hi == 0) li_l[r32] = l_reg; asm volatile("s_waitcnt lgkmcnt(0)" ::: "memory");
    float rs[16];
#pragma unroll
    for (int r = 0; r < 16; ++r) { const float rl = __builtin_amdgcn_rcpf(li_l[crow(r, hi)]); float s = 0.f;
#pragma unroll
        for (int d0 = 0; d0 < 4; ++d0) { o[d0][r] *= rl; s = fmaf(o[d0][r], o[d0][r], s); }
        s += __shfl_xor(s, 1); s += __shfl_xor(s, 2); s += __shfl_xor(s, 4); s += __shfl_xor(s, 8); s += __shfl_xor(s, 16);
        rs[r] = __builtin_amdgcn_rsqf(s * (1.0f / 128.0f) + 1e-6f); }
    float gw[4];
#pragma unroll
    for (int d0 = 0; d0 < 4; ++d0) gw[d0] = cur.gattn[d0 * 32 + r32];
#pragma unroll
    for (int rh = 0; rh < 2; ++rh) {
        unsigned short gq[8][4];
#pragma unroll
        for (int r8 = 0; r8 < 8; ++r8) { const int orow = wid * QBLK + crow(rh * 8 + r8, hi);
#pragma unroll
            for (int d0 = 0; d0 < 4; ++d0) gq[r8][d0] = *(const unsigned short*)(cur.GA + (size_t)orow * LDR + d0 * 32 + r32); }
#pragma unroll
        for (int r8 = 0; r8 < 8; ++r8) { const int r = rh * 8 + r8, orow = wid * QBLK + crow(r, hi);
#pragma unroll
            for (int d0 = 0; d0 < 4; ++d0) { const float ga = __uint_as_float((unsigned)gq[r8][d0] << 16);
                const float v = o[d0][r] * rs[r] * gw[d0] * ga; const float vn = __shfl_xor(v, 1);
                if ((r32 & 1) == 0) *(unsigned*)(cur.Y + (size_t)orow * LDY + d0 * 32 + r32) = cvtpk(v, vn); } }
        asm volatile("" ::: "memory"); }
    __syncthreads();
#undef RESC
#undef KBASE
#undef MASKT
#undef SEAM_K0
#undef HALF_STEP
}
#undef ROW
#undef VMW
#undef VMWN
#undef SLOAD_H
#undef SWRITE_HK
#undef SWRITE_HV
#undef SWRITE_H

struct SwaItem { int bh, qb0, qb1; };
__device__ __forceinline__ SwaItem swa_decode(int L, int nbh, int nqb, int nx) {
    SwaItem it; int x;
    { const int xcd = L & 7, k = L >> 3, gi = k / nx, r = k - gi * nx; it.bh = gi * 8 + xcd; x = r; }
    it.qb0 = x; it.qb1 = nqb - 1 - x;
    return it;
}
struct PTensors { const bf16* Q; const bf16* K; const bf16* V; const float* Bias; const bf16* GA; bf16* Y; const float* gattn; };
__device__ __forceinline__ BlockRef swa_ref(const SwaItem& it, int pass, const PTensors& T) {
    const int qb = pass ? it.qb1 : it.qb0, b = it.bh >> 3, h = it.bh & 7; const size_t row0 = (size_t)b * 2048 + (size_t)qb * QB;
    BlockRef r; r.Q = T.Q + row0 * LDR + h * D; r.K = T.K + (size_t)b * 2048 * LDR + h * D; r.V = T.V + (size_t)b * 2048 * LDR + h * D;
    r.Bias = T.Bias + (size_t)it.bh * 2048; r.GA = T.GA + row0 * LDR + h * D; r.Y = T.Y + row0 * LDY + h * D; r.gattn = T.gattn + h * D; r.P0 = qb * QB;
    return r;
}
__device__ __forceinline__ BlockRef block_ref(int p, const PTensors& T) {
    SwaItem it; it.bh = p & 127; it.qb0 = it.qb1 = 7 - (p >> 7);
    return swa_ref(it, 0, T);
}
}

namespace sa {
using namespace pa;
constexpr int SA_BIAS = 131072, SA_WS = SA_BIAS + 4160 * 4, SA_M = SA_WS + 2048, SA_L = SA_M + 1024, SA_WT = SA_L + 1024, LDS_BYTES = SA_WT + 64;
constexpr float SQRTD = 11.313708498984761f, C2 = 1.4426950408889634f * SCALE;
struct STensors { const bf16* Q; const bf16* Kn; const bf16* Vn; const float* ck; const float* cv; const float* clogf; const float* logf_s; const bf16* GA; bf16* Y; const float* gattn; };

__device__ __forceinline__ void sm_step(f32x16& p, float& m_reg, float& l_reg, float& alpha, bf16x8& pa0, bf16x8& pa1) {
    float pmax = p[0];
#pragma unroll
    for (int r = 1; r < 16; ++r) pmax = fmaxf(pmax, p[r]);
    { auto rr = __builtin_amdgcn_permlane32_swap(__float_as_uint(pmax), __float_as_uint(pmax), false, false);
      pmax = fmaxf(__uint_as_float(rr[0]), __uint_as_float(rr[1])); }
    float mn;
    if (__builtin_expect(__all((pmax - m_reg) * SCALE <= THR), 1)) { mn = m_reg; alpha = 1.f; }
    else { mn = fmaxf(m_reg, pmax); alpha = __builtin_amdgcn_exp2f((m_reg - mn) * C2); m_reg = mn; }
    const float mnL = -mn * C2;
    float ps = 0.f;
#pragma unroll
    for (int r = 0; r < 16; ++r) { p[r] = __builtin_amdgcn_exp2f(fmaf(p[r], C2, mnL)); ps += p[r]; }
    { auto rr = __builtin_amdgcn_permlane32_swap(__float_as_uint(ps), __float_as_uint(ps), false, false);
      ps = __uint_as_float(rr[0]) + __uint_as_float(rr[1]); }
    l_reg = l_reg * alpha + ps;
#define PK4(P, B_, OUT) do { unsigned a0 = cvtpk(P[B_+0], P[B_+1]), a1 = cvtpk(P[B_+2], P[B_+3]);                          \
        unsigned b0 = cvtpk(P[B_+4], P[B_+5]), b1 = cvtpk(P[B_+6], P[B_+7]);                                             \
        auto r0 = __builtin_amdgcn_permlane32_swap(a0, b0, false, false); auto r1 = __builtin_amdgcn_permlane32_swap(a1, b1, false, false); \
        u32x4 w = {r0[0], r1[0], r0[1], r1[1]}; OUT = *reinterpret_cast<bf16x8*>(&w); } while (0)
    PK4(p, 0, pa0); PK4(p, 8, pa1);
#undef PK4
}

__device__ __forceinline__ void sample_unit(char* lds, int b, int h, const STensors& T) {
    const int tid = threadIdx.x, wid = __builtin_amdgcn_readfirstlane(tid >> 6); int lane = tid & 63; asm volatile("" : "+v"(lane));
    const int r32 = lane & 31, hi = lane >> 5;
    char* Kt = lds + wid * 16384; char* Vt = Kt + 8192;
    float* biasL = (float*)(lds + SA_BIAS);
    float* ws = (float*)(lds + SA_WS) + wid * 64; float* li_l = ws; float* al_l = ws + 32;
    float* Mx = (float*)(lds + SA_M); float* Lx = (float*)(lds + SA_L); float* wt = (float*)(lds + SA_WT);
    {
        const float* lf = T.clogf + ((size_t)b * 4096 + 512 * wid + 8 * lane) * 8 + h;
        float v[8], e[8];
#pragma unroll
        for (int k = 0; k < 8; ++k) v[k] = lf[k * 8];
        float run = 0.f;
#pragma unroll
        for (int k = 7; k >= 0; --k) { e[k] = run; run += v[k]; }
        float incl = run;
#pragma unroll
        for (int off = 1; off < 64; off <<= 1) { const float t = __shfl_down(incl, off); if (lane + off < 64) incl += t; }
        const float excl = incl - run;
        if (lane == 0) wt[wid] = incl;
        float nv = 0.f;
        if (wid == 0) { if (lane < 32) nv = T.logf_s[((size_t)b * 32 + lane) * 8 + h];
#pragma unroll
            for (int off = 1; off < 32; off <<= 1) { const float t = __shfl_up(nv, off); if (lane >= off) nv += t; } }
        __syncthreads();
        float X = 0.f;
        for (int w2 = wid + 1; w2 < 8; ++w2) X += wt[w2];
#pragma unroll
        for (int k = 0; k < 8; ++k) biasL[512 * wid + 8 * lane + k] = (e[k] + excl + X) * SQRTD;
        if (wid == 0 && lane < 32) biasL[4096 + lane] = -nv * SQRTD;
    }
    bf16x8 qr[8];
    { const bf16* qp = T.Q + ((size_t)b * 32 + r32) * 1024 + h * 128 + hi * 8;
#pragma unroll
      for (int d0 = 0; d0 < 8; ++d0) qr[d0] = load8<bf16>(qp + d0 * 16); }
    __syncthreads();
    float m_reg = -1e30f, l_reg = 0.f; f32x16 o[4] = {};
    const int vb0 = (int)(uintptr_t)Vt + v_rd_base(lane);
    const char* ckb = (const char*)(T.ck + (((size_t)b * 4096) * 8 + h) * 128);
    const char* cvb = (const char*)(T.cv + (((size_t)b * 4096) * 8 + h) * 128);
    const unsigned lofs = (unsigned)(hi * 4096 + r32 * 16);
    char* const kwb0 = Kt + KSWZ(0 + hi, r32 * 8); char* const kwb1 = Kt + KSWZ(2 + hi, r32 * 8); char* const kwb2 = Kt + KSWZ(4 + hi, r32 * 8); char* const kwb3 = Kt + KSWZ(6 + hi, r32 * 8);
    char* const vwb = Vt + ((r32 * 4) >> 5) * 512 + hi * 64 + ((r32 * 4) & 31) * 2;
    f32x4 stg[16];
#define SA_ISSUE(src, kb) do { const char* s_ = (src) + (size_t)(kb) * 4096; _Pragma("unroll") for (int i = 0; i < 16; ++i) stg[i] = *(const f32x4*)(s_ + (size_t)i * 8192 + lofs); } while (0)
#define SA_WRITE_K() do { _Pragma("unroll") for (int i = 0; i < 16; ++i) { uint2 w_; w_.x = cvtpk(stg[i][0], stg[i][1]); w_.y = cvtpk(stg[i][2], stg[i][3]); \
        char* kb_ = (i & 3) == 0 ? kwb0 : ((i & 3) == 1 ? kwb1 : ((i & 3) == 2 ? kwb2 : kwb3)); *(uint2*)(kb_ + (i >> 2) * 2048) = w_; } } while (0)
#define SA_WRITE_V() do { _Pragma("unroll") for (int i = 0; i < 16; ++i) { uint2 w_; w_.x = cvtpk(stg[i][0], stg[i][1]); w_.y = cvtpk(stg[i][2], stg[i][3]); \
        *(uint2*)(vwb + (i & 1) * 128 + ((i >> 1) & 1) * 2048 + ((i >> 2) & 1) * 256 + ((i >> 3) & 1) * 4096) = w_; } } while (0)
#define SA_VMW() asm volatile("s_waitcnt vmcnt(0)" ::: "memory")
#define SA_LGW() asm volatile("s_waitcnt lgkmcnt(0)" ::: "memory")
#define SA_QKT(p, kb) do { const char* bt_ = (const char*)(biasL + (kb) + 4 * hi); \
        { const f32x4 b0 = *(const f32x4*)(bt_), b1 = *(const f32x4*)(bt_ + 32), b2 = *(const f32x4*)(bt_ + 64), b3 = *(const f32x4*)(bt_ + 96); \
          p = (f32x16){b0[0], b0[1], b0[2], b0[3], b1[0], b1[1], b1[2], b1[3], b2[0], b2[1], b2[2], b2[3], b3[0], b3[1], b3[2], b3[3]}; } \
        _Pragma("unroll") for (int d0 = 0; d0 < 8; ++d0) { const bf16x8 kf = *(const bf16x8*)(Kt + KSWZ(r32, ((d0 & 3) * 16 + hi * 8) * 2) + (d0 >> 2) * 128); \
            p = __builtin_amdgcn_mfma_f32_32x32x16_bf16(kf, qr[d0], p, 0, 0, 0); } } while (0)
#define SA_RESC(a) do { if (__any((a) < 1.f)) { if (hi == 0) al_l[r32] = (a); SA_LGW();              \
        _Pragma("unroll") for (int d_ = 0; d_ < 4; ++d_) _Pragma("unroll") for (int r = 0; r < 16; ++r) o[d_][r] *= al_l[crow(r, hi)]; } } while (0)
#define SA_TRRD(dst, off) asm volatile("ds_read_b64_tr_b16 %0, %1 offset:%2" : "=&v"(dst) : "v"(vb0), "i"(off) : "memory")
#define SA_PV() do { _Pragma("unroll") for (int d0 = 0; d0 < 4; ++d0) { s16x4 l0, h0, l1, h1; \
        if (d0 == 0) { SA_TRRD(l0, 0); SA_TRRD(h0, 2048); SA_TRRD(l1, 4096); SA_TRRD(h1, 6144); } \
        else if (d0 == 1) { SA_TRRD(l0, 512); SA_TRRD(h0, 2560); SA_TRRD(l1, 4608); SA_TRRD(h1, 6656); } \
        else if (d0 == 2) { SA_TRRD(l0, 1024); SA_TRRD(h0, 3072); SA_TRRD(l1, 5120); SA_TRRD(h1, 7168); } \
        else { SA_TRRD(l0, 1536); SA_TRRD(h0, 3584); SA_TRRD(l1, 5632); SA_TRRD(h1, 7680); } \
        SA_LGW(); SBAR(); \
        o[d0] = __builtin_amdgcn_mfma_f32_32x32x16_bf16(pa0, (bf16x8){l0[0], l0[1], l0[2], l0[3], h0[0], h0[1], h0[2], h0[3]}, o[d0], 0, 0, 0); \
        o[d0] = __builtin_amdgcn_mfma_f32_32x32x16_bf16(pa1, (bf16x8){l1[0], l1[1], l1[2], l1[3], h1[0], h1[1], h1[2], h1[3]}, o[d0], 0, 0, 0); } } while (0)
    const int kw0 = 512 * wid;
    SA_ISSUE(ckb, kw0);
#pragma unroll 1
    for (int i = 0; i < 16; ++i) {
        const int kb = kw0 + 32 * i;
        f32x16 p; float alpha; bf16x8 pa0, pa1;
        SA_VMW(); SA_WRITE_K(); SBAR();
        SA_ISSUE(cvb, kb); SBAR();
        SA_LGW(); SA_QKT(p, kb);
        sm_step(p, m_reg, l_reg, alpha, pa0, pa1);
        SA_VMW(); SA_WRITE_V(); SBAR();
        if (i + 1 < 16) SA_ISSUE(ckb, kb + 32);
        SBAR();
        SA_RESC(alpha);
        SA_LGW(); SA_PV();
    }
    if (wid == 0) {
        const bf16* kn = T.Kn + ((size_t)b * 32 + (lane >> 4)) * 1024 + h * 128 + (lane & 15) * 8;
        const bf16* vn = T.Vn + ((size_t)b * 32 + (lane >> 4)) * 1024 + h * 128 + (lane & 15) * 8;
        bf16x8 kk[8], vv[8];
#pragma unroll
        for (int i = 0; i < 8; ++i) { kk[i] = load8<bf16>(kn + (size_t)i * 4096); vv[i] = load8<bf16>(vn + (size_t)i * 4096); }
#pragma unroll
        for (int i = 0; i < 8; ++i) { const int row = 4 * i + (lane >> 4); *(bf16x8*)(Kt + KSWZ(row, (lane & 15) * 16)) = kk[i]; *(bf16x8*)(Vt + v_st(row, (lane & 15) * 8)) = vv[i]; }
        f32x16 p; float alpha; bf16x8 pa0, pa1;
        SA_LGW(); SA_QKT(p, 4096);
        { const float NEG = -__builtin_inff();
#pragma unroll
          for (int r = 0; r < 16; ++r) if (crow(r, hi) > r32) p[r] = NEG; }
        sm_step(p, m_reg, l_reg, alpha, pa0, pa1);
        SA_RESC(alpha);
        SA_LGW(); SA_PV();
    }
    if (hi == 0) Mx[wid * 32 + r32] = m_reg;
    __syncthreads();
    { float ms = Mx[r32];
#pragma unroll
      for (int w2 = 1; w2 < 8; ++w2) ms = fmaxf(ms, Mx[w2 * 32 + r32]);
      const float f = __builtin_amdgcn_exp2f((m_reg - ms) * C2);
      l_reg *= f;
      if (hi == 0) { al_l[r32] = f; Lx[wid * 32 + r32] = l_reg; }
      SA_LGW();
#pragma unroll
      for (int d_ = 0; d_ < 4; ++d_)
#pragma unroll
          for (int r = 0; r < 16; ++r) o[d_][r] *= al_l[crow(r, hi)]; }
#define SA_OWR(slot) do { char* sp_ = lds + (slot) * 16384 + lane * 16; _Pragma("unroll") for (int d_ = 0; d_ < 4; ++d_) _Pragma("unroll") for (int g = 0; g < 4; ++g) \
        *(f32x4*)(sp_ + (d_ * 4 + g) * 1024) = (f32x4){o[d_][4 * g], o[d_][4 * g + 1], o[d_][4 * g + 2], o[d_][4 * g + 3]}; } while (0)
#define SA_OAD(slot) do { const char* sp_ = lds + (slot) * 16384 + lane * 16; _Pragma("unroll") for (int d_ = 0; d_ < 4; ++d_) _Pragma("unroll") for (int g = 0; g < 4; ++g) { \
        const f32x4 t_ = *(const f32x4*)(sp_ + (d_ * 4 + g) * 1024); o[d_][4 * g] += t_[0]; o[d_][4 * g + 1] += t_[1]; o[d_][4 * g + 2] += t_[2]; o[d_][4 * g + 3] += t_[3]; } } while (0)
    if (wid >= 4) SA_OWR(wid - 4);
    __syncthreads();
    if (wid < 4) SA_OAD(wid);
    __syncthreads();
    if (wid == 2 || wid == 3) SA_OWR(wid - 2);
    __syncthreads();
    if (wid < 2) SA_OAD(wid);
    __syncthreads();
    if (wid == 1) SA_OWR(0);
    __syncthreads();
    if (wid == 0) {
        SA_OAD(0);
        int r32 = lane & 31, hi = lane >> 5; asm volatile("" : "+v"(r32), "+v"(hi));
        float lt = Lx[r32];
#pragma unroll
        for (int w2 = 1; w2 < 8; ++w2) lt += Lx[w2 * 32 + r32];
        if (hi == 0) li_l[r32] = lt;
        SA_LGW();
        float rs[16];
#pragma unroll
        for (int r = 0; r < 16; ++r) { const float rl = __builtin_amdgcn_rcpf(li_l[crow(r, hi)]); float s = 0.f;
#pragma unroll
            for (int d0 = 0; d0 < 4; ++d0) { o[d0][r] *= rl; s = fmaf(o[d0][r], o[d0][r], s); }
            s += __shfl_xor(s, 1); s += __shfl_xor(s, 2); s += __shfl_xor(s, 4); s += __shfl_xor(s, 8); s += __shfl_xor(s, 16);
            rs[r] = __builtin_amdgcn_rsqf(s * (1.0f / 128.0f) + 1e-6f); }
        float gw[4];
#pragma unroll
        for (int d0 = 0; d0 < 4; ++d0) gw[d0] = T.gattn[h * 128 + d0 * 32 + r32];
        const bf16* gap = T.GA + (size_t)b * 32 * 1024 + h * 128; bf16* yp = T.Y + (size_t)b * 32 * 2048 + h * 128;
        unsigned short gq[16][4];
#pragma unroll
        for (int r = 0; r < 16; ++r) { const int orow = crow(r, hi);
#pragma unroll
            for (int d0 = 0; d0 < 4; ++d0) gq[r][d0] = *(const unsigned short*)(gap + (size_t)orow * 1024 + d0 * 32 + r32); }
#pragma unroll
        for (int r = 0; r < 16; ++r) { const int orow = crow(r, hi);
#pragma unroll
            for (int d0 = 0; d0 < 4; ++d0) { const float ga = __uint_as_float((unsigned)gq[r][d0] << 16);
                const float v = o[d0][r] * rs[r] * gw[d0] * ga; const float vn = __shfl_xor(v, 1);
                if ((r32 & 1) == 0) *(unsigned*)(yp + (size_t)orow * 2048 + d0 * 32 + r32) = cvtpk(v, vn); } }
    }
    __syncthreads();
#undef SA_ISSUE
#undef SA_WRITE_K
#undef SA_WRITE_V
#undef SA_VMW
#undef SA_LGW
#undef SA_QKT
#undef SA_RESC
#undef SA_TRRD
#undef SA_PV
#undef SA_OWR
#undef SA_OAD
}
}

namespace lru {
using namespace pa;
constexpr int WP = 272;
constexpr int L_WR = 0, L_WI = 128 * WP, L_CW = 2 * 128 * WP, L_CST = L_CW + 5 * 128 * 4, L_XA = L_CST + 4 * 128 * 4, L_XU = L_XA + 2 * 8 * 32 * 4, L_CAR = L_XU + 2 * 8 * 32 * 4, L_GL = L_CAR + 2 * 128 * 4, LDS_BYTES = L_GL + 8 * 8192;
struct LTensors { const bf16* XL; const bf16* GL; bf16* Y; const bf16* WrT; const bf16* WiT; const float* conv_w; const float* conv_b; const float* b_r; const float* b_i; const float* lam; const float* g_lru;
                  const float* state_h; const float* state_conv; float* h_p; float* h_s; };

__device__ __forceinline__ void load_weights(char* lds, const LTensors& T, int n) {
    int tid = threadIdx.x; asm volatile("" : "+v"(tid));
#pragma unroll
    for (int i = 0; i < 4; ++i) { const int ch = tid + 512 * i, row = ch >> 4, c16 = ch & 15;
        *(u32x4*)(lds + L_WR + row * WP + c16 * 16) = *(const u32x4*)((const char*)(T.WrT + (size_t)n * 16384) + row * 256 + c16 * 16);
        *(u32x4*)(lds + L_WI + row * WP + c16 * 16) = *(const u32x4*)((const char*)(T.WiT + (size_t)n * 16384) + row * 256 + c16 * 16); }
    for (int i = tid; i < 5 * 128; i += 512) { const int d = i >> 7, c = i & 127; ((float*)(lds + L_CW))[i] = (d < 4) ? T.conv_w[d * 1024 + n * 128 + c] : T.conv_b[n * 128 + c]; }
    if (tid < 128) { const int c = n * 128 + tid; float* cst = (float*)(lds + L_CST);
        cst[tid] = T.b_r[c]; cst[128 + tid] = T.b_i[c]; const float lam = T.lam[c]; cst[256 + tid] = 8.0f * (fmaxf(-lam, 0.f) + log1pf(expf(-fabsf(lam)))); cst[384 + tid] = T.g_lru[c]; }
    if (tid < 256) ((float*)(lds + L_CAR))[tid] = 0.f;
}
template <bool SAMPLE>
__device__ __forceinline__ void tile_afrags(const char* lds, const bf16* xl, int t0, const float* hist, bf16x8 (&af)[8], int r32, int hi) {
    const float* cw = (const float*)(lds + L_CW);
#pragma unroll
    for (int kh = 0; kh < 2; ++kh) {
        bf16x8 raw[4][4];
#pragma unroll
        for (int k4 = 0; k4 < 4; ++k4)
#pragma unroll
            for (int d = 0; d < 4; ++d) { const int tt = r32 - 3 + d; raw[k4][d] = (bf16x8){0, 0, 0, 0, 0, 0, 0, 0};
                if (t0 + tt >= 0) raw[k4][d] = *(const bf16x8*)(xl + (ptrdiff_t)tt * 1024 + (kh * 4 + k4) * 16 + hi * 8); }
#pragma unroll
        for (int k4 = 0; k4 < 4; ++k4) { const int ks = kh * 4 + k4, c8 = ks * 16 + hi * 8;
            f32x4 x0 = *(const f32x4*)(cw + 4 * 128 + c8), x1 = *(const f32x4*)(cw + 4 * 128 + c8 + 4);
#pragma unroll
            for (int d = 0; d < 4; ++d) { const int tt = r32 - 3 + d; const bf16x8 rw = raw[k4][d];
                f32x4 v0 = (f32x4){__uint_as_float((unsigned)(unsigned short)rw[0] << 16), __uint_as_float((unsigned)(unsigned short)rw[1] << 16), __uint_as_float((unsigned)(unsigned short)rw[2] << 16), __uint_as_float((unsigned)(unsigned short)rw[3] << 16)};
                f32x4 v1 = (f32x4){__uint_as_float((unsigned)(unsigned short)rw[4] << 16), __uint_as_float((unsigned)(unsigned short)rw[5] << 16), __uint_as_float((unsigned)(unsigned short)rw[6] << 16), __uint_as_float((unsigned)(unsigned short)rw[7] << 16)};
                if (SAMPLE) { if (t0 + tt < 0) { const float* hp = hist + (size_t)(tt + 3) * 1024 + c8; v0 = *(const f32x4*)hp; v1 = *(const f32x4*)(hp + 4); } }
                const f32x4 w0 = *(const f32x4*)(cw + d * 128 + c8), w1 = *(const f32x4*)(cw + d * 128 + c8 + 4);
                x0 += w0 * v0; x1 += w1 * v1; }
            af[ks] = pack8(x0, x1); }
        asm volatile("" ::: "memory"); }
}
__device__ __forceinline__ void cb_maps(const char* lds, const bf16x8 (&af)[8], int cb, bool first0, f32x16& PA, f32x16& PU, float& tA, float& tU, int r32, int hi) {
    f32x16 ar = {}, ai = {}, ax = {};
    const char* wp = lds + (cb * 32 + r32) * WP + hi * 16;
#pragma unroll
    for (int ks = 0; ks < 8; ++ks) {
        const bf16x8 br = *(const bf16x8*)(wp + L_WR + ks * 32), bi = *(const bf16x8*)(wp + L_WI + ks * 32);
        ar = __builtin_amdgcn_mfma_f32_32x32x16_bf16(af[ks], br, ar, 0, 0, 0);
        ai = __builtin_amdgcn_mfma_f32_32x32x16_bf16(af[ks], bi, ai, 0, 0, 0);
        if ((ks & 1) == 1) asm volatile("" ::: "memory"); }
    {
        const int j = r32 & 7; const unsigned one = (j & 1) ? 0x3F800000u : 0x00003F80u; const bool hm = (hi == ((r32 >> 3) & 1));
        const bool c0 = hm && ((r32 >> 4) == 0), c1 = hm && ((r32 >> 4) == 1);
        u32x4 f0, f1;
        f0.x = (c0 && (j >> 1) == 0) ? one : 0u; f0.y = (c0 && (j >> 1) == 1) ? one : 0u; f0.z = (c0 && (j >> 1) == 2) ? one : 0u; f0.w = (c0 && (j >> 1) == 3) ? one : 0u;
        f1.x = (c1 && (j >> 1) == 0) ? one : 0u; f1.y = (c1 && (j >> 1) == 1) ? one : 0u; f1.z = (c1 && (j >> 1) == 2) ? one : 0u; f1.w = (c1 && (j >> 1) == 3) ? one : 0u;
        ax = __builtin_amdgcn_mfma_f32_32x32x16_bf16(af[2 * cb], *reinterpret_cast<bf16x8*>(&f0), ax, 0, 0, 0);
        ax = __builtin_amdgcn_mfma_f32_32x32x16_bf16(af[2 * cb + 1], *reinterpret_cast<bf16x8*>(&f1), ax, 0, 0, 0); }
    const float* cst = (const float*)(lds + L_CST) + cb * 32 + r32;
    const float cbr = cst[0], cbi = cst[128], csp = cst[256];
    const bool first = first0 && (hi == 0);
#pragma unroll
    for (int r = 0; r < 16; ++r) {
        const float rg = __builtin_amdgcn_rcpf(1.0f + __builtin_amdgcn_exp2f(-1.4426950408889634f * (ar[r] + cbr)));
        const float ig = __builtin_amdgcn_rcpf(1.0f + __builtin_amdgcn_exp2f(-1.4426950408889634f * (ai[r] + cbi)));
        const float av = __builtin_amdgcn_exp2f(-1.4426950408889634f * csp * rg);
        float mult = __builtin_amdgcn_sqrtf(fmaxf(fmaf(-av, av, 1.0f), 0.f));
        if (r == 0 && first) mult = 1.0f;
        ar[r] = av; ai[r] = mult * ig * ax[r]; }
    float Ag[4], Ug[4];
#pragma unroll
    for (int gl = 0; gl < 4; ++gl) { const int r0 = 4 * gl;
        float pa = ar[r0], pu = ai[r0];
#pragma unroll
        for (int k = 1; k < 4; ++k) { pu = fmaf(ar[r0 + k], pu, ai[r0 + k]); pa = ar[r0 + k] * pa; ar[r0 + k] = pa; ai[r0 + k] = pu; }
        Ag[gl] = pa; Ug[gl] = pu; }
    float GA = 1.0f, GU = 0.f;
#pragma unroll
    for (int gl = 0; gl < 4; ++gl) { const int r0 = 4 * gl;
        const float oA = __shfl_xor(Ag[gl], 32), oU = __shfl_xor(Ug[gl], 32);
        const float sA0 = hi ? oA : Ag[gl], sU0 = hi ? oU : Ug[gl], sA1 = hi ? Ag[gl] : oA, sU1 = hi ? Ug[gl] : oU;
        const float GA1 = sA0 * GA, GU1 = fmaf(sA0, GU, sU0);
        const float mA = hi ? GA1 : GA, mU = hi ? GU1 : GU;
#pragma unroll
        for (int k = 0; k < 4; ++k) { PU[r0 + k] = fmaf(ar[r0 + k], mU, ai[r0 + k]); PA[r0 + k] = ar[r0 + k] * mA; }
        GA = sA1 * GA1; GU = fmaf(sA1, GU1, sU1); }
    tA = GA; tU = GU;
}
__device__ __forceinline__ void tile_gates_dma(char* lds, const bf16* gl, int wid, int lane) {
#pragma unroll
    for (int i = 0; i < 8; ++i)
        __builtin_amdgcn_global_load_lds((const __attribute__((address_space(1))) unsigned*)(gl + (size_t)(4 * i + (lane >> 4)) * 1024 + (lane & 15) * 8),
                                         (__attribute__((address_space(3))) unsigned*)(lds + L_GL + wid * 8192 + i * 1024), 16, 0, 0);
}
__device__ __forceinline__ void tile_out(const char* lds, f32x16 (&H)[4], const char* glt  , bf16* y, int r32, int hi) {
    const float* cst = (const float*)(lds + L_CST) + 384 + r32;
    const float cg0 = cst[0], cg1 = cst[32], cg2 = cst[64], cg3 = cst[96];
#pragma unroll
    for (int r = 0; r < 16; ++r) { float s = 0.f; const int tt = crow(r, hi);
#pragma unroll
        for (int cb = 0; cb < 4; ++cb) s = fmaf(H[cb][r], H[cb][r], s);
        s += __shfl_xor(s, 1); s += __shfl_xor(s, 2); s += __shfl_xor(s, 4); s += __shfl_xor(s, 8); s += __shfl_xor(s, 16);
        const float rs = __builtin_amdgcn_rsqf(s * (1.0f / 128.0f) + 1e-6f);
#pragma unroll
        for (int cb = 0; cb < 4; ++cb) { const float g = __uint_as_float((unsigned)(*(const unsigned short*)(glt + tt * 256 + (cb * 32 + r32) * 2)) << 16);
            const float v = H[cb][r] * rs * (cb == 0 ? cg0 : (cb == 1 ? cg1 : (cb == 2 ? cg2 : cg3))) * g; const float vn = __shfl_xor(v, 1);
            if ((r32 & 1) == 0) *(unsigned*)(y + (size_t)tt * 2048 + cb * 32 + r32) = cvtpk(v, vn); } }
}
__device__ __forceinline__ void prompt_unit(char* lds, const LTensors& T, int b, int n) {
    const int tid = threadIdx.x, wid = __builtin_amdgcn_readfirstlane(tid >> 6); const int lane0 = tid & 63;
    load_weights(lds, T, n);
    __syncthreads();
    float* XA = (float*)(lds + L_XA); float* XU = (float*)(lds + L_XU); float* CAR = (float*)(lds + L_CAR);
#pragma unroll 1
    for (int ch = 0; ch < 8; ++ch) {
        int lane = lane0; asm volatile("" : "+v"(lane)); const int r32 = lane & 31, hi = lane >> 5;
        const int t0 = ch * 256 + wid * 32; const size_t row = (size_t)b * 2048 + t0;
        tile_gates_dma(lds, T.GL + row * 1024 + n * 128, wid, lane);
        bf16x8 af[8];
        tile_afrags<false>(lds, T.XL + row * 1024 + n * 128, t0, nullptr, af, r32, hi);
        f32x16 H[4];
#pragma unroll
        for (int cb = 0; cb < 4; ++cb) { const int par = cb & 1, c = cb * 32 + r32;
            f32x16 PA, PU; float tA, tU;
            cb_maps(lds, af, cb, t0 == 0, PA, PU, tA, tU, r32, hi);
            if (hi == 0) { XA[(par * 8 + wid) * 32 + r32] = tA; XU[(par * 8 + wid) * 32 + r32] = tU; }
            __syncthreads();
            float hin = CAR[(ch & 1) * 128 + c];
            for (int w2 = 0; w2 < wid; ++w2) hin = fmaf(XA[(par * 8 + w2) * 32 + r32], hin, XU[(par * 8 + w2) * 32 + r32]);
#pragma unroll
            for (int r = 0; r < 16; ++r) H[cb][r] = fmaf(PA[r], hin, PU[r]);
            if (wid == 7 && hi == 1) { CAR[((ch + 1) & 1) * 128 + c] = H[cb][15]; if (ch == 7) T.h_p[(size_t)b * 1024 + n * 128 + c] = H[cb][15]; } }
        asm volatile("s_waitcnt vmcnt(0)" ::: "memory");
        { int r32v = r32, hiv = hi; asm volatile("" : "+v"(r32v), "+v"(hiv)); tile_out(lds, H, lds + L_GL + wid * 8192, T.Y + row * 2048 + 1024 + n * 128, r32v, hiv); }
    }
    __syncthreads();
}
__device__ __forceinline__ void sample_unit(char* lds, const LTensors& T, int n) {
    const int tid = threadIdx.x, wid = __builtin_amdgcn_readfirstlane(tid >> 6); const int lane0 = tid & 63;
    load_weights(lds, T, n);
    __syncthreads();
#pragma unroll 1
    for (int bi = 0; bi < 4; ++bi) { const int b = wid + 8 * bi;
        int lane = lane0; asm volatile("" : "+v"(lane)); const int r32 = lane & 31, hi = lane >> 5; const size_t row = 32768 + (size_t)b * 32;
        tile_gates_dma(lds, T.GL + row * 1024 + n * 128, wid, lane);
        bf16x8 af[8];
        tile_afrags<true>(lds, T.XL + row * 1024 + n * 128, 0, T.state_conv + (size_t)b * 3 * 1024 + n * 128, af, r32, hi);
        f32x16 H[4];
#pragma unroll
        for (int cb = 0; cb < 4; ++cb) { const int c = n * 128 + cb * 32 + r32;
            f32x16 PA, PU; float tA, tU;
            cb_maps(lds, af, cb, false, PA, PU, tA, tU, r32, hi);
            const float hin = T.state_h[(size_t)b * 1024 + c];
#pragma unroll
            for (int r = 0; r < 16; ++r) H[cb][r] = fmaf(PA[r], hin, PU[r]);
            if (hi == 1) T.h_s[(size_t)b * 1024 + c] = H[cb][15]; }
        asm volatile("s_waitcnt vmcnt(0)" ::: "memory");
        { int r32v = r32, hiv = hi; asm volatile("" : "+v"(r32v), "+v"(hiv)); tile_out(lds, H, lds + L_GL + wid * 8192, T.Y + row * 2048 + 1024 + n * 128, r32v, hiv); }
    }
    __syncthreads();
}
}

constexpr int NWAVES = 8;
constexpr int N_LAUNCHES = MK_N_LAUNCHES;
constexpr int PER_PHASE = 5;
constexpr int DM = 2048, SEQ = 2048, NB = 16, DB = 32, DS = 32, PAST = 4096, NH = 8, HD = 128, DA = 1024, DL = 1024;
constexpr int MP = NB * SEQ, MS = DB * DS, M = MP + MS;
constexpr int D_IN = 6152, NIN = 6144;
constexpr float LN_EPS = 1e-5f, ALPHA = 1.189207115002721f;
constexpr size_t O_YP = 0, O_YS = O_YP + (size_t)MP * DM, O_KP = O_YS + (size_t)MS * DM, O_VP = O_KP + (size_t)MP * DA, O_FP = O_VP + (size_t)MP * DA,
                 O_HP = O_FP + (size_t)MP * NH, O_CP = O_HP + (size_t)NB * DL, O_KS = O_CP + (size_t)NB * 3 * DL, O_VS = O_KS + (size_t)MS * DA, O_FS = O_VS + (size_t)MS * DA,
                 O_HS = O_FS + (size_t)MS * NH, O_CS = O_HS + (size_t)DB * DL, O_END = O_CS + (size_t)DB * 3 * DL;
static_assert(O_END == 138878976, "d_out size");
constexpr size_t MiB = 1u << 20;
constexpr size_t WS_CTL = 0, CTL_ZERO_BYTES = 1 * MiB;
constexpr size_t WS_WIN = 2 * MiB;
constexpr size_t WS_WOUT = 26 * MiB;
constexpr size_t WS_WR = 34 * MiB, WS_WI = 34 * MiB + 512 * 1024;
constexpr size_t WS_BIAS = 35 * MiB;
constexpr size_t WS_XB = 40 * MiB;
constexpr size_t ACT_BYTES = (size_t)M * 1024 * 2;
constexpr size_t WS_ACT = 172 * MiB;
constexpr size_t WS_YC = WS_ACT + 6 * ACT_BYTES;
constexpr size_t WS_END = WS_YC + (size_t)M * 2048 * 2;
static_assert(ACT_BYTES == 66 * MiB && WS_XB + (size_t)M * 2048 * 2 <= WS_ACT, "ws map");
constexpr int CW_TMO = 0, CW_CODE = 1, CW_BAR = 4096, CW_QUEUE = 8192;
constexpr int PH_BYTES = 153600;
constexpr int LDSCTL_OFF = PH_BYTES, MISC_OFF = LDSCTL_OFF + 320, LDS_BYTES = 155648;
static_assert(MISC_OFF + 128 <= LDS_BYTES && sa::LDS_BYTES <= PH_BYTES && lru::LDS_BYTES <= PH_BYTES && pa::LDS_BYTES <= PH_BYTES && pg8::STAGE_BYTES <= PH_BYTES, "LDS map");

#define GAS __attribute__((address_space(1)))
#define LAS __attribute__((address_space(3)))
typedef unsigned short bf16;
typedef unsigned v4u __attribute__((ext_vector_type(4)));
typedef float f32x4 __attribute__((ext_vector_type(4)));
typedef GAS unsigned gu32;
#define RLX_AGENT __ATOMIC_RELAXED, __HIP_MEMORY_SCOPE_AGENT
#define LDS_WAIT() asm volatile("s_waitcnt lgkmcnt(0)" ::: "memory")
#define VM_WAIT() asm volatile("s_waitcnt vmcnt(0)" ::: "memory")
__device__ __forceinline__ unsigned f2bf(float f) { unsigned u = __builtin_bit_cast(unsigned, f); return (u + 0x7fffu + ((u >> 16) & 1u)) >> 16; }
__device__ __forceinline__ unsigned pk2(float lo, float hi) { return f2bf(lo) | (f2bf(hi) << 16); }

#define XB_TMO      128
#define XB_XCNT(j)  (256  + 64 * (j))
#define XB_XSUB(j)  (1280 + 64 * (j))
#define XB_XGEN(j)  (2304 + 64 * (j))
#define XB_TOP      3328
#define XB_TOPGEN   3392
#define XCD_BAR_WORDS 3456
#define XB_SPIN_CAP (1u << 18)

__device__ __forceinline__ unsigned xb_ld(unsigned* p)              { return __hip_atomic_load(p, __ATOMIC_RELAXED, __HIP_MEMORY_SCOPE_AGENT); }
__device__ __forceinline__ unsigned xb_add(unsigned* p, unsigned v) { return __hip_atomic_fetch_add(p, v, __ATOMIC_RELAXED, __HIP_MEMORY_SCOPE_AGENT); }
__device__ __forceinline__ unsigned xb_xcc_id() { return (unsigned)__builtin_amdgcn_s_getreg((3 << 11) | 20) & 0xFu; }
#define XB_SPIN(cond, bar) do { unsigned _sp = 0; while (cond) { __builtin_amdgcn_s_sleep(1); \
    if ((++_sp & 255u) == 0u) { if (xb_ld(&(bar)[XB_TMO])) break; if (_sp > XB_SPIN_CAP) { atomicAdd(&(bar)[XB_TMO], 1u); break; } } } } while (0)

struct XcdBarrier {
    unsigned* bar; unsigned x;
    volatile LAS unsigned* st;
};

__device__ __forceinline__ XcdBarrier xcd_barrier_post(unsigned* bar, volatile LAS unsigned* st) {
    XcdBarrier b; b.bar = bar; b.x = xb_xcc_id(); b.st = st;
    if (threadIdx.x == 0) (void)xb_add(&bar[XB_XCNT(b.x)], 1u);
    return b;
}
__device__ __forceinline__ void xcd_barrier_complete(unsigned* bar, unsigned x, unsigned& nloc, unsigned& nx) {
    const unsigned G = gridDim.x * gridDim.y * gridDim.z;
    unsigned sum, cnt, mine, sp = 0u;
    for (;;) {
        sum = 0u; cnt = 0u; mine = 0u;
#pragma unroll
        for (unsigned j = 0; j < 16; ++j) { const unsigned c = xb_ld(&bar[XB_XCNT(j)]); sum += c; cnt += (c > 0u) ? 1u : 0u; mine = (j == x) ? c : mine; }
        if (sum == G) break;
        __builtin_amdgcn_s_sleep(1);
        if ((++sp & 255u) == 0u) { if (xb_ld(&bar[XB_TMO])) break; if (sp > XB_SPIN_CAP) { atomicAdd(&bar[XB_TMO], 1u); break; } }
    }
    nloc = mine > 0u ? mine : 1u; nx = cnt > 0u ? cnt : 1u;
}

__device__ __forceinline__ void xcd_barrier(const XcdBarrier& b) {
    asm volatile("s_waitcnt vmcnt(0)" ::: "memory");
    __syncthreads();
    if (threadIdx.x == 0) {
        unsigned* bar = b.bar;
        __builtin_amdgcn_s_waitcnt(0);
        unsigned nloc = b.st[0], nx = b.st[1];
        if (nloc == 0u) { xcd_barrier_complete(bar, b.x, nloc, nx); b.st[0] = nloc; b.st[1] = nx; }
        const unsigned old = xb_add(&bar[XB_XSUB(b.x)], 1u);
        const unsigned gen = old / nloc;
        if (old + 1u == (gen + 1u) * nloc) {
            __builtin_amdgcn_fence(__ATOMIC_RELEASE, "agent");
            asm volatile("s_waitcnt vmcnt(0)" ::: "memory");
            const unsigned og = xb_add(&bar[XB_TOP], 1u);
            const unsigned tg = og / nx;
            if (og + 1u == (tg + 1u) * nx) xb_add(&bar[XB_TOPGEN], 1u);
            else XB_SPIN(xb_ld(&bar[XB_TOPGEN]) == tg, bar);
            __builtin_amdgcn_fence(__ATOMIC_ACQUIRE, "agent");
            xb_add(&bar[XB_XGEN(b.x)], 1u);
            asm volatile("s_waitcnt vmcnt(0)" ::: "memory");
        } else {
            XB_SPIN(xb_ld(&bar[XB_XGEN(b.x)]) == gen, bar);
            __builtin_amdgcn_fence(__ATOMIC_ACQUIRE, "agent");
            asm volatile("s_waitcnt vmcnt(0)" ::: "memory");
        }
    }
    __syncthreads();
}

__device__ __forceinline__ float wave_sum(float v) {
#pragma unroll
    for (int o = 1; o < 64; o <<= 1) v += __shfl_xor(v, o);
    return v;
}
__device__ __forceinline__ void p0_transpose_item(const float* W, int ldw, int scol, bf16* WT, int K, int drow, int k0, LAS float* scr, int lane) {
#pragma unroll 8
    for (int i = 0; i < 32; ++i) { const int kk = 2 * i + (lane >> 5); scr[kk * 33 + (lane & 31)] = W[(size_t)(k0 + kk) * ldw + scol + (lane & 31)]; }
    LDS_WAIT(); asm volatile("" ::: "memory");
    const int c = lane & 7;
#pragma unroll
    for (int j = 0; j < 4; ++j) { const int n = (lane >> 3) + 8 * j; const LAS float* s = scr + (8 * c) * 33 + n;
        v4u o; o.x = pk2(s[0 * 33], s[1 * 33]); o.y = pk2(s[2 * 33], s[3 * 33]); o.z = pk2(s[4 * 33], s[5 * 33]); o.w = pk2(s[6 * 33], s[7 * 33]);
        *(GAS v4u*)(WT + (size_t)(drow + n) * K + k0 + 8 * c) = o; }
    LDS_WAIT(); asm volatile("" ::: "memory");
}

struct Args { const float* in[21]; float* out; unsigned char* ws; int ph_lo, ph_hi; };

__global__ void __launch_bounds__(NWAVES * 64, 2) fwd_kernel(Args args) {
    extern __shared__ __attribute__((aligned(16))) unsigned char lds[];
    LAS unsigned char* ldsl = (LAS unsigned char*)lds;
    volatile LAS unsigned* MISC = (volatile LAS unsigned*)(ldsl + MISC_OFF);
    const int tid = threadIdx.x, lane = tid & 63, wave = __builtin_amdgcn_readfirstlane(tid >> 6);
    const int G = gridDim.x, bx = blockIdx.x;
    unsigned char* ws = args.ws;
    gu32* ctl = (gu32*)(ws + WS_CTL);
    float* out = args.out;
    const float* x_p = args.in[0]; const float* x_s = args.in[1];
    bf16* WinT = (bf16*)(ws + WS_WIN); bf16* WoutT = (bf16*)(ws + WS_WOUT); bf16* WrT = (bf16*)(ws + WS_WR); bf16* WiT = (bf16*)(ws + WS_WI);
    float* BIAS = (float*)(ws + WS_BIAS); bf16* XB = (bf16*)(ws + WS_XB); bf16* ACT = (bf16*)(ws + WS_ACT); bf16* YC = (bf16*)(ws + WS_YC);
    constexpr size_t ACT_EL = ACT_BYTES / 2;
    bf16* QB = ACT; bf16* KBf = ACT + ACT_EL; bf16* VBf = ACT + 2 * ACT_EL; bf16* GA = ACT + 3 * ACT_EL; bf16* XL = ACT + 4 * ACT_EL; bf16* GL = ACT + 5 * ACT_EL;

    for (int u = tid; u < (LDS_BYTES - LDSCTL_OFF) / 4; u += NWAVES * 64) ((LAS unsigned*)(ldsl + LDSCTL_OFF))[u] = 0u;
    __syncthreads();
    XcdBarrier bar; bar.bar = (unsigned*)(ctl + CW_BAR); bar.x = 0; bar.st = nullptr;
    if (N_LAUNCHES != PER_PHASE) bar = xcd_barrier_post((unsigned*)(ctl + CW_BAR), MISC + 8);
#define GRID_BAR(seam) do { if (N_LAUNCHES == PER_PHASE) { if (tid == 0) __hip_atomic_store(ctl + CW_TMO, 0xBADBA0u | (unsigned)(seam), RLX_AGENT); } else { xcd_barrier(bar); } } while (0)
    const int lo = args.ph_lo, hi_ph = args.ph_hi;
#ifndef ONLY_PHASE
#define ONLY_PHASE -1
#endif
#define IN(k) (lo <= (k) && (k) < hi_ph && (ONLY_PHASE < 0 || ONLY_PHASE == (k)))
#define BOTH(k) (IN(k) && IN((k) + 1))
#ifndef PROBE_REPEAT
#define PROBE_REPEAT -1
#endif
#define REP(k) for (int rep_ = 0; rep_ < ((PROBE_REPEAT == (k)) ? 2 : 1); ++rep_)

    if (IN(0)) {
        REP(0) {
        const int gw = bx * NWAVES + wave, NGW = G * NWAVES;
        const float* w_in = args.in[7]; const float* w_out = args.in[18]; const float* w_r = args.in[11]; const float* w_i = args.in[13]; const float* b_f = args.in[8];
        LAS float* scr = (LAS float*)(ldsl + wave * 16384);
        constexpr int I_IN = 32 * 192, I_OUT = 32 * 64, I_R = 64, NITEMS = I_IN + I_OUT + 2 * I_R;
        for (int it = gw; it < NITEMS; it += NGW) {
            int r = it;
            if (r < I_IN) { const int kb = r / 192, nb = r % 192; p0_transpose_item(w_in, D_IN, 32 * nb + (nb >= 96 ? 8 : 0), WinT, 2048, 32 * nb, 64 * kb, scr, lane); continue; } r -= I_IN;
            if (r < I_OUT) { const int kb = r / 64, nb = r % 64; p0_transpose_item(w_out, 2048, 32 * nb, WoutT, 2048, 32 * nb, 64 * kb, scr, lane); continue; } r -= I_OUT;
            if (r < I_R) { const int n = r >> 3, kb = (r >> 2) & 1, nb = r & 3; p0_transpose_item(w_r + (size_t)n * 16384, 128, 32 * nb, WrT + (size_t)n * 16384, 128, 32 * nb, 64 * kb, scr, lane); continue; } r -= I_R;
            { const int n = r >> 3, kb = (r >> 2) & 1, nb = r & 3; p0_transpose_item(w_i + (size_t)n * 16384, 128, 32 * nb, WiT + (size_t)n * 16384, 128, 32 * nb, 64 * kb, scr, lane); }
        }
        __syncthreads();
        LAS float* wf = (LAS float*)ldsl;
#pragma unroll
        for (int i = 0; i < 4; ++i) { const int k = tid + 512 * i; const f32x4 a = *(const f32x4*)(w_in + (size_t)k * D_IN + 3072), b = *(const f32x4*)(w_in + (size_t)k * D_IN + 3076);
            wf[0 * 2048 + k] = a[0]; wf[1 * 2048 + k] = a[1]; wf[2 * 2048 + k] = a[2]; wf[3 * 2048 + k] = a[3]; wf[4 * 2048 + k] = b[0]; wf[5 * 2048 + k] = b[1]; wf[6 * 2048 + k] = b[2]; wf[7 * 2048 + k] = b[3]; }
        __syncthreads();
        const float bfl = (lane < 8) ? b_f[lane] : 0.f;
        for (int m = gw; m < M; m += NGW) {
            const float* xr = (m < MP) ? x_p + (size_t)m * DM : x_s + (size_t)(m - MP) * DM;
            f32x4 v[8];
#pragma unroll
            for (int j = 0; j < 8; ++j) v[j] = *(const f32x4*)(xr + 4 * lane + 256 * j);
            GAS unsigned long long* o8 = (GAS unsigned long long*)(XB + (size_t)m * DM) + lane;
#pragma unroll
            for (int j = 0; j < 8; ++j) o8[64 * j] = (unsigned long long)pk2(v[j][0], v[j][1]) | ((unsigned long long)pk2(v[j][2], v[j][3]) << 32);
            float acc[8];
#pragma unroll
            for (int h = 0; h < 8; ++h) { float a = 0.f;
#pragma unroll
                for (int j = 0; j < 8; ++j) { const f32x4 w = *(const LAS f32x4*)(wf + h * 2048 + 256 * j + 4 * lane); a = fmaf(v[j][0], w[0], a); a = fmaf(v[j][1], w[1], a); a = fmaf(v[j][2], w[2], a); a = fmaf(v[j][3], w[3], a); }
                acc[h] = wave_sum(a); asm volatile("" ::: "memory"); }
            float z = acc[0];
#pragma unroll
            for (int h = 1; h < 8; ++h) z = (lane == h) ? acc[h] : z;
            if (lane < 8) { z += bfl; const float lf = fminf(z, 0.f) - log1pf(expf(-fabsf(z)));
                float* fo = (m < MP) ? out + O_FP + (size_t)m * NH : out + O_FS + (size_t)(m - MP) * NH; fo[lane] = lf; }
        }
        __syncthreads();
        }
        GRID_BAR(0);
    }

    if (IN(1)) {
        if (bx >= G - 16) {
            const int bh = (bx - (G - 16)) * NWAVES + wave, b = bh >> 3, h = bh & 7;
            const float* lf = out + O_FP + ((size_t)b * SEQ + 32 * lane) * NH + h;
            float v[32];
#pragma unroll
            for (int k = 0; k < 32; ++k) v[k] = lf[k * NH];
#pragma unroll
            for (int k = 1; k < 32; ++k) v[k] += v[k - 1];
            float incl = v[31];
#pragma unroll
            for (int off = 1; off < 64; off <<= 1) { const float t = __shfl_up(incl, off); if (lane >= off) incl += t; }
            const float excl = incl - v[31];
            float* bo = BIAS + (size_t)bh * SEQ + 32 * lane;
#pragma unroll
            for (int k = 0; k < 32; k += 4) *(f32x4*)(bo + k) = (f32x4){-(v[k] + excl) * sa::SQRTD, -(v[k + 1] + excl) * sa::SQRTD, -(v[k + 2] + excl) * sa::SQRTD, -(v[k + 3] + excl) * sa::SQRTD};
        }
        REP(1) {
        pg8::Gemm g{XB, WinT, M, NIN, DM}; pg8::InMain S{G, bx};
        pg8::EpiIn E{ACT, ACT_EL, out + O_KP, out + O_VP, out + O_KS, out + O_VS, out + O_CP, out + O_CS};
        pg8::gemm_phase<pg8::EpiIn, pg8::InMain, true, true>(ldsl, g, S, E);
        }
        GRID_BAR(1);
    }

    if (IN(2)) {
        lru::LTensors LT{(const pa::bf16*)XL, (const pa::bf16*)GL, (pa::bf16*)YC, (const pa::bf16*)WrT, (const pa::bf16*)WiT, args.in[9], args.in[10], args.in[12], args.in[14], args.in[15], args.in[17],
                         args.in[5], args.in[6], out + O_HP, out + O_HS};
        const pa::PTensors PT{(const pa::bf16*)QB, (const pa::bf16*)KBf, (const pa::bf16*)VBf, BIAS, (const pa::bf16*)GA, (pa::bf16*)YC, args.in[16]};
        const sa::STensors ST{(const pa::bf16*)(QB + (size_t)MP * 1024), (const pa::bf16*)(KBf + (size_t)MP * 1024), (const pa::bf16*)(VBf + (size_t)MP * 1024), args.in[2], args.in[3], args.in[4],
                              out + O_FS, (const pa::bf16*)(GA + (size_t)MP * 1024), (pa::bf16*)(YC + (size_t)MP * 2048), args.in[16]};
        constexpr int N_LRU = 136, N_PA = 1024, N_SA = 256, N_TAIL = 96;
        gu32* qdone = ctl + CW_QUEUE + 64 * 15;
#define QUEUE_LOOP(qidx, nitems, BODY) do { gu32* qctr_ = ctl + CW_QUEUE + 64 * (qidx); \
            for (int k_ = 0;; ++k_) { if (tid == 0) MISC[16 + (k_ & 1)] = __hip_atomic_fetch_add(qctr_, 1u, RLX_AGENT); __syncthreads(); \
                const int item = (int)MISC[16 + (k_ & 1)]; if (item >= (nitems)) break; BODY; } __syncthreads(); } while (0)
        if (bx < N_TAIL) {
            pg8::Gemm g{XB, WinT, M, NIN, DM}; pg8::OneUnit S{104 + (bx >> 2), bx & 3};
            pg8::EpiIn E{ACT, ACT_EL, out + O_KP, out + O_VP, out + O_KS, out + O_VS, out + O_CP, out + O_CS};
            pg8::gemm_phase<pg8::EpiIn, pg8::OneUnit, true, true>(ldsl, g, S, E);
            VM_WAIT(); __syncthreads();
            if (tid == 0) { __builtin_amdgcn_fence(__ATOMIC_RELEASE, "agent"); VM_WAIT(); (void)__hip_atomic_fetch_add(qdone, 1u, RLX_AGENT); }
            QUEUE_LOOP(2, N_SA, sa::sample_unit((char*)lds, item >> 3, item & 7, ST));
        }
        QUEUE_LOOP(0, N_LRU, { if (item < 128) lru::prompt_unit((char*)lds, LT, item >> 3, item & 7); else lru::sample_unit((char*)lds, LT, item - 128); });
        {
            gu32* qctr_ = ctl + CW_QUEUE + 64 * 1; int kq = 0;
#define QFETCH(dst) do { if (tid == 0) MISC[16 + (kq & 1)] = __hip_atomic_fetch_add(qctr_, 1u, RLX_AGENT); __syncthreads(); dst = (int)MISC[16 + (kq & 1)]; ++kq; } while (0)
#define PA_GATE(p) do { if (((p) & 127) >= 104) { if (tid == 0) { unsigned sp = 0; while (__hip_atomic_load(qdone, RLX_AGENT) < (unsigned)N_TAIL) { __builtin_amdgcn_s_sleep(2); if (++sp > (1u << 22)) { __hip_atomic_store(ctl + CW_TMO, 0x51u, RLX_AGENT); break; } } \
                    __builtin_amdgcn_fence(__ATOMIC_ACQUIRE, "agent"); VM_WAIT(); } __syncthreads(); } } while (0)
            int cur; QFETCH(cur);
            if (cur < N_PA) {
                PA_GATE(cur);
                pa::BlockRef cb = pa::block_ref(cur, PT); pa::Seam S; pa::causal_prime(cb, (char*)lds, S); int par = 0;
                for (;;) { int nxt; QFETCH(nxt); const bool more = nxt < N_PA; if (more) PA_GATE(nxt);
                    const pa::BlockRef nb = more ? pa::block_ref(nxt, PT) : cb;
                    pa::causal_block(cb, nb, (char*)lds, S, par);
                    if (!more) break; cb = nb; par ^= 1; }
            }
            __syncthreads();
#undef QFETCH
#undef PA_GATE
        }
        QUEUE_LOOP(2, N_SA, sa::sample_unit((char*)lds, item >> 3, item & 7, ST));
        if (PROBE_REPEAT == 20) { GRID_BAR(2); QUEUE_LOOP(6, N_LRU, { if (item < 128) lru::prompt_unit((char*)lds, LT, item >> 3, item & 7); else lru::sample_unit((char*)lds, LT, item - 128); }); }
        if (PROBE_REPEAT == 31) { GRID_BAR(2); QUEUE_LOOP(8, N_SA, sa::sample_unit((char*)lds, item >> 3, item & 7, ST)); }
        if (PROBE_REPEAT == 32) { GRID_BAR(2); }
        GRID_BAR(2);
    }

    if (IN(3)) {
        REP(3) {
        pg8::Gemm g{YC, WoutT, MP, DM, DM}; pg8::StaticOrder S; S.init(MP, DM, G, bx);
        pg8::EpiOut E{XB};
        pg8::gemm_phase<pg8::EpiOut, pg8::StaticOrder, true, true>(ldsl, g, S, E);
        }
        GRID_BAR(3);
    }

    if (IN(4)) {
        const float* ln_g = args.in[19]; const float* ln_b = args.in[20];
        if (bx < 32) {
            pg8::Gemm g{YC, WoutT, M, DM, DM}; pg8::OneUnit S{128 + (bx >> 3), bx & 7};
            pg8::EpiOut E{XB};
            pg8::gemm_phase<pg8::EpiOut, pg8::OneUnit, true, true>(ldsl, g, S, E);
        }
        f32x4 gv[8], bv[8];
#pragma unroll
        for (int j = 0; j < 8; ++j) { gv[j] = *(const f32x4*)(ln_g + 4 * lane + 256 * j); bv[j] = *(const f32x4*)(ln_b + 4 * lane + 256 * j); }
#define LN_ROW(m) do { const float* xr = (((m) < MP) ? x_p + (size_t)(m) * DM : x_s + (size_t)((m) - MP) * DM) + 4 * lane; \
            const bf16* orow = XB + (size_t)(m) * DM + 4 * lane; float* yr = out + O_YP + (size_t)(m) * DM + 4 * lane; \
            f32x4 v[8]; float s = 0.f; \
            _Pragma("unroll") for (int j = 0; j < 8; ++j) { const f32x4 xv = *(const f32x4*)(xr + 256 * j); const uint2 ob = *(const uint2*)(orow + 256 * j); \
                const f32x4 ov = {__uint_as_float(ob.x << 16), __uint_as_float(ob.x & 0xffff0000u), __uint_as_float(ob.y << 16), __uint_as_float(ob.y & 0xffff0000u)}; \
                v[j] = xv * ALPHA + ov; s += (v[j][0] + v[j][1]) + (v[j][2] + v[j][3]); } \
            const float mean = wave_sum(s) * (1.f / DM); float s2 = 0.f; \
            _Pragma("unroll") for (int j = 0; j < 8; ++j) { v[j] = v[j] - mean; s2 += (v[j][0] * v[j][0] + v[j][1] * v[j][1]) + (v[j][2] * v[j][2] + v[j][3] * v[j][3]); } \
            const float rstd = 1.f / sqrtf(wave_sum(s2) * (1.f / DM) + LN_EPS); \
            _Pragma("unroll") for (int j = 0; j < 8; ++j) *(f32x4*)(yr + 256 * j) = v[j] * rstd * gv[j] + bv[j]; } while (0)
        QUEUE_LOOP(3, MP / 64, { for (int r8 = 0; r8 < 8; ++r8) { const int m = item * 64 + r8 * 8 + wave; LN_ROW(m); } });
        GRID_BAR(4);
        { const int gw = bx * NWAVES + wave; if (gw < MS) { const int m = MP + gw; LN_ROW(m); } }
#undef LN_ROW
#undef QUEUE_LOOP
    }
#undef IN
#undef BOTH
#undef GRID_BAR
}

extern "C" void kernel_launch(void* const* d_in, const int* in_sizes, int n_in, void* d_out, int out_size, void* d_ws, size_t ws_size, hipStream_t stream) {
    static int grid = 0;
    if (grid == 0) {
        if (n_in != 21 || (size_t)out_size != O_END || ws_size < WS_END) { fprintf(stderr, "kernel_launch: unexpected shapes: n_in %d out %d ws %zu (need >= %zu); nothing launched\n", n_in, out_size, ws_size, (size_t)WS_END); grid = -1; return; }
        int dev = 0, cus = 0, per_cu = 0;
        if (hipGetDevice(&dev) != hipSuccess || hipDeviceGetAttribute(&cus, hipDeviceAttributeMultiprocessorCount, dev) != hipSuccess) { fprintf(stderr, "kernel_launch: device query failed\n"); grid = -1; return; }
        if (hipFuncSetAttribute((const void*)fwd_kernel, hipFuncAttributeMaxDynamicSharedMemorySize, LDS_BYTES) != hipSuccess) { fprintf(stderr, "kernel_launch: hipFuncSetAttribute failed\n"); grid = -1; return; }
        if (hipOccupancyMaxActiveBlocksPerMultiprocessor(&per_cu, (const void*)fwd_kernel, NWAVES * 64, LDS_BYTES) != hipSuccess || per_cu < 1)
            fprintf(stderr, "kernel_launch: note: occupancy query reports %d workgroups per CU\n", per_cu);
        (void)hipGetLastError();
        grid = cus;
        if (grid != 256) { fprintf(stderr, "kernel_launch: built for a 256-CU device (unit orders assume 256 workgroups), found %d; nothing launched\n", cus); grid = -1; return; }
    }
    if (grid < 0) return;
    if (hipMemsetAsync((char*)d_ws + WS_CTL, 0, CTL_ZERO_BYTES, stream) != hipSuccess) { fprintf(stderr, "kernel_launch: memset failed\n"); return; }
    Args a{};
    for (int i = 0; i < 21; ++i) a.in[i] = (const float*)d_in[i];
    a.out = (float*)d_out; a.ws = (unsigned char*)d_ws;
    if (N_LAUNCHES == 1) { a.ph_lo = 0; a.ph_hi = PER_PHASE; hipLaunchKernelGGL(fwd_kernel, dim3(grid), dim3(NWAVES * 64), LDS_BYTES, stream, a); }

    const hipError_t le = hipPeekAtLastError();
    if (le != hipSuccess) fprintf(stderr, "kernel_launch: launch failed: %s\n", hipGetErrorName(le));
}
```
